# Optimizing an MI355X kernel written in HIP

```python
import jax
import jax.numpy as jnp
from jax import lax
import numpy as np

D_MODEL = 1024
BATCH = 32
SEQ = 2048
DEPTH = 2

GRID_W = 64
CTX_LEN = 256
N_MIXERS = 2
N_ATTN_LAYERS = (DEPTH + N_MIXERS - 1) // N_MIXERS
N_RET_LAYERS = DEPTH // N_MIXERS

HEAD_DIM = 64
N_HEADS = D_MODEL // HEAD_DIM
N_KV_HEADS = N_HEADS // 4
GQA_GROUP = N_HEADS // N_KV_HEADS
WINDOW = 128
ATTN_BLOCK = 128
ATTN_PROJ = (N_HEADS + 2 * N_KV_HEADS) * HEAD_DIM

RET_HEADS = D_MODEL // 256
RET_QK_DIM = D_MODEL // RET_HEADS
RET_V_DIM = 2 * D_MODEL // RET_HEADS
RET_VWIDTH = 2 * D_MODEL
RET_CHUNK = 128
RET_PROJ = 2 * D_MODEL + 2 * RET_VWIDTH

D_FF = -(-8 * D_MODEL // (3 * 256)) * 256

ROPE_BASE = 10000.0
EPS = 1e-6
NEG_INF = -1e30

kernel_name = 'hybrid_swa_sink_retention_dit'


def rms_norm(x, g):
    xf = x.astype(jnp.float32)
    y = xf * lax.rsqrt(jnp.mean(xf * xf, axis=-1, keepdims=True) + EPS)
    return (y * g.astype(jnp.float32)).astype(x.dtype)


def modulate(h, shift, scale):
    return h * (1 + scale) + shift


def grid_positions(n):
    rows = n // GRID_W
    row = jnp.broadcast_to(jnp.arange(rows, dtype=jnp.int32)[:, None], (rows, GRID_W)).reshape(n)
    col = jnp.broadcast_to(jnp.arange(GRID_W, dtype=jnp.int32)[None, :], (rows, GRID_W)).reshape(n)
    return row, col


def rope_tables(n, head_dim):
    row, col = grid_positions(n)
    axis_dim = head_dim // 2
    inv = ROPE_BASE ** (-jnp.arange(0, axis_dim, 2, dtype=jnp.float32) / axis_dim)
    ang_r = row.astype(jnp.float32)[:, None] * inv
    ang_c = col.astype(jnp.float32)[:, None] * inv
    return jnp.cos(ang_r), jnp.sin(ang_r), jnp.cos(ang_c), jnp.sin(ang_c)


def rotate_axis(x, cos, sin):
    x1, x2 = jnp.split(x, 2, axis=-1)
    cos = cos[:, None, :]
    sin = sin[:, None, :]
    return jnp.concatenate([x1 * cos - x2 * sin, x1 * sin + x2 * cos], axis=-1)


def rope_2d(x, tables):
    cos_r, sin_r, cos_c, sin_c = tables
    xr, xc = jnp.split(x.astype(jnp.float32), 2, axis=-1)
    out = jnp.concatenate([rotate_axis(xr, cos_r, sin_r), rotate_axis(xc, cos_c, sin_c)], axis=-1)
    return out.astype(x.dtype)


def swiglu(h, w_in, w_out):
    gate, up = jnp.split(h @ w_in, 2, axis=-1)
    return (jax.nn.silu(gate) * up) @ w_out


def windowed_gqa_sink(h_x, h_c, w_qkv, q_gain, k_gain, sink, w_o, need_ctx_out):
    B, S, _ = h_x.shape
    L = h_c.shape[1]
    nb = S // ATTN_BLOCK
    band = ATTN_BLOCK + 2 * WINDOW
    scale = HEAD_DIM ** -0.5
    qd = N_HEADS * HEAD_DIM
    kvd = N_KV_HEADS * HEAD_DIM
    tables = rope_tables(S, HEAD_DIM)
    sink_g = sink.astype(jnp.float32).reshape(N_KV_HEADS, GQA_GROUP)[None, :, :, None, None]

    q_x, k_x, v_x = jnp.split(h_x @ w_qkv, [qd, qd + kvd], axis=-1)
    q_x = rope_2d(rms_norm(q_x.reshape(B, S, N_HEADS, HEAD_DIM), q_gain), tables)
    q_x = q_x.reshape(B, S, N_KV_HEADS, GQA_GROUP, HEAD_DIM)
    k_x = rope_2d(rms_norm(k_x.reshape(B, S, N_KV_HEADS, HEAD_DIM), k_gain), tables)
    v_x = v_x.reshape(B, S, N_KV_HEADS, HEAD_DIM)
    k_c, v_c = jnp.split(h_c @ w_qkv[:, qd:], 2, axis=-1)
    k_c = rms_norm(k_c.reshape(B, L, N_KV_HEADS, HEAD_DIM), k_gain)
    v_c = v_c.reshape(B, L, N_KV_HEADS, HEAD_DIM)

    pad = ((0, 0), (WINDOW, WINDOW), (0, 0), (0, 0))
    k_pad = jnp.pad(k_x, pad)
    v_pad = jnp.pad(v_x, pad)
    r_idx = jnp.arange(ATTN_BLOCK, dtype=jnp.int32)[:, None]
    n_idx = jnp.arange(band, dtype=jnp.int32)[None, :]
    in_window = (n_idx >= r_idx) & (n_idx - r_idx <= 2 * WINDOW)

    def block(b):
        start = b * ATTN_BLOCK
        qb = lax.dynamic_slice_in_dim(q_x, start, ATTN_BLOCK, axis=1)
        kb = lax.dynamic_slice_in_dim(k_pad, start, band, axis=1)
        vb = lax.dynamic_slice_in_dim(v_pad, start, band, axis=1)
        key_pos = start - WINDOW + n_idx
        valid = in_window & (key_pos >= 0) & (key_pos < S)
        s_ctx = jnp.einsum('bqkgd,bnkd->bkgqn', qb, k_c, preferred_element_type=jnp.float32) * scale
        s_loc = jnp.einsum('bqkgd,bnkd->bkgqn', qb, kb, preferred_element_type=jnp.float32) * scale
        s_loc = jnp.where(valid, s_loc, NEG_INF)
        sink_col = jnp.broadcast_to(sink_g, s_ctx.shape[:-1] + (1,))
        p = jax.nn.softmax(jnp.concatenate([s_ctx, s_loc, sink_col], axis=-1), axis=-1).astype(vb.dtype)
        return (jnp.einsum('bkgqn,bnkd->bqkgd', p[..., :L], v_c)
                + jnp.einsum('bkgqn,bnkd->bqkgd', p[..., L:L + band], vb))

    o_x = jnp.moveaxis(lax.map(block, jnp.arange(nb, dtype=jnp.int32)), 0, 1).reshape(B, S, qd)
    out_x = o_x @ w_o

    out_c = None
    if need_ctx_out:
        q_c = rms_norm((h_c @ w_qkv[:, :qd]).reshape(B, L, N_HEADS, HEAD_DIM), q_gain)
        q_c = q_c.reshape(B, L, N_KV_HEADS, GQA_GROUP, HEAD_DIM)
        s_c = jnp.einsum('bqkgd,bnkd->bkgqn', q_c, k_c, preferred_element_type=jnp.float32) * scale
        sink_col = jnp.broadcast_to(sink_g, s_c.shape[:-1] + (1,))
        p_c = jax.nn.softmax(jnp.concatenate([s_c, sink_col], axis=-1), axis=-1).astype(v_c.dtype)
        o_c = jnp.einsum('bkgqn,bnkd->bqkgd', p_c[..., :L], v_c)
        out_c = o_c.reshape(B, L, qd) @ w_o
    return out_c, out_x


def retention_chunked(q, k, v, log_gamma, state0):
    B, T, H, _ = q.shape
    nc = T // RET_CHUNK
    pos = jnp.arange(RET_CHUNK, dtype=jnp.float32)
    diff = pos[:, None] - pos[None, :]
    intra = jnp.where(diff >= 0, jnp.exp(log_gamma[:, None, None] * jnp.maximum(diff, 0.0)), 0.0)
    q_decay = jnp.exp(log_gamma[None, :] * (pos + 1.0)[:, None])[None, :, :, None]
    k_decay = jnp.exp(log_gamma[None, :] * (RET_CHUNK - 1.0 - pos)[:, None])[None, :, :, None]
    chunk_decay = jnp.exp(log_gamma * RET_CHUNK)[None, :, None, None]

    def to_chunks(a):
        return jnp.moveaxis(a.reshape(B, nc, RET_CHUNK, H, a.shape[-1]), 1, 0)

    def step(state, inp):
        qc, kc, vc = inp
        scores = jnp.einsum('bnhd,bmhd->bhnm', qc, kc) * intra
        inner = jnp.einsum('bhnm,bmhe->bnhe', scores, vc)
        cross = jnp.einsum('bnhd,bhde->bnhe', qc, state) * q_decay
        new_state = state * chunk_decay + jnp.einsum('bmhd,bmhe->bhde', kc * k_decay, vc)
        return new_state, inner + cross

    state, out = lax.scan(step, state0, (to_chunks(q), to_chunks(k), to_chunks(v)))
    return jnp.moveaxis(out, 0, 1).reshape(B, T, H, v.shape[-1]), state


def retention_final_state(k, v, log_gamma):
    T = k.shape[1]
    pos = jnp.arange(T, dtype=jnp.float32)
    decay = jnp.exp(log_gamma[None, :] * (T - 1.0 - pos)[:, None])[None, :, :, None]
    return jnp.einsum('bthd,bthe->bhde', k * decay, v)


def bidir_retention(h_x, h_c, w_qkvg, decay_logit, gn_gain, w_o, need_ctx_out):
    B, S, _ = h_x.shape
    L = h_c.shape[1]
    qk = RET_HEADS * RET_QK_DIM
    f32 = jnp.float32
    tables = rope_tables(S, RET_QK_DIM)
    log_g = jax.nn.log_sigmoid(decay_logit.astype(f32))
    k_scale = RET_QK_DIM ** -0.5

    q_x, k_x, v_x, g_x = jnp.split(h_x @ w_qkvg, [qk, 2 * qk, 2 * qk + RET_VWIDTH], axis=-1)
    q_x = rope_2d(q_x.reshape(B, S, RET_HEADS, RET_QK_DIM), tables).astype(f32)
    k_x = rope_2d(k_x.reshape(B, S, RET_HEADS, RET_QK_DIM), tables).astype(f32) * k_scale
    v_x = v_x.reshape(B, S, RET_HEADS, RET_V_DIM).astype(f32)
    k_c, v_c = jnp.split(h_c @ w_qkvg[:, qk:2 * qk + RET_VWIDTH], [qk], axis=-1)
    k_c = k_c.reshape(B, L, RET_HEADS, RET_QK_DIM).astype(f32) * k_scale
    v_c = v_c.reshape(B, L, RET_HEADS, RET_V_DIM).astype(f32)

    def flip(a):
        return jnp.flip(a, axis=1)

    def gated_out(o, g):
        mu = jnp.mean(o, axis=-1, keepdims=True)
        var = jnp.mean(jnp.square(o - mu), axis=-1, keepdims=True)
        y = ((o - mu) * lax.rsqrt(var + EPS)).reshape(o.shape[0], o.shape[1], RET_VWIDTH) * gn_gain.astype(f32)
        return (jax.nn.silu(g) * y.astype(g.dtype)) @ w_o

    out_c = None
    if need_ctx_out:
        q_c = (h_c @ w_qkvg[:, :qk]).reshape(B, L, RET_HEADS, RET_QK_DIM).astype(f32)
        g_c = h_c @ w_qkvg[:, 2 * qk + RET_VWIDTH:]
        zero_state = jnp.zeros((B, RET_HEADS, RET_QK_DIM, RET_V_DIM), f32)
        oc_f, state_f = retention_chunked(q_c, k_c, v_c, log_g[0], zero_state)
        oc_b, state_b = retention_chunked(flip(q_c), flip(k_c), flip(v_c), log_g[1], zero_state)
        out_c = gated_out(oc_f + flip(oc_b), g_c)
    else:
        state_f = retention_final_state(k_c, v_c, log_g[0])
        state_b = retention_final_state(flip(k_c), flip(v_c), log_g[1])

    ox_f, _ = retention_chunked(q_x, k_x, v_x, log_g[0], state_f)
    ox_b, _ = retention_chunked(flip(q_x), flip(k_x), flip(v_x), log_g[1], state_b)
    out_x = gated_out(ox_f + flip(ox_b), g_x)
    return out_c, out_x


def setup_inputs(seed: int = 0) -> dict:
    key = jax.random.key(seed)
    ks = jax.random.split(key, 19)
    f32 = jnp.float32

    def nrm(k, shape, scale):
        return jax.random.normal(k, shape, f32) * scale

    gamma = 1.0 - 2.0 ** (-5.0 - np.arange(RET_HEADS))
    decay_init = jnp.asarray(np.log(gamma / (1.0 - gamma)), dtype=f32)
    return {
        'x': nrm(ks[0], (BATCH, SEQ, D_MODEL), 1.0),
        'c': nrm(ks[1], (BATCH, D_MODEL), 1.0),
        'ctx': nrm(ks[2], (BATCH, CTX_LEN, D_MODEL), 1.0),
        'c_ctx': nrm(ks[3], (D_MODEL,), 1.0),
        'ada_w': nrm(ks[4], (DEPTH, D_MODEL, 6 * D_MODEL), 0.5 * D_MODEL ** -0.5),
        'ada_b': nrm(ks[5], (DEPTH, 6 * D_MODEL), 0.02),
        'norm1_g': 1.0 + nrm(ks[6], (DEPTH, D_MODEL), 0.02),
        'norm2_g': 1.0 + nrm(ks[7], (DEPTH, D_MODEL), 0.02),
        'ffn_w_in': nrm(ks[8], (DEPTH, D_MODEL, 2 * D_FF), D_MODEL ** -0.5),
        'ffn_w_out': nrm(ks[9], (DEPTH, D_FF, D_MODEL), D_FF ** -0.5),
        'attn_w_qkv': nrm(ks[10], (N_ATTN_LAYERS, D_MODEL, ATTN_PROJ), D_MODEL ** -0.5),
        'attn_q_norm': 1.0 + nrm(ks[11], (N_ATTN_LAYERS, HEAD_DIM), 0.02),
        'attn_k_norm': 1.0 + nrm(ks[12], (N_ATTN_LAYERS, HEAD_DIM), 0.02),
        'attn_sink': nrm(ks[13], (N_ATTN_LAYERS, N_HEADS), 0.5),
        'attn_w_o': nrm(ks[14], (N_ATTN_LAYERS, N_HEADS * HEAD_DIM, D_MODEL), (N_HEADS * HEAD_DIM) ** -0.5),
        'ret_w_qkvg': nrm(ks[15], (N_RET_LAYERS, D_MODEL, RET_PROJ), D_MODEL ** -0.5),
        'ret_decay_logit': decay_init[None, None, :] + nrm(ks[16], (N_RET_LAYERS, 2, RET_HEADS), 0.01),
        'ret_gn_g': 1.0 + nrm(ks[17], (N_RET_LAYERS, RET_VWIDTH), 0.02),
        'ret_w_o': nrm(ks[18], (N_RET_LAYERS, RET_VWIDTH, D_MODEL), RET_VWIDTH ** -0.5),
    }


def reference(x, c, ctx, c_ctx, ada_w, ada_b, norm1_g, norm2_g, ffn_w_in, ffn_w_out,
              attn_w_qkv, attn_q_norm, attn_k_norm, attn_sink, attn_w_o,
              ret_w_qkvg, ret_decay_logit, ret_gn_g, ret_w_o):
    c_act = jax.nn.silu(c)[:, None, :]
    cc_act = jax.nn.silu(c_ctx)[None, None, :]
    y_ctx = ctx
    for i in range(DEPTH):
        need_ctx_out = i < DEPTH - 1
        mx = jnp.split(c_act @ ada_w[i] + ada_b[i], 6, axis=-1)
        mc = jnp.split(cc_act @ ada_w[i] + ada_b[i], 6, axis=-1)
        h_x = modulate(rms_norm(x, norm1_g[i]), mx[0], mx[1])
        h_c = modulate(rms_norm(y_ctx, norm1_g[i]), mc[0], mc[1])
        j = i // N_MIXERS
        if i % N_MIXERS == 0:
            out_c, out_x = windowed_gqa_sink(h_x, h_c, attn_w_qkv[j], attn_q_norm[j], attn_k_norm[j],
                                             attn_sink[j], attn_w_o[j], need_ctx_out)
        else:
            out_c, out_x = bidir_retention(h_x, h_c, ret_w_qkvg[j], ret_decay_logit[j], ret_gn_g[j],
                                           ret_w_o[j], need_ctx_out)
        x = x + mx[2] * out_x
        x = x + mx[5] * swiglu(modulate(rms_norm(x, norm2_g[i]), mx[3], mx[4]), ffn_w_in[i], ffn_w_out[i])
        if need_ctx_out:
            y_ctx = y_ctx + mc[2] * out_c
            y_ctx = y_ctx + mc[5] * swiglu(modulate(rms_norm(y_ctx, norm2_g[i]), mc[3], mc[4]),
                                           ffn_w_in[i], ffn_w_out[i])
    return x
```

```cpp
#include <hip/hip_runtime.h>
#include <hip/hip_cooperative_groups.h>
#include <cstdio>
#include <cstdint>
namespace cg = cooperative_groups;

namespace pg8 {
#define PG8_LAS __attribute__((address_space(3)))
typedef unsigned short bf16_t;
typedef short bf16x8 __attribute__((ext_vector_type(8)));
typedef float f32x4 __attribute__((ext_vector_type(4)));
typedef unsigned u32x4 __attribute__((ext_vector_type(4)));
constexpr int BM = 256, BK = 64, HALF = 128, HTB = HALF * BK * 2  , STAGE_BYTES = 8 * HTB, NXCD = 8, WGM = 8;

__host__ __device__ __forceinline__ int lds_byte(int r, int c) { const int st = (r >> 4) * 2 + (c >> 5), rr = r & 15, cc = c & 31, ob = rr * 64 + cc * 2; return st * 1024 + (ob ^ (((ob >> 9) & 1) << 5)); }
__host__ __device__ __forceinline__ void stage_rc(int b, int& R, int& C) { const int st = b / 1024, sb = b % 1024, swz = sb ^ (((sb >> 9) & 1) << 5); R = (st >> 1) * 16 + swz / 64; C = (st & 1) * 32 + (swz % 64) / 2; }
__host__ __device__ __forceinline__ int perm32(int rho) { const int n = rho >> 4, i = rho & 15; return 8 * (i >> 2) + 4 * n + (i & 3); }

struct Unit { int pm, pn; };
struct Gemm { const bf16_t* A; const bf16_t* Bt; int M, N, K; };

struct StaticOrder {
    int nM, nN, nwg, G, c;
    __host__ __device__ void init(int M, int N, int G_, int c_) { nM = M / BM; nN = N / BM; nwg = nM * nN; G = G_; c = c_; }
    __host__ __device__ bool next(int i, Unit& u) const {
        const long L = (long)i * G + c; if (L >= nwg) return false;
        int wgid = (int)L; { const int q = nwg / NXCD, r = nwg % NXCD, xcd = wgid % NXCD, off = wgid / NXCD; wgid = (xcd < r ? xcd * (q + 1) : r * (q + 1) + (xcd - r) * q) + off; }
        const int nig = WGM * nN, gid = wgid / nig, fm = gid * WGM, gsz = (nM - fm) < WGM ? (nM - fm) : WGM;
        u.pm = fm + ((wgid % nig) % gsz); u.pn = (wgid % nig) / gsz; return true;
    }
    __device__ __forceinline__ void a_ready(const Unit&) const {}
    __device__ __forceinline__ void done(const Unit&) const {}
};

__device__ __forceinline__ unsigned cvt_pk_bf16(float lo, float hi) { unsigned r; asm volatile("v_cvt_pk_bf16_f32 %0, %1, %2" : "=v"(r) : "v"(lo), "v"(hi)); return r; }
typedef float f32x2 __attribute__((ext_vector_type(2)));
template <class Epi, class Sched, bool ALIGN_EPI = false, bool SP2 = false>
__device__ __forceinline__ void gemm_phase(PG8_LAS unsigned char* lds, const Gemm g, const Sched& S, const Epi& E) {
    int tid_l = threadIdx.x; asm volatile("" : "+v"(tid_l));
    const int tid = tid_l, wid = __builtin_amdgcn_readfirstlane(tid >> 6), lane = tid & 63, wr = wid >> 2, wc = wid & 3, fr = lane & 15, fq = lane >> 4;
    const int K = g.K, nt = K / BK;
    unsigned voffA[2], voffB[2];
#pragma unroll
    for (int i = 0; i < 2; ++i) { int R, C; stage_rc(tid * 16 + i * 8192, R, C); const int Rb = Epi::PERM ? ((R & ~31) + perm32(R & 31)) : R;
        voffA[i] = (unsigned)(R * K + C) * 2u; voffB[i] = (unsigned)(Rb * K + C) * 2u; }
    const size_t kstep = (size_t)(BK * 2);
    const size_t hstep = (size_t)HALF * K * 2;
    const size_t tstep = 2 * hstep;
    const unsigned ldsw = (unsigned)wid * 1024u;
    const int aoff = lds_byte(wr * 64 + fr, fq * 8), boff = lds_byte(wc * 32 + fr, fq * 8);
#define PG8_SA(b, h) (((b) * 2 + (h)) * HTB)
#define PG8_SB(b, h) ((4 + (b) * 2 + (h)) * HTB)
#define PG8_STAGE(bufoff, gbase, voff) do { _Pragma("unroll") for (int _i = 0; _i < 2; ++_i) \
        __builtin_amdgcn_global_load_lds((const unsigned*)((const char*)(gbase) + (voff)[_i]), (PG8_LAS unsigned*)(lds + (bufoff) + ldsw + _i * 8192), 16, 0, 0); } while (0)
#define PG8_LDA(dst, b, h) do { _Pragma("unroll") for (int m = 0; m < 4; ++m) _Pragma("unroll") for (int k = 0; k < 2; ++k) dst[m][k] = *(const PG8_LAS bf16x8*)(lds + PG8_SA(b, h) + aoff + m * 2048 + k * 1024); } while (0)
#define PG8_LDB(dst, b, h) do { _Pragma("unroll") for (int n = 0; n < 2; ++n) _Pragma("unroll") for (int k = 0; k < 2; ++k) dst[n][k] = *(const PG8_LAS bf16x8*)(lds + PG8_SB(b, h) + boff + n * 2048 + k * 1024); } while (0)
#define PG8_MMA(ai, bj, At, Bt) do { __builtin_amdgcn_s_setprio(1); _Pragma("unroll") for (int m = 0; m < 4; ++m) _Pragma("unroll") for (int n = 0; n < 2; ++n) _Pragma("unroll") for (int k = 0; k < 2; ++k) \
        acc[ai][bj][m][n] = __builtin_amdgcn_mfma_f32_16x16x32_bf16(Bt[n][k], At[m][k], acc[ai][bj][m][n], 0, 0, 0); __builtin_amdgcn_s_setprio(0); } while (0)
#define PG8_WAIT_V(n) asm volatile("s_waitcnt vmcnt(" #n ")" ::: "memory")
#define PG8_WAIT_L(n) asm volatile("s_waitcnt lgkmcnt(" #n ")" ::: "memory")
#define PG8_BAR __builtin_amdgcn_s_barrier()
#define PG8_SCHED __builtin_amdgcn_sched_barrier(0)
    Unit cur, nxt; int ui = 0;
    if (!S.next(0, cur)) return;
    f32x4 acc[2][2][4][2];
#pragma unroll
    for (int a = 0; a < 2; ++a)
#pragma unroll
        for (int b = 0; b < 2; ++b)
#pragma unroll
            for (int m = 0; m < 4; ++m)
#pragma unroll
                for (int n = 0; n < 2; ++n) acc[a][b][m][n] = (f32x4){0.f, 0.f, 0.f, 0.f};
    bf16x8 At[4][2], B0[2][2], B1[2][2];
    const char* cA = (const char*)g.A + (size_t)cur.pm * tstep; const char* cB = (const char*)g.Bt + (size_t)cur.pn * tstep;
    S.a_ready(cur);
    if constexpr (SP2) {
        PG8_STAGE(PG8_SB(0, 0), cB, voffB); PG8_STAGE(PG8_SB(0, 1), cB + hstep, voffB); PG8_STAGE(PG8_SA(0, 0), cA, voffA); PG8_STAGE(PG8_SA(0, 1), cA + hstep, voffA);
        if (wr == 1) PG8_BAR;
        PG8_WAIT_V(2); PG8_BAR;
        PG8_STAGE(PG8_SB(1, 0), cB + kstep, voffB); PG8_STAGE(PG8_SA(1, 0), cA + kstep, voffA); PG8_STAGE(PG8_SB(1, 1), cB + hstep + kstep, voffB);
        PG8_WAIT_V(6); PG8_BAR;
    } else {
        PG8_STAGE(PG8_SB(0, 0), cB, voffB); PG8_STAGE(PG8_SA(0, 0), cA, voffA); PG8_STAGE(PG8_SB(0, 1), cB + hstep, voffB); PG8_STAGE(PG8_SA(0, 1), cA + hstep, voffA);
        if (wr == 1) PG8_BAR;
        PG8_WAIT_V(4); PG8_BAR;
        PG8_STAGE(PG8_SB(1, 0), cB + kstep, voffB); PG8_STAGE(PG8_SA(1, 0), cA + kstep, voffA); PG8_STAGE(PG8_SB(1, 1), cB + hstep + kstep, voffB);
        PG8_WAIT_V(6); PG8_BAR;
    }
    for (;;) {
        const bool has_next = S.next(ui + 1, nxt);
        const char* nA = has_next ? (const char*)g.A + (size_t)nxt.pm * tstep : cA; const char* nB = has_next ? (const char*)g.Bt + (size_t)nxt.pn * tstep : cB;
        for (int t = 0; t < nt; t += 2) {
            const bool last = (t == nt - 2);
            const char* a1 = cA + (size_t)(t + 1) * kstep;
            const char* a2 = last ? nA : cA + (size_t)(t + 2) * kstep; const char* b2 = last ? nB : cB + (size_t)(t + 2) * kstep;
            const char* a3 = a2 + kstep; const char* b3 = b2 + kstep;
            if (last && has_next) S.a_ready(nxt);
            if constexpr (SP2) {
            PG8_LDB(B0, 0, 0); PG8_LDB(B1, 0, 1); PG8_SCHED; PG8_LDA(At, 0, 0); PG8_STAGE(PG8_SA(1, 1), a1 + hstep, voffA);
            PG8_WAIT_V(8); PG8_WAIT_L(0); PG8_BAR; PG8_MMA(0, 0, At, B0); PG8_MMA(0, 1, At, B1); PG8_BAR; PG8_SCHED;
            PG8_LDA(At, 0, 1); PG8_STAGE(PG8_SB(0, 0), b2, voffB); PG8_STAGE(PG8_SB(0, 1), b2 + hstep, voffB); PG8_STAGE(PG8_SA(0, 0), a2, voffA);
            PG8_WAIT_V(8); PG8_WAIT_L(0); PG8_BAR; PG8_MMA(1, 0, At, B0); PG8_MMA(1, 1, At, B1); PG8_BAR; PG8_SCHED;
            PG8_LDB(B0, 1, 0); PG8_LDB(B1, 1, 1); PG8_SCHED; PG8_LDA(At, 1, 0); PG8_STAGE(PG8_SA(0, 1), a2 + hstep, voffA);
            PG8_WAIT_V(8); PG8_WAIT_L(0); PG8_BAR; PG8_MMA(0, 0, At, B0); PG8_MMA(0, 1, At, B1); PG8_BAR; PG8_SCHED;
            PG8_LDA(At, 1, 1); PG8_STAGE(PG8_SB(1, 0), b3, voffB); PG8_STAGE(PG8_SB(1, 1), b3 + hstep, voffB); PG8_STAGE(PG8_SA(1, 0), a3, voffA);
            PG8_WAIT_V(8); PG8_WAIT_L(0); PG8_BAR; PG8_MMA(1, 0, At, B0); PG8_MMA(1, 1, At, B1); PG8_BAR; PG8_SCHED;
            } else {
            PG8_LDB(B0, 0, 0); PG8_SCHED; PG8_LDA(At, 0, 0); PG8_STAGE(PG8_SA(1, 1), a1 + hstep, voffA);
            PG8_WAIT_L(8); PG8_BAR; PG8_WAIT_L(0); PG8_MMA(0, 0, At, B0); PG8_BAR; PG8_SCHED;
            PG8_LDB(B1, 0, 1); PG8_STAGE(PG8_SB(0, 0), b2, voffB);
            PG8_BAR; PG8_WAIT_L(0); PG8_MMA(0, 1, At, B1); PG8_BAR;
            PG8_LDA(At, 0, 1); PG8_STAGE(PG8_SA(0, 0), a2, voffA);
            PG8_BAR; PG8_WAIT_L(0); PG8_MMA(1, 0, At, B0); PG8_BAR; PG8_SCHED;
            PG8_STAGE(PG8_SB(0, 1), b2 + hstep, voffB);
            PG8_WAIT_V(6); PG8_BAR; PG8_MMA(1, 1, At, B1); PG8_BAR;
            PG8_LDB(B0, 1, 0); PG8_SCHED; PG8_LDA(At, 1, 0); PG8_STAGE(PG8_SA(0, 1), a2 + hstep, voffA);
            PG8_WAIT_L(8); PG8_BAR; PG8_WAIT_L(0); PG8_MMA(0, 0, At, B0); PG8_BAR; PG8_SCHED;
            PG8_LDB(B1, 1, 1); PG8_STAGE(PG8_SB(1, 0), b3, voffB);
            PG8_BAR; PG8_WAIT_L(0); PG8_MMA(0, 1, At, B1); PG8_BAR;
            PG8_LDA(At, 1, 1); PG8_STAGE(PG8_SA(1, 0), a3, voffA);
            PG8_BAR; PG8_WAIT_L(0); PG8_MMA(1, 0, At, B0); PG8_BAR; PG8_SCHED;
            PG8_STAGE(PG8_SB(1, 1), b3 + hstep, voffB);
            PG8_WAIT_V(6); PG8_BAR; PG8_MMA(1, 1, At, B1); PG8_BAR;
            }
        }
        if constexpr (ALIGN_EPI) { if (wr == 0) PG8_BAR; }
        if constexpr (!Epi::AFTER_DRAIN) { E(acc, cur, wr, wc, fr, fq); S.done(cur); }
        if (!has_next) break;
#pragma unroll
        for (int a = 0; a < 2; ++a)
#pragma unroll
            for (int b = 0; b < 2; ++b)
#pragma unroll
                for (int m = 0; m < 4; ++m)
#pragma unroll
                    for (int n = 0; n < 2; ++n) acc[a][b][m][n] = (f32x4){0.f, 0.f, 0.f, 0.f};
        cur = nxt; cA = nA; cB = nB; ++ui;
        if constexpr (ALIGN_EPI) { if (wr == 1) PG8_BAR; }
    }
    PG8_WAIT_V(0);
    if constexpr (!ALIGN_EPI) { if (wr == 0) PG8_BAR; }
    PG8_BAR;
    if constexpr (Epi::AFTER_DRAIN) { E.fused(acc, cur, wr, wc, fr, fq, lds, wid, lane); S.done(cur); }
#undef PG8_SA
#undef PG8_SB
#undef PG8_STAGE
#undef PG8_LDA
#undef PG8_LDB
#undef PG8_MMA
#undef PG8_WAIT_V
#undef PG8_WAIT_L
#undef PG8_BAR
#undef PG8_SCHED
}
}

#ifndef PG8_SP2
#define PG8_SP2 true
#endif
#ifndef PG8_ALIGN
#define PG8_ALIGN true
#endif

#define LAS __attribute__((address_space(3)))
typedef unsigned short bf16_t;
typedef short bf16x8 __attribute__((ext_vector_type(8)));
typedef short s16x4 __attribute__((ext_vector_type(4)));
typedef float f32x4 __attribute__((ext_vector_type(4)));
typedef float f32x16 __attribute__((ext_vector_type(16)));
typedef unsigned u32x4 __attribute__((ext_vector_type(4)));
typedef unsigned u32x2 __attribute__((ext_vector_type(2)));

constexpr int NB = 32, SEQ = 2048, DM = 1024, CL = 256, MX = NB * SEQ, MC = NB * CL, MA = MX + MC, DFF = 2816;
constexpr float LOG2E = 1.4426950408889634f;
constexpr float EPSN = 1e-6f;
constexpr size_t MiB = (size_t)1 << 20;
constexpr size_t WS_WQKV0 = 1 * MiB, WS_WO0 = 4 * MiB, WS_WIN0 = 6 * MiB, WS_WOUT0 = 17 * MiB, WS_WR = 23 * MiB, WS_WRO = 35 * MiB, WS_WIN1 = 39 * MiB, WS_WOUT1 = 50 * MiB;
constexpr size_t WS_MOD = 56 * MiB, WS_TAB0 = 58 * MiB, WS_TAB1 = 58 * MiB + 65536;
constexpr size_t WS_GNS = 60 * MiB;
constexpr size_t WS_X = 64 * MiB;
constexpr size_t WS_H = 208 * MiB, WS_QKV0 = 352 * MiB, WS_ACT0 = 352 * MiB;
constexpr size_t WS_Q1 = 208 * MiB, WS_K1 = 352 * MiB, WS_V1 = 496 * MiB, WS_HL1 = 784 * MiB, WS_ACT1 = 352 * MiB, WS_END = 1024 * MiB;
constexpr int LDS_BYTES = 152 * 1024, XB_LDS_OFF = 150 * 1024;
constexpr size_t WS_BAR = 62 * MiB;
constexpr int NPHASE = 16;

__device__ __forceinline__ unsigned pkbf(float lo, float hi) { return pg8::cvt_pk_bf16(lo, hi); }
__device__ __forceinline__ float bf_lo(unsigned w) { return __builtin_bit_cast(float, w << 16); }
__device__ __forceinline__ float bf_hi(unsigned w) { return __builtin_bit_cast(float, w & 0xffff0000u); }
__device__ __forceinline__ float bf2f(bf16_t v) { return __builtin_bit_cast(float, (unsigned)v << 16); }
__device__ __forceinline__ float wave_sum(float v) {
#pragma unroll
    for (int o = 1; o < 64; o <<= 1) v += __shfl_xor(v, o);
    return v;
}
__device__ __forceinline__ float fast_silu(float x) { return x * __builtin_amdgcn_rcpf(1.0f + __expf(-x)); }

struct EpiSplit {
    static constexpr bool PERM = true, AFTER_DRAIN = false;
    bf16_t* d0; int ld0; int t1; bf16_t* d1; int ld1; int t2; bf16_t* d2; int ld2;
    __device__ __forceinline__ void operator()(const pg8::f32x4 (&acc)[2][2][4][2], const pg8::Unit& u, int wr, int wc, int fr, int fq) const {
        bf16_t* base; int ld, ct;
        if (u.pn < t1) { base = d0; ld = ld0; ct = u.pn; } else if (u.pn < t2) { base = d1; ld = ld1; ct = u.pn - t1; } else { base = d2; ld = ld2; ct = u.pn - t2; }
        const int row0 = u.pm * 256 + wr * 64 + fr, col0 = ct * 256 + wc * 32 + 8 * fq;
#pragma unroll
        for (int ai = 0; ai < 2; ++ai)
#pragma unroll
            for (int m = 0; m < 4; ++m) { bf16_t* rowp = base + (size_t)(row0 + ai * 128 + m * 16) * ld + col0;
#pragma unroll
                for (int bj = 0; bj < 2; ++bj) { const pg8::f32x4 v0 = acc[ai][bj][m][0], v1 = acc[ai][bj][m][1]; u32x4 w;
                    w.x = pkbf(v0[0], v0[1]); w.y = pkbf(v0[2], v0[3]); w.z = pkbf(v1[0], v1[1]); w.w = pkbf(v1[2], v1[3]);
                    *(u32x4*)(rowp + bj * 128) = w; } }
    }
};
struct EpiQKV0 {
    static constexpr bool PERM = true, AFTER_DRAIN = false;
    bf16_t* O; const float* qg; const float* kg; const float* tab0;
    __device__ __forceinline__ void operator()(const pg8::f32x4 (&acc)[2][2][4][2], const pg8::Unit& u, int wr, int wc, int fr, int fq) const {
        const int row0 = u.pm * 256 + wr * 64 + fr, col0 = u.pn * 256 + wc * 32 + 8 * fq;
        if (u.pn >= 5) {
#pragma unroll
            for (int ai = 0; ai < 2; ++ai)
#pragma unroll
                for (int m = 0; m < 4; ++m) { bf16_t* rowp = O + (size_t)(row0 + ai * 128 + m * 16) * 1536 + col0;
#pragma unroll
                    for (int bj = 0; bj < 2; ++bj) { const pg8::f32x4 v0 = acc[ai][bj][m][0], v1 = acc[ai][bj][m][1]; u32x4 w;
                        w.x = pkbf(v0[0], v0[1]); w.y = pkbf(v0[2], v0[3]); w.z = pkbf(v1[0], v1[1]); w.w = pkbf(v1[2], v1[3]); *(u32x4*)(rowp + bj * 128) = w; } }
            return;
        }
        const float* gp = (u.pn < 4 ? qg : kg) + 8 * fq + (fq >= 2 ? 16 : 0);
        const float qs = u.pn < 4 ? 0.125f * LOG2E : 1.0f;
        pg8::f32x4 g1[2], g2[2];
#pragma unroll
        for (int n = 0; n < 2; ++n) { g1[n] = *(const pg8::f32x4*)(gp + 4 * n) * qs; g2[n] = *(const pg8::f32x4*)(gp + 16 + 4 * n) * qs; }
        const bool lat = u.pm * 256 < MX;
#pragma unroll
        for (int ai = 0; ai < 2; ++ai)
#pragma unroll
            for (int m = 0; m < 4; ++m) { const int row = row0 + ai * 128 + m * 16;
                pg8::f32x4 x1[2] = {acc[ai][0][m][0], acc[ai][0][m][1]}, x2[2] = {acc[ai][1][m][0], acc[ai][1][m][1]};
                float ss = 0.f;
#pragma unroll
                for (int n = 0; n < 2; ++n) ss += (x1[n][0] * x1[n][0] + x1[n][1] * x1[n][1]) + (x1[n][2] * x1[n][2] + x1[n][3] * x1[n][3]) + (x2[n][0] * x2[n][0] + x2[n][1] * x2[n][1]) + (x2[n][2] * x2[n][2] + x2[n][3] * x2[n][3]);
                ss += __shfl_xor(ss, 16); ss += __shfl_xor(ss, 32);
                const float rstd = rsqrtf(ss * (1.0f / 64.0f) + EPSN);
#pragma unroll
                for (int n = 0; n < 2; ++n) { x1[n] = x1[n] * rstd * g1[n]; x2[n] = x2[n] * rstd * g2[n]; }
                if (lat) { const int s = row & (SEQ - 1), pos = (fq & 2) ? (s & 63) : (s >> 6);
                    const float* tp = tab0 + ((size_t)pos * 16 + 8 * (fq & 1)) * 2;
#pragma unroll
                    for (int n = 0; n < 2; ++n) { const pg8::f32x4 t0 = *(const pg8::f32x4*)(tp + 8 * n), t1 = *(const pg8::f32x4*)(tp + 8 * n + 4);
                        const pg8::f32x4 cs = {t0[0], t0[2], t1[0], t1[2]}, sn = {t0[1], t0[3], t1[1], t1[3]};
                        const pg8::f32x4 a = x1[n] * cs - x2[n] * sn, bb = x1[n] * sn + x2[n] * cs; x1[n] = a; x2[n] = bb; } }
                bf16_t* rowp = O + (size_t)row * 1536 + col0; u32x4 w;
                w.x = pkbf(x1[0][0], x1[0][1]); w.y = pkbf(x1[0][2], x1[0][3]); w.z = pkbf(x1[1][0], x1[1][1]); w.w = pkbf(x1[1][2], x1[1][3]); *(u32x4*)rowp = w;
                w.x = pkbf(x2[0][0], x2[0][1]); w.y = pkbf(x2[0][2], x2[0][3]); w.z = pkbf(x2[1][0], x2[1][1]); w.w = pkbf(x2[1][2], x2[1][3]); *(u32x4*)(rowp + 128) = w;
                asm volatile("" ::: "memory"); }
    }
};
struct EpiQKV1 {
    static constexpr bool PERM = true, AFTER_DRAIN = false;
    bf16_t* Qd; bf16_t* Kd; bf16_t* Vd; const float* tab1;
    __device__ __forceinline__ void operator()(const pg8::f32x4 (&acc)[2][2][4][2], const pg8::Unit& u, int wr, int wc, int fr, int fq) const {
        bf16_t* base; int ld, ct;
        if (u.pn < 4) { base = Qd; ld = 1024; ct = u.pn; } else if (u.pn < 8) { base = Kd; ld = 1024; ct = u.pn - 4; } else { base = Vd; ld = 2048; ct = u.pn - 8; }
        const int row0 = u.pm * 256 + wr * 64 + fr, col0 = ct * 256 + wc * 32 + 8 * fq;
        const bool rope = u.pn < 8 && u.pm * 256 < MX;
#pragma unroll
        for (int ai = 0; ai < 2; ++ai)
#pragma unroll
            for (int m = 0; m < 4; ++m) { const int row = row0 + ai * 128 + m * 16;
                pg8::f32x4 x1[2] = {acc[ai][0][m][0], acc[ai][0][m][1]}, x2[2] = {acc[ai][1][m][0], acc[ai][1][m][1]};
                if (rope) { const int s = row & (SEQ - 1), pos = (wc & 2) ? (s & 63) : (s >> 6);
                    const float* tp = tab1 + ((size_t)pos * 64 + 32 * (wc & 1) + 8 * fq) * 2;
#pragma unroll
                    for (int n = 0; n < 2; ++n) { const pg8::f32x4 t0 = *(const pg8::f32x4*)(tp + 8 * n), t1 = *(const pg8::f32x4*)(tp + 8 * n + 4);
                        const pg8::f32x4 cs = {t0[0], t0[2], t1[0], t1[2]}, sn = {t0[1], t0[3], t1[1], t1[3]};
                        const pg8::f32x4 a = x1[n] * cs - x2[n] * sn, bb = x1[n] * sn + x2[n] * cs; x1[n] = a; x2[n] = bb; } }
                bf16_t* rowp = base + (size_t)row * ld + col0; u32x4 w;
                w.x = pkbf(x1[0][0], x1[0][1]); w.y = pkbf(x1[0][2], x1[0][3]); w.z = pkbf(x1[1][0], x1[1][1]); w.w = pkbf(x1[1][2], x1[1][3]); *(u32x4*)rowp = w;
                w.x = pkbf(x2[0][0], x2[0][1]); w.y = pkbf(x2[0][2], x2[0][3]); w.z = pkbf(x2[1][0], x2[1][1]); w.w = pkbf(x2[1][2], x2[1][3]); *(u32x4*)(rowp + 128) = w;
                asm volatile("" ::: "memory"); }
    }
};
template <int MODE> struct EpiResid {
    static constexpr bool PERM = true, AFTER_DRAIN = false;
    const float* xin_lat; const float* xin_ctx; bf16_t* X; float* outf; const float* gate;
    __device__ __forceinline__ void operator()(const pg8::f32x4 (&acc)[2][2][4][2], const pg8::Unit& u, int wr, int wc, int fr, int fq) const {
        const int R = u.pm * 256; const int gr = R < MX ? R / SEQ : NB;
        const int col0 = u.pn * 256 + wc * 32 + 8 * fq; const float* gp = gate + (size_t)gr * 6144 + col0;
        const float* xi = R < MX ? xin_lat + (size_t)R * DM : xin_ctx + (size_t)(R - MX) * DM;
        pg8::f32x4 g[2][2];
#pragma unroll
        for (int bj = 0; bj < 2; ++bj)
#pragma unroll
            for (int n = 0; n < 2; ++n) g[bj][n] = *(const pg8::f32x4*)(gp + bj * 128 + 4 * n);
#pragma unroll
        for (int ai = 0; ai < 2; ++ai)
#pragma unroll
            for (int m = 0; m < 4; ++m) { const size_t off = (size_t)(wr * 64 + fr + ai * 128 + m * 16) * DM + col0;
#pragma unroll
                for (int bj = 0; bj < 2; ++bj) {
                    pg8::f32x4 x0, x1;
                    if (MODE == 0) { x0 = *(const pg8::f32x4*)(xi + off + bj * 128); x1 = *(const pg8::f32x4*)(xi + off + bj * 128 + 4); }
                    else { const u32x4 w = *(const u32x4*)(X + (size_t)R * DM + off + bj * 128); x0 = (pg8::f32x4){bf_lo(w.x), bf_hi(w.x), bf_lo(w.y), bf_hi(w.y)}; x1 = (pg8::f32x4){bf_lo(w.z), bf_hi(w.z), bf_lo(w.w), bf_hi(w.w)}; }
                    x0 = x0 + g[bj][0] * acc[ai][bj][m][0]; x1 = x1 + g[bj][1] * acc[ai][bj][m][1];
                    if (MODE == 2) { __builtin_nontemporal_store(x0, (pg8::f32x4*)(outf + (size_t)R * DM + off + bj * 128)); __builtin_nontemporal_store(x1, (pg8::f32x4*)(outf + (size_t)R * DM + off + bj * 128 + 4)); }
                    else { u32x4 w; w.x = pkbf(x0[0], x0[1]); w.y = pkbf(x0[2], x0[3]); w.z = pkbf(x1[0], x1[1]); w.w = pkbf(x1[2], x1[3]); *(u32x4*)(X + (size_t)R * DM + off + bj * 128) = w; } }
                asm volatile("" ::: "memory"); }
    }
};
typedef float f32x2v __attribute__((ext_vector_type(2)));
__device__ __forceinline__ f32x2v swg2(const f32x2v g, const f32x2v u) {
    f32x2v e; e.x = __builtin_amdgcn_exp2f(g.x); e.y = __builtin_amdgcn_exp2f(g.y);
    const f32x2v d = e + 1.0f; f32x2v r; r.x = __builtin_amdgcn_rcpf(d.x); r.y = __builtin_amdgcn_rcpf(d.y);
    return (g * u) * r;
}
struct EpiSwiglu {
    static constexpr bool PERM = true, AFTER_DRAIN = false;
    bf16_t* O;
    __device__ __forceinline__ void operator()(const pg8::f32x4 (&acc)[2][2][4][2], const pg8::Unit& u, int wr, int wc, int fr, int fq) const {
        const int row0 = u.pm * 256 + wr * 64 + fr, col0 = u.pn * 128 + wc * 32 + 8 * fq;
#pragma unroll
        for (int ai = 0; ai < 2; ++ai)
#pragma unroll
            for (int m = 0; m < 4; ++m) { const pg8::f32x4 g0 = acc[ai][0][m][0], g1 = acc[ai][0][m][1], u0 = acc[ai][1][m][0], u1 = acc[ai][1][m][1]; u32x4 w;
                { const f32x2v a = swg2((f32x2v){g0[0], g0[1]}, (f32x2v){u0[0], u0[1]}), b = swg2((f32x2v){g0[2], g0[3]}, (f32x2v){u0[2], u0[3]});
                  const f32x2v c = swg2((f32x2v){g1[0], g1[1]}, (f32x2v){u1[0], u1[1]}), d = swg2((f32x2v){g1[2], g1[3]}, (f32x2v){u1[2], u1[3]});
                  w.x = pkbf(a.x, a.y); w.y = pkbf(b.x, b.y); w.z = pkbf(c.x, c.y); w.w = pkbf(d.x, d.y); }
                *(u32x4*)(O + (size_t)(row0 + ai * 128 + m * 16) * DFF + col0) = w; }
    }
};
struct EpiGate {
    static constexpr bool PERM = true, AFTER_DRAIN = false;
    bf16_t* Y; const float* stats; const float* gain;
    __device__ __forceinline__ void operator()(const pg8::f32x4 (&acc)[2][2][4][2], const pg8::Unit& u, int wr, int wc, int fr, int fq) const {
        const int row0 = u.pm * 256 + wr * 64 + fr, col0 = u.pn * 256 + wc * 32 + 8 * fq, hg = u.pn >> 1;
        pg8::f32x4 g[2][2];
#pragma unroll
        for (int bj = 0; bj < 2; ++bj)
#pragma unroll
            for (int n = 0; n < 2; ++n) g[bj][n] = *(const pg8::f32x4*)(gain + col0 + bj * 128 + 4 * n);
#pragma unroll
        for (int ai = 0; ai < 2; ++ai)
#pragma unroll
            for (int m = 0; m < 4; ++m) { const int row = row0 + ai * 128 + m * 16; bf16_t* rowp = Y + (size_t)row * 2048 + col0;
                const float s0 = stats[((size_t)row * 4 + hg) * 2], s1 = stats[((size_t)row * 4 + hg) * 2 + 1];
                const float mu = s0 * (1.0f / 512.0f), rstd = rsqrtf(fmaxf(s1 * (1.0f / 512.0f) - mu * mu, 0.f) + EPSN);
#pragma unroll
                for (int bj = 0; bj < 2; ++bj) { const u32x4 y = *(const u32x4*)(rowp + bj * 128); const pg8::f32x4 v0 = acc[ai][bj][m][0], v1 = acc[ai][bj][m][1];
                    const pg8::f32x4 y0 = ((pg8::f32x4){bf_lo(y.x), bf_hi(y.x), bf_lo(y.y), bf_hi(y.y)} - mu) * rstd * g[bj][0], y1 = ((pg8::f32x4){bf_lo(y.z), bf_hi(y.z), bf_lo(y.w), bf_hi(y.w)} - mu) * rstd * g[bj][1];
                    u32x4 w;
                    w.x = pkbf(fast_silu(v0[0]) * y0[0], fast_silu(v0[1]) * y0[1]); w.y = pkbf(fast_silu(v0[2]) * y0[2], fast_silu(v0[3]) * y0[3]);
                    w.z = pkbf(fast_silu(v1[0]) * y1[0], fast_silu(v1[1]) * y1[1]); w.w = pkbf(fast_silu(v1[2]) * y1[2], fast_silu(v1[3]) * y1[3]);
                    *(u32x4*)(rowp + bj * 128) = w; }
                asm volatile("" ::: "memory"); }
    }
};

__device__ __forceinline__ int drow_map(int mode, int n) {
    if (mode == 1) return n < DFF ? (n / 128) * 256 + (n % 128) : ((n - DFF) / 128) * 256 + 128 + ((n - DFF) % 128);
    if (mode == 2) { if (n >= 2048) return n; const int o = n & 255, blk = o >> 6, nb = (blk == 1) ? 2 : (blk == 2 ? 1 : blk); return (n - o) + 64 * nb + (o & 63); }
    if (mode == 3) { if (n >= 1280) return n; const int o = n & 255, hd = o >> 6, d = o & 63, q16 = d >> 4; return (n - o) + 128 * (q16 & 1) + 32 * hd + 16 * (q16 >> 1) + (d & 15); }
    return n;
}
__device__ __forceinline__ void transpose_item(const float* W, int K, int N, bf16_t* WT, int k0, int n0, int mode, LAS float* scr, int lane) {
#pragma unroll 8
    for (int i = 0; i < 32; ++i) { const int kk = 2 * i + (lane >> 5); scr[kk * 33 + (lane & 31)] = W[(size_t)(k0 + kk) * N + n0 + (lane & 31)]; }
    asm volatile("s_waitcnt lgkmcnt(0)" ::: "memory");
    const int c = lane & 7;
    const float wsc = mode == 1 ? (n0 < DFF ? -LOG2E : -1.0f / LOG2E) : 1.0f;
#pragma unroll
    for (int j = 0; j < 4; ++j) { const int n = (lane >> 3) + 8 * j; const LAS float* s = scr + (8 * c) * 33 + n;
        u32x4 o; o.x = pkbf(s[0 * 33] * wsc, s[1 * 33] * wsc); o.y = pkbf(s[2 * 33] * wsc, s[3 * 33] * wsc); o.z = pkbf(s[4 * 33] * wsc, s[5 * 33] * wsc); o.w = pkbf(s[6 * 33] * wsc, s[7 * 33] * wsc);
        *(u32x4*)(WT + (size_t)drow_map(mode, n0 + n) * K + k0 + 8 * c) = o; }
    asm volatile("s_waitcnt lgkmcnt(0)" ::: "memory");
}

struct Args { const float* in[19]; float* out; unsigned char* ws; int ph_lo, ph_hi; };

__device__ __forceinline__ void phase0(const Args& a, LAS unsigned char* lds, int tid) {
    const int wave = tid >> 6, lane = tid & 63;
    const int gw = blockIdx.x * 8 + wave, NGW = gridDim.x * 8;
    unsigned char* ws = a.ws;
    {
        LAS float* scr = (LAS float*)(lds + wave * 16384);
        constexpr int I0 = 16 * 48, I1 = 16 * 32, I2 = 16 * 176, I3 = 44 * 32, I4 = 16 * 192, I5 = 32 * 32, I6 = I2, I7 = I3;
        constexpr int NIT = I0 + I1 + I2 + I3 + I4 + I5 + I6 + I7;
        for (int it = gw; it < NIT; it += NGW) {
            int r = it; const float* W; bf16_t* WT; int K, N; int mode = 0;
            if (r < I0) { W = a.in[10]; WT = (bf16_t*)(ws + WS_WQKV0); K = 1024; N = 1536; mode = 3; }
            else if ((r -= I0) < I1) { W = a.in[14]; WT = (bf16_t*)(ws + WS_WO0); K = 1024; N = 1024; }
            else if ((r -= I1) < I2) { W = a.in[8]; WT = (bf16_t*)(ws + WS_WIN0); K = 1024; N = 5632; mode = 1; }
            else if ((r -= I2) < I3) { W = a.in[9]; WT = (bf16_t*)(ws + WS_WOUT0); K = 2816; N = 1024; }
            else if ((r -= I3) < I4) { W = a.in[15]; WT = (bf16_t*)(ws + WS_WR); K = 1024; N = 6144; mode = 2; }
            else if ((r -= I4) < I5) { W = a.in[18]; WT = (bf16_t*)(ws + WS_WRO); K = 2048; N = 1024; }
            else if ((r -= I5) < I6) { W = a.in[8] + (size_t)1024 * 5632; WT = (bf16_t*)(ws + WS_WIN1); K = 1024; N = 5632; mode = 1; }
            else { r -= I6; W = a.in[9] + (size_t)2816 * 1024; WT = (bf16_t*)(ws + WS_WOUT1); K = 2816; N = 1024; }
            const int nblk = N / 32, kb = r / nblk, nb = r % nblk, n0 = 32 * nb;
            transpose_item(W, K, N, WT, 64 * kb, n0, mode, scr, lane);
        }
    }
    { f32x4* gs = (f32x4*)(ws + WS_GNS); for (int i = blockIdx.x * 512 + tid; i < MX * 8 / 4; i += gridDim.x * 512) gs[i] = (f32x4){0.f, 0.f, 0.f, 0.f}; }
    {
        const int gt = blockIdx.x * 512 + tid;
        if (gt < 64 * 16 + 64 * 64) {
            int pos, f; float expo; float* dst;
            if (gt < 1024) { pos = gt >> 4; f = gt & 15; expo = -(float)(2 * f) / 32.0f; dst = (float*)(ws + WS_TAB0) + (size_t)gt * 2; }
            else { const int g2 = gt - 1024; pos = g2 >> 6; f = g2 & 63; expo = -(float)(2 * f) / 128.0f; dst = (float*)(ws + WS_TAB1) + (size_t)g2 * 2; }
            const float inv = exp2f(expo * 13.287712379549449f);
            const float ang = (float)pos * inv;
            const double ad = (double)ang; const double kk = __builtin_rint(ad * 0.15915494309189535); const float red = (float)(ad - kk * 6.283185307179586);
            dst[0] = __cosf(red); dst[1] = __sinf(red);
        }
    }
    __syncthreads();
    {
        LAS float* sc = (LAS float*)lds + wave * (128 * 36);
        LAS float* red = (LAS float*)lds;
        float* mod = (float*)(ws + WS_MOD);
        for (int it = blockIdx.x; it < 192; it += gridDim.x) {
            const int l = it / 96, n0 = (it % 96) * 64;
            int lane_l = lane; asm volatile("" : "+v"(lane_l));
#pragma unroll
            for (int t0 = 0; t0 < 66; t0 += 22) {
                float tv[22];
#pragma unroll
                for (int t = 0; t < 22; ++t) { const int r = (t0 + t) >> 1, k = lane_l + 64 * (t & 1); tv[t] = r < 32 ? a.in[1][r * 1024 + wave * 128 + k] : a.in[3][wave * 128 + k]; }
#pragma unroll
                for (int t = 0; t < 22; ++t) { const int r = (t0 + t) >> 1, k = lane_l + 64 * (t & 1); sc[k * 36 + r] = tv[t] * __builtin_amdgcn_rcpf(1.0f + __expf(-tv[t])); }
                asm volatile("" ::: "memory");
            }
            asm volatile("s_waitcnt lgkmcnt(0)" ::: "memory");
            float acc[33];
#pragma unroll
            for (int r = 0; r < 33; ++r) acc[r] = 0.f;
            const float* Wp = a.in[4] + ((size_t)l * 1024 + wave * 128) * 6144 + n0 + lane_l;
#pragma unroll 1
            for (int k0 = 0; k0 < 128; k0 += 16) {
                float wv[16];
#pragma unroll
                for (int kk = 0; kk < 16; ++kk) wv[kk] = Wp[(size_t)(k0 + kk) * 6144];
#pragma unroll
                for (int kk = 0; kk < 16; ++kk) { const int k = k0 + kk;
#pragma unroll
                    for (int r4 = 0; r4 < 8; ++r4) { const f32x4 s = *(const LAS f32x4*)(sc + k * 36 + 4 * r4); acc[4 * r4] += s[0] * wv[kk]; acc[4 * r4 + 1] += s[1] * wv[kk]; acc[4 * r4 + 2] += s[2] * wv[kk]; acc[4 * r4 + 3] += s[3] * wv[kk]; }
                    acc[32] += sc[k * 36 + 32] * wv[kk];
                    if ((kk & 1) == 1) asm volatile("" ::: "memory"); }
            }
            __syncthreads();
#pragma unroll
            for (int r = 0; r < 33; ++r) red[(wave * 33 + r) * 64 + lane] = acc[r];
            __syncthreads();
            for (int idx = tid; idx < 33 * 64; idx += 512) { const int r = idx >> 6, cc = idx & 63; float s = 0.f;
#pragma unroll
                for (int w = 0; w < 8; ++w) s += red[(w * 33 + r) * 64 + cc];
                mod[((size_t)l * 33 + r) * 6144 + n0 + cc] = s + a.in[5][l * 6144 + n0 + cc]; }
            __syncthreads();
        }
    }
}

template <bool SRC_BF16>
__device__ __forceinline__ void norm_phase(const float* src_lat, const float* src_ctx, const bf16_t* srcb, const float* g, const float* shift, const float* scale, int nrows, bf16_t* dst, int tid) {
    const int lane = tid & 63, gw = blockIdx.x * 8 + (tid >> 6), NGW = gridDim.x * 8;
    for (int row = gw; row < nrows; row += NGW) {
        const int r = row < MX ? row / SEQ : NB;
        f32x4 v[4]; float ss = 0.f;
        if (SRC_BF16) {
            const u32x4 w0 = *(const u32x4*)(srcb + (size_t)row * DM + 8 * lane), w1 = *(const u32x4*)(srcb + (size_t)row * DM + 512 + 8 * lane);
            v[0] = (f32x4){bf_lo(w0.x), bf_hi(w0.x), bf_lo(w0.y), bf_hi(w0.y)}; v[1] = (f32x4){bf_lo(w0.z), bf_hi(w0.z), bf_lo(w0.w), bf_hi(w0.w)};
            v[2] = (f32x4){bf_lo(w1.x), bf_hi(w1.x), bf_lo(w1.y), bf_hi(w1.y)}; v[3] = (f32x4){bf_lo(w1.z), bf_hi(w1.z), bf_lo(w1.w), bf_hi(w1.w)};
        } else {
            const float* src = row < MX ? src_lat + (size_t)row * DM : src_ctx + (size_t)(row - MX) * DM;
#pragma unroll
            for (int j = 0; j < 4; ++j) v[j] = ((const f32x4*)src)[lane + 64 * j];
        }
#pragma unroll
        for (int j = 0; j < 4; ++j) ss += (v[j].x * v[j].x + v[j].y * v[j].y) + (v[j].z * v[j].z + v[j].w * v[j].w);
        const float rstd = rsqrtf(wave_sum(ss) * (1.0f / DM) + EPSN);
#pragma unroll
        for (int j = 0; j < 4; ++j) { const int col = SRC_BF16 ? 8 * lane + 512 * (j >> 1) + 4 * (j & 1) : 4 * lane + 256 * j;
            const f32x4 gg = *(const f32x4*)(g + col), sh = *(const f32x4*)(shift + (size_t)r * 6144 + col), sc = *(const f32x4*)(scale + (size_t)r * 6144 + col);
            const f32x4 y = v[j] * rstd * gg; const f32x4 h = y * (sc + 1.0f) + sh;
            u32x2 w; w.x = pkbf(h.x, h.y); w.y = pkbf(h.z, h.w);
            *(u32x2*)(dst + (size_t)row * DM + col) = w; }
    }
}

__device__ __forceinline__ void qknorm_phase(bf16_t* QKV, const float* qg, const float* kg, const float* tab0, int tid) {
    const long total = (long)MA * 160, stride = (long)gridDim.x * 512;
    for (long idx = (long)blockIdx.x * 512 + tid; idx < total; idx += stride) {
        const int ch = (int)(idx & 7), hd = (int)((idx >> 3) % 20), row = (int)(idx / 160);
        bf16_t* p = QKV + (size_t)row * 1536 + hd * 64 + ch * 8;
        const u32x4 w = *(const u32x4*)p;
        float v[8] = {bf_lo(w.x), bf_hi(w.x), bf_lo(w.y), bf_hi(w.y), bf_lo(w.z), bf_hi(w.z), bf_lo(w.w), bf_hi(w.w)};
        float ss = 0.f;
#pragma unroll
        for (int j = 0; j < 8; ++j) ss += v[j] * v[j];
        ss += __shfl_xor(ss, 1); ss += __shfl_xor(ss, 2); ss += __shfl_xor(ss, 4);
        const float rstd = rsqrtf(ss * (1.0f / 64.0f) + EPSN);
        const float* gp = (hd < 16 ? qg : kg) + ch * 8;
#pragma unroll
        for (int j = 0; j < 8; ++j) v[j] = v[j] * rstd * gp[j];
        float pv[8];
#pragma unroll
        for (int j = 0; j < 8; ++j) pv[j] = __shfl_xor(v[j], 2);
        if (row < MX) {
            const int s = row & (SEQ - 1), pos = (ch & 4) ? (s & 63) : (s >> 6);
            const float* tp = tab0 + ((size_t)pos * 16 + (ch & 1) * 8) * 2;
#pragma unroll
            for (int j = 0; j < 8; ++j) { const float cs = tp[2 * j], sn = tp[2 * j + 1];
                v[j] = (ch & 2) ? (pv[j] * sn + v[j] * cs) : (v[j] * cs - pv[j] * sn); }
        }
        const float qs = hd < 16 ? 0.125f * LOG2E : 1.0f;
        u32x4 o; o.x = pkbf(v[0] * qs, v[1] * qs); o.y = pkbf(v[2] * qs, v[3] * qs); o.z = pkbf(v[4] * qs, v[5] * qs); o.w = pkbf(v[6] * qs, v[7] * qs);
        *(u32x4*)p = o;
    }
}

__device__ __forceinline__ void rope1_phase(bf16_t* Q1, bf16_t* K1, const float* tab1, int tid) {
    const long total = (long)MX * 128, stride = (long)gridDim.x * 512;
    for (long idx = (long)blockIdx.x * 512 + tid; idx < total; idx += stride) {
        const int c8 = (int)(idx & 7), ax = (int)((idx >> 3) & 1), hd = (int)((idx >> 4) & 3), which = (int)((idx >> 6) & 1), row = (int)(idx >> 7);
        bf16_t* p = (which ? K1 : Q1) + (size_t)row * 1024 + hd * 256 + ax * 128 + c8 * 8;
        const u32x4 w1 = *(const u32x4*)p, w2 = *(const u32x4*)(p + 64);
        const float x1[8] = {bf_lo(w1.x), bf_hi(w1.x), bf_lo(w1.y), bf_hi(w1.y), bf_lo(w1.z), bf_hi(w1.z), bf_lo(w1.w), bf_hi(w1.w)};
        const float x2[8] = {bf_lo(w2.x), bf_hi(w2.x), bf_lo(w2.y), bf_hi(w2.y), bf_lo(w2.z), bf_hi(w2.z), bf_lo(w2.w), bf_hi(w2.w)};
        const int s = row & (SEQ - 1), pos = ax ? (s & 63) : (s >> 6);
        const float* tp = tab1 + ((size_t)pos * 64 + c8 * 8) * 2;
        float o1[8], o2[8];
#pragma unroll
        for (int j = 0; j < 8; ++j) { const float cs = tp[2 * j], sn = tp[2 * j + 1]; o1[j] = x1[j] * cs - x2[j] * sn; o2[j] = x1[j] * sn + x2[j] * cs; }
        u32x4 a, b; a.x = pkbf(o1[0], o1[1]); a.y = pkbf(o1[2], o1[3]); a.z = pkbf(o1[4], o1[5]); a.w = pkbf(o1[6], o1[7]);
        b.x = pkbf(o2[0], o2[1]); b.y = pkbf(o2[2], o2[3]); b.z = pkbf(o2[4], o2[5]); b.w = pkbf(o2[6], o2[7]);
        *(u32x4*)p = a; *(u32x4*)(p + 64) = b;
    }
}

__device__ __forceinline__ void gn_phase(bf16_t* Y, const float* gng, int tid) {
    const int lane = tid & 63, gw = blockIdx.x * 8 + (tid >> 6), NGW = gridDim.x * 8;
    for (int it = gw; it < MX * 4; it += NGW) {
        const int row = it >> 2, h = it & 3;
        bf16_t* p = Y + (size_t)row * 2048 + h * 512 + lane * 8;
        const u32x4 w = *(const u32x4*)p;
        float v[8] = {bf_lo(w.x), bf_hi(w.x), bf_lo(w.y), bf_hi(w.y), bf_lo(w.z), bf_hi(w.z), bf_lo(w.w), bf_hi(w.w)};
        float s = 0.f;
#pragma unroll
        for (int j = 0; j < 8; ++j) s += v[j];
        const float mu = wave_sum(s) * (1.0f / 512.0f); float q = 0.f;
#pragma unroll
        for (int j = 0; j < 8; ++j) { v[j] -= mu; q += v[j] * v[j]; }
        const float rstd = rsqrtf(wave_sum(q) * (1.0f / 512.0f) + EPSN);
        const float* gp = gng + h * 512 + lane * 8;
        const f32x4 g0 = *(const f32x4*)gp, g1 = *(const f32x4*)(gp + 4);
        u32x4 o; o.x = pkbf(v[0] * rstd * g0.x, v[1] * rstd * g0.y); o.y = pkbf(v[2] * rstd * g0.z, v[3] * rstd * g0.w);
        o.z = pkbf(v[4] * rstd * g1.x, v[5] * rstd * g1.y); o.w = pkbf(v[6] * rstd * g1.z, v[7] * rstd * g1.w);
        *(u32x4*)p = o;
    }
}

__device__ __forceinline__ f32x16 mfma32(bf16x8 a, bf16x8 b, f32x16 c) { return __builtin_amdgcn_mfma_f32_32x32x16_bf16(a, b, c, 0, 0, 0); }
__device__ __forceinline__ bf16x8 tr_pair(const LAS bf16_t* p0, const LAS bf16_t* p1) {
    const s16x4 a = __builtin_amdgcn_ds_read_tr16_b64_v4i16((LAS s16x4*)p0);
    const s16x4 b = __builtin_amdgcn_ds_read_tr16_b64_v4i16((LAS s16x4*)p1);
    return __builtin_shufflevector(a, b, 0, 1, 2, 3, 4, 5, 6, 7);
}
__device__ __forceinline__ bf16x8 pack8(const f32x16& v, int base) {
    u32x4 w; w.x = pkbf(v[base + 0], v[base + 1]); w.y = pkbf(v[base + 2], v[base + 3]); w.z = pkbf(v[base + 4], v[base + 5]); w.w = pkbf(v[base + 6], v[base + 7]);
    return __builtin_bit_cast(bf16x8, w);
}

constexpr int AKS = 72;
__device__ __forceinline__ void attn_phase(LAS unsigned char* lds, const bf16_t* QKV, bf16_t* O, const float* sink, const float* qg, const float* kg, int tid) {
    const int wid = __builtin_amdgcn_readfirstlane(tid >> 6), lane = tid & 63, r = lane & 31, hh = lane >> 5, blk = (lane >> 4) & 1, q4 = (lane & 15) >> 2, p4 = lane & 3;
    LAS bf16_t* Kl = (LAS bf16_t*)lds;
    LAS bf16_t* Vl = (LAS bf16_t*)(lds + 64 * AKS * 2);
    const int skey = tid >> 3, sch = tid & 7;
    float Bnd;
    { float gq = fabsf(qg[lane]), gk = fabsf(kg[lane]);
#pragma unroll
      for (int o = 1; o < 64; o <<= 1) { gq = fmaxf(gq, __shfl_xor(gq, o)); gk = fmaxf(gk, __shfl_xor(gk, o)); }
      Bnd = 8.0f * LOG2E * 1.02f * gq * gk; }
    for (int u0 = blockIdx.x; u0 < 2304; u0 += gridDim.x) {
        int u = u0;
        if (gridDim.x == 256 && u0 < 2048) { const int x = u0 & 7, idx = (u0 >> 3) & 31, rnd = u0 >> 8; u = ((rnd * 16 + x * 2 + (idx >> 4)) << 4) | (idx & 15); }
        int b, kvh, qb; bool isctx;
        if (u < 2048) { b = u >> 6; kvh = (u >> 4) & 3; qb = u & 15; isctx = false; } else { const int v = u - 2048; b = v >> 3; kvh = (v >> 1) & 3; qb = v & 1; isctx = true; }
        const int hq = kvh * 4 + (wid >> 1);
        const int qloc = qb * 128 + (wid & 1) * 64;
        const size_t qrow0 = isctx ? (size_t)MX + b * CL + qloc : (size_t)b * SEQ + qloc;
        bf16x8 qf[2][4];
#pragma unroll
        for (int qq = 0; qq < 2; ++qq)
#pragma unroll
            for (int s = 0; s < 4; ++s) qf[qq][s] = *(const bf16x8*)(QKV + (qrow0 + 32 * qq + r) * 1536 + (hq >> 2) * 256 + (s >> 1) * 128 + (hq & 3) * 32 + (s & 1) * 16 + 8 * hh);
        const float sl2 = sink[hq] * LOG2E;
        const float psink = hh == 0 ? __builtin_amdgcn_exp2f(sl2 - Bnd) : 0.0f;
        float lrun[2] = {psink, psink};
        f32x16 oacc[2][2];
#pragma unroll
        for (int i = 0; i < 2; ++i)
#pragma unroll
            for (int j = 0; j < 2; ++j)
#pragma unroll
                for (int e = 0; e < 16; ++e) oacc[i][j][e] = 0.f;
        int tlo = 2 - 2 * qb; if (tlo < 0) tlo = 0;
        int thi = 33 - 2 * qb; if (thi > 5) thi = 5;
        const int ntile = isctx ? 4 : 4 + (thi - tlo + 1);
        u32x4 kreg, vreg;
        {   const size_t row = (size_t)MX + b * CL + skey;
            kreg = *(const u32x4*)(QKV + row * 1536 + 1024 + (sch >> 2) * 128 + kvh * 32 + (sch & 3) * 8); vreg = *(const u32x4*)(QKV + row * 1536 + 1280 + kvh * 64 + sch * 8); }
        for (int it = 0; it < ntile; ++it) {
            __syncthreads();
            *(LAS u32x4*)(Kl + skey * AKS + sch * 8) = kreg; *(LAS u32x4*)(Vl + skey * AKS + sch * 8) = vreg;
            __syncthreads();
            if (it + 1 < ntile) { const int nt = it + 1;
                const size_t row = nt < 4 ? (size_t)MX + b * CL + 64 * nt + skey : (size_t)b * SEQ + qb * 128 - 128 + 64 * (tlo + nt - 4) + skey;
                kreg = *(const u32x4*)(QKV + row * 1536 + 1024 + (sch >> 2) * 128 + kvh * 32 + (sch & 3) * 8); vreg = *(const u32x4*)(QKV + row * 1536 + 1280 + kvh * 64 + sch * 8); }
            const int rel = it >= 4 ? (qb * 128 - 128 + 64 * (tlo + it - 4)) - qloc : 0;
            if (rel <= -192 || rel >= 192) continue;
            float nbnd = -Bnd; asm volatile("" : "+v"(nbnd));
            f32x16 st[2][2];
#pragma unroll
            for (int i = 0; i < 2; ++i)
#pragma unroll
                for (int j = 0; j < 2; ++j)
#pragma unroll
                    for (int e = 0; e < 16; ++e) st[i][j][e] = nbnd;
#pragma unroll
            for (int kb = 0; kb < 2; ++kb)
#pragma unroll
                for (int s = 0; s < 4; ++s) { const bf16x8 ka = *(const LAS bf16x8*)(Kl + (32 * kb + r) * AKS + 16 * s + 8 * hh);
                    st[kb][0] = mfma32(ka, qf[0][s], st[kb][0]); st[kb][1] = mfma32(ka, qf[1][s], st[kb][1]); }
            if (rel == -128 || rel == 128) {
                const int kbase = qb * 128 - 128 + 64 * (tlo + it - 4);
#pragma unroll
                for (int kb = 0; kb < 2; ++kb)
#pragma unroll
                    for (int qq = 0; qq < 2; ++qq) { const int qpos = qloc + 32 * qq + r;
#pragma unroll
                        for (int e = 0; e < 16; ++e) { const int key = kbase + 32 * kb + 8 * (e >> 2) + 4 * hh + (e & 3); int d = qpos - key; d = d < 0 ? -d : d;
                            st[kb][qq][e] = d <= 128 ? st[kb][qq][e] : -1e30f; } }
            }
            bf16x8 pf[2][2][2];
#pragma unroll
            for (int qq = 0; qq < 2; ++qq) {
                float ps = 0.f;
#pragma unroll
                for (int kb = 0; kb < 2; ++kb)
#pragma unroll
                    for (int s2 = 0; s2 < 2; ++s2) { float p[8];
#pragma unroll
                        for (int j = 0; j < 8; ++j) { p[j] = __builtin_amdgcn_exp2f(st[kb][qq][8 * s2 + j]); ps += p[j]; }
                        u32x4 w; w.x = pkbf(p[0], p[1]); w.y = pkbf(p[2], p[3]); w.z = pkbf(p[4], p[5]); w.w = pkbf(p[6], p[7]);
                        pf[kb][s2][qq] = __builtin_bit_cast(bf16x8, w); }
                lrun[qq] += ps;
            }
            __builtin_amdgcn_sched_barrier(0);
#pragma unroll
            for (int kb = 0; kb < 2; ++kb)
#pragma unroll
                for (int s2 = 0; s2 < 2; ++s2)
#pragma unroll
                    for (int db = 0; db < 2; ++db) {
                        const LAS bf16_t* vp = Vl + (32 * kb + 16 * s2 + 4 * hh + q4) * AKS + 32 * db + 16 * blk + 4 * p4;
                        const bf16x8 va = tr_pair(vp, vp + 8 * AKS);
                        oacc[db][0] = mfma32(va, pf[kb][s2][0], oacc[db][0]); oacc[db][1] = mfma32(va, pf[kb][s2][1], oacc[db][1]); }
        }
#pragma unroll
        for (int qq = 0; qq < 2; ++qq) {
            const float lt = lrun[qq] + __shfl_xor(lrun[qq], 32), inv = 1.0f / lt;
            bf16_t* op = O + (qrow0 + 32 * qq + r) * 1024 + hq * 64 + 4 * hh;
#pragma unroll
            for (int db = 0; db < 2; ++db)
#pragma unroll
                for (int g = 0; g < 4; ++g) { u32x2 w; w.x = pkbf(oacc[db][qq][4 * g] * inv, oacc[db][qq][4 * g + 1] * inv); w.y = pkbf(oacc[db][qq][4 * g + 2] * inv, oacc[db][qq][4 * g + 3] * inv);
                    *(u32x2*)(op + 32 * db + 8 * g) = w; }
        }
    }
}

constexpr int RS = 136;
__device__ __forceinline__ u32x4 scale8(const u32x4 w, const float f) {
    u32x4 o; o.x = pkbf(bf_lo(w.x) * f, bf_hi(w.x) * f); o.y = pkbf(bf_lo(w.y) * f, bf_hi(w.y) * f); o.z = pkbf(bf_lo(w.z) * f, bf_hi(w.z) * f); o.w = pkbf(bf_lo(w.w) * f, bf_hi(w.w) * f); return o;
}
__device__ __forceinline__ u32x4 add8(const u32x4 a, const u32x4 b) {
    u32x4 o; o.x = pkbf(bf_lo(a.x) + bf_lo(b.x), bf_hi(a.x) + bf_hi(b.x)); o.y = pkbf(bf_lo(a.y) + bf_lo(b.y), bf_hi(a.y) + bf_hi(b.y));
    o.z = pkbf(bf_lo(a.z) + bf_lo(b.z), bf_hi(a.z) + bf_hi(b.z)); o.w = pkbf(bf_lo(a.w) + bf_lo(b.w), bf_hi(a.w) + bf_hi(b.w)); return o;
}
template <int PM> __device__ __forceinline__ f32x16 rmf(bf16x8 a, bf16x8 b, f32x16 c) {
    if (PM == 1) { const u32x4 x = __builtin_bit_cast(u32x4, a), y = __builtin_bit_cast(u32x4, b); c[0] += __builtin_bit_cast(float, (x.x ^ y.x) & 0x3f800000u) + __builtin_bit_cast(float, (x.w ^ y.w) & 0x3f800000u); return c; }
    if (PM == 2) { const bf16x8 k = {0x3c00, 0x3c00, 0x3c00, 0x3c00, 0x3c00, 0x3c00, 0x3c00, 0x3c00}; return __builtin_amdgcn_mfma_f32_32x32x16_bf16(k, k, c, 0, 0, 0); }
    return __builtin_amdgcn_mfma_f32_32x32x16_bf16(a, b, c, 0, 0, 0);
}
template <int PM>
__device__ __forceinline__ void ret_phase(LAS unsigned char* lds, const bf16_t* Q1, const bf16_t* K1, bf16_t* V1, bf16_t* OF, float* gstats, unsigned* gsync, const float* decay_logit, int tid) {
    const int wid = tid >> 6, lane = tid & 63, r = lane & 31, hh = lane >> 5, blk = (lane >> 4) & 1, q4 = (lane & 15) >> 2, p4 = lane & 3;
    LAS bf16_t* QH = (LAS bf16_t*)lds;
    LAS bf16_t* KH = (LAS bf16_t*)(lds + 128 * RS * 2);
    LAS bf16_t* VL = (LAS bf16_t*)(lds + 2 * 128 * RS * 2);
    LAS bf16_t* SL = (LAS bf16_t*)(lds + 3 * 128 * RS * 2);
    LAS bf16_t* OL = KH;
    const int eb = wid & 3, dg = wid >> 2, nb = wid >> 1, mg = wid & 1;
    const int o_row = r * RS + 8 * hh;
    const int o_tr = (8 * hh + q4) * RS + 16 * blk + 4 * p4;
    const int sn = tid >> 4, scc = tid & 15;
    unsigned* gctr = (gsync != nullptr && gridDim.x == 256) ? gsync + ((blockIdx.x & 7) * 8 + ((blockIdx.x >> 5) & 7)) * 64 : nullptr;
    unsigned gtarget = 0u;
    for (int u0 = blockIdx.x; u0 < 512; u0 += gridDim.x) {
        int u = u0;
        if (gridDim.x == 256) { const int x = u0 & 7, idx = (u0 >> 3) & 31, rnd = u0 >> 8; u = ((rnd * 64 + x * 8 + (idx >> 2)) << 2) | (idx & 3); }
        const int b = u >> 4, h = (u >> 2) & 3, sl = u & 3;
        for (int dir = 0; dir < 2; ++dir) {
            const float logit = decay_logit[dir * 4 + h];
            const float lg2 = -log1pf(__expf(-logit)) * LOG2E;
            const float cd = exp2f(lg2 * 128.0f);
            f32x16 S[2][2];
#pragma unroll
            for (int i = 0; i < 2; ++i)
#pragma unroll
                for (int j = 0; j < 2; ++j)
#pragma unroll
                    for (int e = 0; e < 16; ++e) S[i][j][e] = 0.f;
            u32x4 rq[4], rk[4], rv[4];
#define RET_ROFF(i) (dir ? 127 - (sn + 32 * (i)) : (sn + 32 * (i)))
#define RET_ROFF2(i) (dir ? 127 - (sn2_ + 32 * (i)) : (sn2_ + 32 * (i)))
#define RET_TOK(base, i) ((base) + (size_t)RET_ROFF(i))
#define RET_LOAD_QK(stp, dhp) do { const bool cx_ = (stp) < 2; const int ci_ = cx_ ? (dir ? 1 - (stp) : (stp)) : (dir ? 17 - (stp) : (stp) - 2); \
        const size_t rb_ = cx_ ? (size_t)MX + b * CL + ci_ * 128 : (size_t)b * SEQ + ci_ * 128; \
        const bf16_t* qp_ = Q1 + rb_ * 1024 + h * 256 + (dhp) * 128; const bf16_t* kp_ = K1 + rb_ * 1024 + h * 256 + (dhp) * 128; \
        int sn2_ = sn; asm volatile("" : "+v"(sn2_)); \
        _Pragma("unroll") for (int i_ = 0; i_ < 4; ++i_) { const int o_ = RET_ROFF2(i_) * 1024 + scc * 8; \
            if (PM == 3) { rq[i_] = (u32x4){0x3c003c00u, 0x3c003c00u, 0x3c003c00u, 0x3c003c00u}; rk[i_] = rq[i_]; } else { \
            if (!cx_) rq[i_] = *(const u32x4*)(qp_ + o_); \
            rk[i_] = *(const u32x4*)(kp_ + o_); } } } while (0)
#define RET_LOAD_V(stp) do { const bool cx_ = (stp) < 2; const int ci_ = cx_ ? (dir ? 1 - (stp) : (stp)) : (dir ? 17 - (stp) : (stp) - 2); \
        const size_t rb_ = cx_ ? (size_t)MX + b * CL + ci_ * 128 : (size_t)b * SEQ + ci_ * 128; \
        const bf16_t* vp_ = V1 + rb_ * 2048 + h * 512 + sl * 128; \
        int sn2_ = sn; asm volatile("" : "+v"(sn2_)); \
        _Pragma("unroll") for (int i_ = 0; i_ < 4; ++i_) { const int o_ = RET_ROFF2(i_) * 2048 + scc * 8; if (PM == 3) rv[i_] = (u32x4){0x3c003c00u, 0x3c003c00u, 0x3c003c00u, 0x3c003c00u}; else rv[i_] = *(const u32x4*)(vp_ + o_); } } while (0)
            RET_LOAD_QK(0, 0); RET_LOAD_V(0);
            for (int st = 0; st < 18; ++st) {
                const bool isctx = st < 2;
                const int cidx = isctx ? (dir ? 1 - st : st) : (dir ? 17 - st : st - 2);
                gtarget += 4u;
                if (gctr != nullptr && tid == 0) { __hip_atomic_fetch_add(gctr, 1u, __ATOMIC_RELAXED, __HIP_MEMORY_SCOPE_AGENT);
                    for (int sp = 0; sp < 48 && __hip_atomic_load(gctr, __ATOMIC_RELAXED, __HIP_MEMORY_SCOPE_AGENT) < gtarget; ++sp) __builtin_amdgcn_s_sleep(2); }
                int r_l = r, hh_l = hh, sn_l = sn; float lg2_l = lg2; asm volatile("" : "+v"(r_l), "+v"(hh_l), "+v"(sn_l), "+v"(lg2_l));
                f32x16 sc[2], out[2];
#pragma unroll
                for (int i = 0; i < 2; ++i)
#pragma unroll
                    for (int e = 0; e < 16; ++e) { sc[i][e] = 0.f; out[i][e] = 0.f; }
#pragma unroll
                for (int dh = 0; dh < 2; ++dh) {
                    if (PM != 4) __syncthreads();
#pragma unroll
                    for (int i = 0; i < 4; ++i) { const int n = sn_l + 32 * i;
                        if (!isctx) *(LAS u32x4*)(QH + n * RS + scc * 8) = rq[i];
                        *(LAS u32x4*)(KH + n * RS + scc * 8) = rk[i];
                        if (dh == 0) *(LAS u32x4*)(VL + n * RS + scc * 8) = scale8(rv[i], 0.0625f * __builtin_amdgcn_exp2f(-lg2_l * (float)(n + 1))); }
                    if (!isctx) {
#pragma unroll
                        for (int i = 0; i < 2; ++i)
#pragma unroll
                            for (int g = 0; g < 4; ++g) { u32x2 w; w.x = pkbf(S[dh][i][4 * g], S[dh][i][4 * g + 1]); w.y = pkbf(S[dh][i][4 * g + 2], S[dh][i][4 * g + 3]);
                                *(LAS u32x2*)(SL + (32 * eb + r) * RS + 32 * (2 * dg + i) + 8 * g + 4 * hh) = w; }
                    }
                    if (PM != 4) __syncthreads();
                    if (dh == 0) RET_LOAD_QK(st, 1); else if (st + 1 < 18) RET_LOAD_QK(st + 1, 0);
                    if (!isctx) {
                        if (2 * mg <= nb) {
                            const bool two = 2 * mg + 1 <= nb;
#pragma unroll 2
                            for (int s = 0; s < 8; ++s) {
                                const bf16x8 qb_ = *(const LAS bf16x8*)(QH + o_row + 32 * nb * RS + 16 * s);
                                const bf16x8 k0 = *(const LAS bf16x8*)(KH + o_row + 32 * (2 * mg) * RS + 16 * s);
                                sc[0] = rmf<PM>(k0, qb_, sc[0]);
                                if (two) { const bf16x8 k1 = *(const LAS bf16x8*)(KH + o_row + 32 * (2 * mg + 1) * RS + 16 * s); sc[1] = rmf<PM>(k1, qb_, sc[1]); } }
                        }
#pragma unroll 2
                        for (int s = 0; s < 8; ++s) {
                            const bf16x8 sb = *(const LAS bf16x8*)(SL + o_row + 32 * eb * RS + 16 * s);
                            const bf16x8 q0 = *(const LAS bf16x8*)(QH + o_row + 32 * (2 * dg) * RS + 16 * s), q1 = *(const LAS bf16x8*)(QH + o_row + 32 * (2 * dg + 1) * RS + 16 * s);
                            out[0] = rmf<PM>(sb, q0, out[0]); out[1] = rmf<PM>(sb, q1, out[1]); }
                    }
#pragma unroll 2
                    for (int s = 0; s < 8; ++s) {
                        const LAS bf16_t* vp = VL + o_tr + 16 * s * RS + 32 * eb;
                        const bf16x8 vb = tr_pair(vp, vp + 4 * RS);
                        const LAS bf16_t* kp = KH + o_tr + 16 * s * RS + 32 * (2 * dg);
                        const bf16x8 ka0 = tr_pair(kp, kp + 4 * RS), ka1 = tr_pair(kp + 32, kp + 32 + 4 * RS);
                        S[dh][0] = rmf<PM>(ka0, vb, S[dh][0]); S[dh][1] = rmf<PM>(ka1, vb, S[dh][1]); }
                }
                if (!isctx) {
                    if (PM != 4) __syncthreads();
#pragma unroll
                    for (int i = 0; i < 2; ++i) { const bool diag = (2 * mg + i) == nb;
#pragma unroll
                        for (int g = 0; g < 4; ++g) { const int n = 32 * nb + r_l, m0 = 32 * (2 * mg + i) + 8 * g + 4 * hh_l;
                            float v0 = sc[i][4 * g], v1 = sc[i][4 * g + 1], v2 = sc[i][4 * g + 2], v3 = sc[i][4 * g + 3];
                            if (diag) { v0 = n >= m0 ? v0 : 0.f; v1 = n >= m0 + 1 ? v1 : 0.f; v2 = n >= m0 + 2 ? v2 : 0.f; v3 = n >= m0 + 3 ? v3 : 0.f; }
                            u32x2 w; w.x = pkbf(v0, v1); w.y = pkbf(v2, v3); *(LAS u32x2*)(QH + n * RS + m0) = w; } }
                    if (PM != 4) __syncthreads();
                }
                if (isctx) RET_LOAD_V(st + 1);
                if (!isctx) {
#pragma unroll 2
                    for (int s = 0; s < 4 * dg + 2; ++s) {
                        const LAS bf16_t* vp = VL + o_tr + 16 * s * RS + 32 * eb;
                        const bf16x8 vb = tr_pair(vp, vp + 4 * RS);
                        const bf16x8 p0 = *(const LAS bf16x8*)(QH + o_row + 32 * (2 * dg) * RS + 16 * s), p1 = *(const LAS bf16x8*)(QH + o_row + 32 * (2 * dg + 1) * RS + 16 * s);
                        out[0] = rmf<PM>(vb, p0, out[0]); out[1] = rmf<PM>(vb, p1, out[1]); }
#pragma unroll 2
                    for (int s = 4 * dg + 2; s < 4 * dg + 4; ++s) {
                        const LAS bf16_t* vp = VL + o_tr + 16 * s * RS + 32 * eb;
                        const bf16x8 vb = tr_pair(vp, vp + 4 * RS);
                        const bf16x8 p1 = *(const LAS bf16x8*)(QH + o_row + 32 * (2 * dg + 1) * RS + 16 * s);
                        out[1] = rmf<PM>(vb, p1, out[1]); }
#pragma unroll
                    for (int i = 0; i < 2; ++i) { const int n = 32 * (2 * dg + i) + r_l; const float f = __builtin_amdgcn_exp2f(lg2_l * (float)(n + 1));
#pragma unroll
                        for (int g = 0; g < 4; ++g) { u32x2 w; w.x = pkbf(out[i][4 * g] * f, out[i][4 * g + 1] * f); w.y = pkbf(out[i][4 * g + 2] * f, out[i][4 * g + 3] * f);
                            *(LAS u32x2*)(OL + n * RS + 32 * eb + 8 * g + 4 * hh_l) = w; } }
                    if (st + 1 < 18) RET_LOAD_V(st + 1);
                    if (PM != 4) __syncthreads();
                    const size_t lb = ((size_t)b * SEQ + cidx * 128) * 2048 + h * 512 + sl * 128;
                    bf16_t* ofb = OF + lb; bf16_t* vob = V1 + lb;
#pragma unroll
                    for (int i = 0; i < 4; ++i) { const int n = sn_l + 32 * i; const int off = (dir ? 127 - n : n) * 2048 + scc * 8;
                        const u32x4 v = *(const LAS u32x4*)(OL + n * RS + scc * 8);
                        if (dir == 0) *(u32x4*)(ofb + off) = v;
                        else { const u32x4 o = *(const u32x4*)(ofb + off);
                            const float t0 = bf_lo(v.x) + bf_lo(o.x), t1 = bf_hi(v.x) + bf_hi(o.x), t2 = bf_lo(v.y) + bf_lo(o.y), t3 = bf_hi(v.y) + bf_hi(o.y), t4 = bf_lo(v.z) + bf_lo(o.z), t5 = bf_hi(v.z) + bf_hi(o.z), t6 = bf_lo(v.w) + bf_lo(o.w), t7 = bf_hi(v.w) + bf_hi(o.w);
                            u32x4 w; w.x = pkbf(t0, t1); w.y = pkbf(t2, t3); w.z = pkbf(t4, t5); w.w = pkbf(t6, t7); *(u32x4*)(vob + off) = w;
                            float s0 = ((t0 + t1) + (t2 + t3)) + ((t4 + t5) + (t6 + t7)), s1 = ((t0 * t0 + t1 * t1) + (t2 * t2 + t3 * t3)) + ((t4 * t4 + t5 * t5) + (t6 * t6 + t7 * t7));
#pragma unroll
                            for (int o2 = 1; o2 < 16; o2 <<= 1) { s0 += __shfl_xor(s0, o2); s1 += __shfl_xor(s1, o2); }
                            if (scc == 0) { const int ro_ = dir ? 127 - (sn_l + 32 * i) : (sn_l + 32 * i); float* gp = gstats + ((size_t)b * SEQ + cidx * 128) * 8 + h * 2 + ro_ * 8; atomicAdd(gp, s0); atomicAdd(gp + 1, s1); } }
                        asm volatile("" ::: "memory"); }
                }
#pragma unroll
                for (int i = 0; i < 2; ++i)
#pragma unroll
                    for (int j = 0; j < 2; ++j)
#pragma unroll
                        for (int e = 0; e < 16; ++e) S[i][j][e] *= cd;
            }
#undef RET_TOK
#undef RET_ROFF
#undef RET_ROFF2
#undef RET_LOAD_QK
#undef RET_LOAD_V
        }
    }
}

#define XB_TMO      128
#define XB_XCNT(j)  (256  + 64 * (j))
#define XB_XSUB(j)  (1280 + 64 * (j))
#define XB_XGEN(j)  (2304 + 64 * (j))
#define XB_TOP      3328
#define XB_TOPGEN   3392
#define XCD_BAR_WORDS 3456
#define XB_SPIN_CAP (1u << 18)

__device__ __forceinline__ unsigned xb_ld(unsigned* p)              { return __hip_atomic_load(p, __ATOMIC_RELAXED, __HIP_MEMORY_SCOPE_AGENT); }
__device__ __forceinline__ unsigned xb_add(unsigned* p, unsigned v) { return __hip_atomic_fetch_add(p, v, __ATOMIC_RELAXED, __HIP_MEMORY_SCOPE_AGENT); }
__device__ __forceinline__ unsigned xb_xcc_id() { return (unsigned)__builtin_amdgcn_s_getreg((3 << 11) | 20) & 0xFu; }
#define XB_SPIN(cond, bar) do { unsigned _sp = 0; while (cond) { __builtin_amdgcn_s_sleep(1); \
    if ((++_sp & 255u) == 0u) { if (xb_ld(&(bar)[XB_TMO])) break; if (_sp > XB_SPIN_CAP) { atomicAdd(&(bar)[XB_TMO], 1u); break; } } } } while (0)

struct XcdBarrier {
    unsigned* bar; unsigned x;
    volatile LAS unsigned* st;
};

__device__ __forceinline__ XcdBarrier xcd_barrier_post(unsigned* bar, volatile LAS unsigned* st) {
    XcdBarrier b; b.bar = bar; b.x = xb_xcc_id(); b.st = st;
    if (threadIdx.x == 0) (void)xb_add(&bar[XB_XCNT(b.x)], 1u);
    return b;
}
__device__ __forceinline__ void xcd_barrier_complete(unsigned* bar, unsigned x, unsigned& nloc, unsigned& nx) {
    const unsigned G = gridDim.x * gridDim.y * gridDim.z;
    unsigned sum, cnt, mine, sp = 0u;
    for (;;) {
        sum = 0u; cnt = 0u; mine = 0u;
#pragma unroll
        for (unsigned j = 0; j < 16; ++j) { const unsigned c = xb_ld(&bar[XB_XCNT(j)]); sum += c; cnt += (c > 0u) ? 1u : 0u; mine = (j == x) ? c : mine; }
        if (sum == G) break;
        __builtin_amdgcn_s_sleep(1);
        if ((++sp & 255u) == 0u) { if (xb_ld(&bar[XB_TMO])) break; if (sp > XB_SPIN_CAP) { atomicAdd(&bar[XB_TMO], 1u); break; } }
    }
    nloc = mine > 0u ? mine : 1u; nx = cnt > 0u ? cnt : 1u;
}

__device__ __forceinline__ void xcd_barrier(const XcdBarrier& b) {
    asm volatile("s_waitcnt vmcnt(0)" ::: "memory");
    __syncthreads();
    if (threadIdx.x == 0) {
        unsigned* bar = b.bar;
        __builtin_amdgcn_s_waitcnt(0);
        unsigned nloc = b.st[0], nx = b.st[1];
        if (nloc == 0u) { xcd_barrier_complete(bar, b.x, nloc, nx); b.st[0] = nloc; b.st[1] = nx; }
        const unsigned old = xb_add(&bar[XB_XSUB(b.x)], 1u);
        const unsigned gen = old / nloc;
        if (old + 1u == (gen + 1u) * nloc) {
            __builtin_amdgcn_fence(__ATOMIC_RELEASE, "agent");
            asm volatile("s_waitcnt vmcnt(0)" ::: "memory");
            const unsigned og = xb_add(&bar[XB_TOP], 1u);
            const unsigned tg = og / nx;
            if (og + 1u == (tg + 1u) * nx) xb_add(&bar[XB_TOPGEN], 1u);
            else XB_SPIN(xb_ld(&bar[XB_TOPGEN]) == tg, bar);
            __builtin_amdgcn_fence(__ATOMIC_ACQUIRE, "agent");
            xb_add(&bar[XB_XGEN(b.x)], 1u);
            asm volatile("s_waitcnt vmcnt(0)" ::: "memory");
        } else {
            XB_SPIN(xb_ld(&bar[XB_XGEN(b.x)]) == gen, bar);
            __builtin_amdgcn_fence(__ATOMIC_ACQUIRE, "agent");
            asm volatile("s_waitcnt vmcnt(0)" ::: "memory");
        }
    }
    __syncthreads();
}

__global__ void __launch_bounds__(512, 2) mega_fwd(Args a) {
    extern __shared__ __attribute__((aligned(16))) unsigned char lds_raw[];
    LAS unsigned char* lds = (LAS unsigned char*)lds_raw;
    cg::grid_group grid = cg::this_grid();
    volatile LAS unsigned* xb_st = (volatile LAS unsigned*)(lds + XB_LDS_OFF);
    if (threadIdx.x < 4) xb_st[threadIdx.x] = 0u;
    __syncthreads();
    const XcdBarrier xbar = xcd_barrier_post((unsigned*)(a.ws + WS_BAR), xb_st);
    unsigned char* const ws = a.ws;
    const int lo = a.ph_lo, hi = a.ph_hi;
#ifndef NO_RET
#define NO_RET 0
#endif
#ifndef NO_ATTN
#define NO_ATTN 0
#endif
#ifndef NO_GEMM
#define NO_GEMM 0
#endif
#define IN(k) (lo <= (k) && (k) < hi)
#define TID ({ int t_ = threadIdx.x; asm volatile("" : "+v"(t_)); t_; })
#define SYNC(k) do { if (lo <= (k) && (k) + 1 < hi) { if ((k) == 0) grid.sync(); else xcd_barrier(xbar); } } while (0)
#define MODP ((float*)(ws + WS_MOD))
#define BF(off) ((bf16_t*)(ws + (off)))
#define GEMM(EpiT, Aoff, Boff, M_, N_, K_, E) do { const pg8::Gemm g_{BF(Aoff), BF(Boff), (M_), (N_), (K_)}; pg8::StaticOrder S_; S_.init((M_), (N_), (int)gridDim.x, (int)blockIdx.x); \
        if (!NO_GEMM) pg8::gemm_phase<EpiT, pg8::StaticOrder, PG8_ALIGN, PG8_SP2>(lds, g_, S_, E); } while (0)
    if (IN(0)) { phase0(a, lds, TID); } SYNC(0);
    if (IN(1)) { norm_phase<false>(a.in[0], a.in[2], nullptr, a.in[6], MODP, MODP + 1024, MA, BF(WS_H), TID); } SYNC(1);
    if (IN(2)) { const EpiQKV0 e{BF(WS_QKV0), a.in[11], a.in[12], (const float*)(ws + WS_TAB0)}; GEMM(EpiQKV0, WS_H, WS_WQKV0, MA, 1536, 1024, e); } SYNC(2);
    if (IN(3) && !NO_ATTN) { attn_phase(lds, BF(WS_QKV0), BF(WS_H), a.in[13], a.in[11], a.in[12], TID); } SYNC(3);
    if (IN(4)) { const EpiResid<0> e{a.in[0], a.in[2], BF(WS_X), nullptr, MODP + 2048}; GEMM(EpiResid<0>, WS_H, WS_WO0, MA, 1024, 1024, e); } SYNC(4);
    if (IN(5)) { norm_phase<true>(nullptr, nullptr, BF(WS_X), a.in[7], MODP + 3072, MODP + 4096, MA, BF(WS_H), TID); } SYNC(5);
    if (IN(6)) { const EpiSwiglu e{BF(WS_ACT0)}; GEMM(EpiSwiglu, WS_H, WS_WIN0, MA, 5632, 1024, e); } SYNC(6);
    if (IN(7)) { const EpiResid<1> e{nullptr, nullptr, BF(WS_X), nullptr, MODP + 5120}; GEMM(EpiResid<1>, WS_ACT0, WS_WOUT0, MA, 1024, 2816, e); } SYNC(7);
    if (IN(8)) { norm_phase<true>(nullptr, nullptr, BF(WS_X), a.in[6] + 1024, MODP + 33 * 6144, MODP + 33 * 6144 + 1024, MA, BF(WS_HL1), TID); } SYNC(8);
    if (IN(9)) { const EpiQKV1 e{BF(WS_Q1), BF(WS_K1), BF(WS_V1), (const float*)(ws + WS_TAB1)}; GEMM(EpiQKV1, WS_HL1, WS_WR, MA, 4096, 1024, e); } SYNC(9);
    if (IN(10) && !NO_RET) { ret_phase<0>(lds, BF(WS_Q1), BF(WS_K1), BF(WS_V1), (bf16_t*)a.out, (float*)(ws + WS_GNS), nullptr, a.in[16], TID); } SYNC(10);
    if (IN(11)) { const EpiGate e{BF(WS_V1), (const float*)(ws + WS_GNS), a.in[17]}; GEMM(EpiGate, WS_HL1, WS_WR + (size_t)4096 * 1024 * 2, MX, 2048, 1024, e); } SYNC(11);
    if (IN(12)) { const EpiResid<1> e{nullptr, nullptr, BF(WS_X), nullptr, MODP + 33 * 6144 + 2048}; GEMM(EpiResid<1>, WS_V1, WS_WRO, MX, 1024, 2048, e); } SYNC(12);
    if (IN(13)) { norm_phase<true>(nullptr, nullptr, BF(WS_X), a.in[7] + 1024, MODP + 33 * 6144 + 3072, MODP + 33 * 6144 + 4096, MX, BF(WS_Q1), TID); } SYNC(13);
    if (IN(14)) { const EpiSwiglu e{BF(WS_ACT1)}; GEMM(EpiSwiglu, WS_Q1, WS_WIN1, MX, 5632, 1024, e); } SYNC(14);
    if (IN(15)) { const EpiResid<2> e{nullptr, nullptr, BF(WS_X), a.out, MODP + 33 * 6144 + 5120}; GEMM(EpiResid<2>, WS_ACT1, WS_WOUT1, MX, 1024, 2816, e); }
#ifdef PROBE_UP1
    grid.sync();
    { const EpiSwiglu e{BF(WS_ACT1)}; GEMM(EpiSwiglu, WS_Q1, WS_WIN1, MX, 5632, 1024, e); }
#endif
#ifdef PROBE_RET
    grid.sync();
    ret_phase<PROBE_RET - 1>(lds, BF(WS_Q1), BF(WS_K1), BF(WS_V1), BF(WS_V1), (float*)(ws + WS_GNS), nullptr, a.in[16], TID);
#endif
#ifdef PROBE_SYNC
    for (int i = 0; i < 20; ++i) grid.sync();
#endif
#ifdef PROBE_RESID
    grid.sync();
    { const EpiResid<1> e{nullptr, nullptr, BF(WS_HL1), nullptr, MODP + 33 * 6144 + 2048}; GEMM(EpiResid<1>, WS_V1, WS_WRO, MX, 1024, 2048, e); }
    grid.sync();
    { const EpiResid<1> e{nullptr, nullptr, BF(WS_HL1), nullptr, MODP + 33 * 6144 + 5120}; GEMM(EpiResid<1>, WS_ACT1, WS_WOUT1, MX, 1024, 2816, e); }
#endif
#ifdef PROBE_NORM
    grid.sync();
    norm_phase<true>(nullptr, nullptr, BF(WS_X), a.in[7] + 1024, MODP + 33 * 6144 + 3072, MODP + 33 * 6144 + 4096, MX, BF(WS_Q1), TID);
    grid.sync();
    phase0(a, lds, TID);
#endif
}


#ifndef MK_MULTI
#define MK_MULTI 0
#endif
extern "C" void kernel_launch(void* const* d_in, const int* in_sizes, int n_in, void* d_out, int out_size, void* d_ws, size_t ws_size, hipStream_t stream) {
    static int grid = 0;
    if (grid == 0) {
        int dev = 0, cus = 0, per_cu = 0;
        (void)hipGetDevice(&dev); (void)hipDeviceGetAttribute(&cus, hipDeviceAttributeMultiprocessorCount, dev);
        if (hipFuncSetAttribute((const void*)mega_fwd, hipFuncAttributeMaxDynamicSharedMemorySize, LDS_BYTES) != hipSuccess) fprintf(stderr, "kernel_launch: hipFuncSetAttribute failed\n");
        if (hipOccupancyMaxActiveBlocksPerMultiprocessor(&per_cu, (const void*)mega_fwd, 512, LDS_BYTES) != hipSuccess || per_cu < 1) { fprintf(stderr, "kernel_launch: occupancy query says %d blocks/CU\n", per_cu); per_cu = 1; }
        (void)hipGetLastError();
        grid = cus > 0 ? cus : 256;
        if (n_in != 19 || ws_size < WS_END) fprintf(stderr, "kernel_launch: unexpected n_in %d / ws_size %zu (need %zu)\n", n_in, ws_size, (size_t)WS_END);
    }
    (void)hipMemsetAsync((unsigned char*)d_ws + WS_BAR, 0, 65536, stream);
    Args a{};
    for (int i = 0; i < 19; ++i) a.in[i] = (const float*)d_in[i];
    a.out = (float*)d_out; a.ws = (unsigned char*)d_ws;
#if MK_MULTI
    for (int ph = 0; ph < NPHASE; ++ph) { a.ph_lo = ph; a.ph_hi = ph + 1; hipLaunchKernelGGL(mega_fwd, dim3(grid), dim3(512), LDS_BYTES, stream, a); }
#else
    a.ph_lo = 0; a.ph_hi = NPHASE;
    void* args[] = {&a};
    const hipError_t e = hipLaunchCooperativeKernel((const void*)mega_fwd, dim3(grid), dim3(512), args, LDS_BYTES, stream);
    if (e != hipSuccess) fprintf(stderr, "kernel_launch: cooperative launch failed: %s (grid %d)\n", hipGetErrorString(e), grid);
#endif
}
```

```cpp
#include <hip/hip_runtime.h>
#include <hip/hip_cooperative_groups.h>
#include <cstdio>
#include <cstdint>
namespace cg = cooperative_groups;

namespace pg8 {
#define PG8_LAS __attribute__((address_space(3)))
typedef unsigned short bf16_t;
typedef short bf16x8 __attribute__((ext_vector_type(8)));
typedef float f32x4 __attribute__((ext_vector_type(4)));
typedef unsigned u32x4 __attribute__((ext_vector_type(4)));
constexpr int BM = 256, BK = 64, HALF = 128, HTB = HALF * BK * 2  , STAGE_BYTES = 8 * HTB, NXCD = 8, WGM = 8;

__host__ __device__ __forceinline__ int lds_byte(int r, int c) { const int st = (r >> 4) * 2 + (c >> 5), rr = r & 15, cc = c & 31, ob = rr * 64 + cc * 2; return st * 1024 + (ob ^ (((ob >> 9) & 1) << 5)); }
__host__ __device__ __forceinline__ void stage_rc(int b, int& R, int& C) { const int st = b / 1024, sb = b % 1024, swz = sb ^ (((sb >> 9) & 1) << 5); R = (st >> 1) * 16 + swz / 64; C = (st & 1) * 32 + (swz % 64) / 2; }
__host__ __device__ __forceinline__ int perm32(int rho) { const int n = rho >> 4, i = rho & 15; return 8 * (i >> 2) + 4 * n + (i & 3); }

struct Unit { int pm, pn; };
struct Gemm { const bf16_t* A; const bf16_t* Bt; int M, N, K; };

struct StaticOrder {
    int nM, nN, nwg, G, c;
    __host__ __device__ void init(int M, int N, int G_, int c_) { nM = M / BM; nN = N / BM; nwg = nM * nN; G = G_; c = c_; }
    __host__ __device__ bool next(int i, Unit& u) const {
        const long L = (long)i * G + c; if (L >= nwg) return false;
        int wgid = (int)L; { const int q = nwg / NXCD, r = nwg % NXCD, xcd = wgid % NXCD, off = wgid / NXCD; wgid = (xcd < r ? xcd * (q + 1) : r * (q + 1) + (xcd - r) * q) + off; }
        const int nig = WGM * nN, gid = wgid / nig, fm = gid * WGM, gsz = (nM - fm) < WGM ? (nM - fm) : WGM;
        u.pm = fm + ((wgid % nig) % gsz); u.pn = (wgid % nig) / gsz; return true;
    }
    __device__ __forceinline__ void a_ready(const Unit&) const {}
    __device__ __forceinline__ void done(const Unit&) const {}
};

__device__ __forceinline__ unsigned cvt_pk_bf16(float lo, float hi) { unsigned r; asm volatile("v_cvt_pk_bf16_f32 %0, %1, %2" : "=v"(r) : "v"(lo), "v"(hi)); return r; }
typedef float f32x2 __attribute__((ext_vector_type(2)));
template <class Epi, class Sched, bool ALIGN_EPI = false, bool SP2 = false>
__device__ __forceinline__ void gemm_phase(PG8_LAS unsigned char* lds, const Gemm g, const Sched& S, const Epi& E) {
    int tid_l = threadIdx.x; asm volatile("" : "+v"(tid_l));
    const int tid = tid_l, wid = __builtin_amdgcn_readfirstlane(tid >> 6), lane = tid & 63, wr = wid >> 2, wc = wid & 3, fr = lane & 15, fq = lane >> 4;
    const int K = g.K, nt = K / BK;
    unsigned voffA[2], voffB[2];
#pragma unroll
    for (int i = 0; i < 2; ++i) { int R, C; stage_rc(tid * 16 + i * 8192, R, C); const int Rb = Epi::PERM ? ((R & ~31) + perm32(R & 31)) : R;
        voffA[i] = (unsigned)(R * K + C) * 2u; voffB[i] = (unsigned)(Rb * K + C) * 2u; }
    const size_t kstep = (size_t)(BK * 2);
    const size_t hstep = (size_t)HALF * K * 2;
    const size_t tstep = 2 * hstep;
    const unsigned ldsw = (unsigned)wid * 1024u;
    const int aoff = lds_byte(wr * 64 + fr, fq * 8), boff = lds_byte(wc * 32 + fr, fq * 8);
#define PG8_SA(b, h) (((b) * 2 + (h)) * HTB)
#define PG8_SB(b, h) ((4 + (b) * 2 + (h)) * HTB)
#define PG8_STAGE(bufoff, gbase, voff) do { _Pragma("unroll") for (int _i = 0; _i < 2; ++_i) \
        __builtin_amdgcn_global_load_lds((const unsigned*)((const char*)(gbase) + (voff)[_i]), (PG8_LAS unsigned*)(lds + (bufoff) + ldsw + _i * 8192), 16, 0, 0); } while (0)
#define PG8_LDA(dst, b, h) do { _Pragma("unroll") for (int m = 0; m < 4; ++m) _Pragma("unroll") for (int k = 0; k < 2; ++k) dst[m][k] = *(const PG8_LAS bf16x8*)(lds + PG8_SA(b, h) + aoff + m * 2048 + k * 1024); } while (0)
#define PG8_LDB(dst, b, h) do { _Pragma("unroll") for (int n = 0; n < 2; ++n) _Pragma("unroll") for (int k = 0; k < 2; ++k) dst[n][k] = *(const PG8_LAS bf16x8*)(lds + PG8_SB(b, h) + boff + n * 2048 + k * 1024); } while (0)
#define PG8_MMA(ai, bj, At, Bt) do { __builtin_amdgcn_s_setprio(1); _Pragma("unroll") for (int m = 0; m < 4; ++m) _Pragma("unroll") for (int n = 0; n < 2; ++n) _Pragma("unroll") for (int k = 0; k < 2; ++k) \
        acc[ai][bj][m][n] = __builtin_amdgcn_mfma_f32_16x16x32_bf16(Bt[n][k], At[m][k], acc[ai][bj][m][n], 0, 0, 0); __builtin_amdgcn_s_setprio(0); } while (0)
#define PG8_WAIT_V(n) asm volatile("s_waitcnt vmcnt(" #n ")" ::: "memory")
#define PG8_WAIT_L(n) asm volatile("s_waitcnt lgkmcnt(" #n ")" ::: "memory")
#define PG8_BAR __builtin_amdgcn_s_barrier()
#define PG8_SCHED __builtin_amdgcn_sched_barrier(0)
    Unit cur, nxt; int ui = 0;
    if (!S.next(0, cur)) return;
    f32x4 acc[2][2][4][2];
#pragma unroll
    for (int a = 0; a < 2; ++a)
#pragma unroll
        for (int b = 0; b < 2; ++b)
#pragma unroll
            for (int m = 0; m < 4; ++m)
#pragma unroll
                for (int n = 0; n < 2; ++n) acc[a][b][m][n] = (f32x4){0.f, 0.f, 0.f, 0.f};
    bf16x8 At[4][2], B0[2][2], B1[2][2];
    const char* cA = (const char*)g.A + (size_t)cur.pm * tstep; const char* cB = (const char*)g.Bt + (size_t)cur.pn * tstep;
    S.a_ready(cur);
    if constexpr (SP2) {
        PG8_STAGE(PG8_SB(0, 0), cB, voffB); PG8_STAGE(PG8_SB(0, 1), cB + hstep, voffB); PG8_STAGE(PG8_SA(0, 0), cA, voffA); PG8_STAGE(PG8_SA(0, 1), cA + hstep, voffA);
        if (wr == 1) PG8_BAR;
        PG8_WAIT_V(2); PG8_BAR;
        PG8_STAGE(PG8_SB(1, 0), cB + kstep, voffB); PG8_STAGE(PG8_SA(1, 0), cA + kstep, voffA); PG8_STAGE(PG8_SB(1, 1), cB + hstep + kstep, voffB);
        PG8_WAIT_V(6); PG8_BAR;
    } else {
        PG8_STAGE(PG8_SB(0, 0), cB, voffB); PG8_STAGE(PG8_SA(0, 0), cA, voffA); PG8_STAGE(PG8_SB(0, 1), cB + hstep, voffB); PG8_STAGE(PG8_SA(0, 1), cA + hstep, voffA);
        if (wr == 1) PG8_BAR;
        PG8_WAIT_V(4); PG8_BAR;
        PG8_STAGE(PG8_SB(1, 0), cB + kstep, voffB); PG8_STAGE(PG8_SA(1, 0), cA + kstep, voffA); PG8_STAGE(PG8_SB(1, 1), cB + hstep + kstep, voffB);
        PG8_WAIT_V(6); PG8_BAR;
    }
    for (;;) {
        const bool has_next = S.next(ui + 1, nxt);
        const char* nA = has_next ? (const char*)g.A + (size_t)nxt.pm * tstep : cA; const char* nB = has_next ? (const char*)g.Bt + (size_t)nxt.pn * tstep : cB;
        for (int t = 0; t < nt; t += 2) {
            const bool last = (t == nt - 2);
            const char* a1 = cA + (size_t)(t + 1) * kstep;
            const char* a2 = last ? nA : cA + (size_t)(t + 2) * kstep; const char* b2 = last ? nB : cB + (size_t)(t + 2) * kstep;
            const char* a3 = a2 + kstep; const char* b3 = b2 + kstep;
            if (last && has_next) S.a_ready(nxt);
            if constexpr (SP2) {
            PG8_LDB(B0, 0, 0); PG8_LDB(B1, 0, 1); PG8_SCHED; PG8_LDA(At, 0, 0); PG8_STAGE(PG8_SA(1, 1), a1 + hstep, voffA);
            PG8_WAIT_V(8); PG8_WAIT_L(0); PG8_BAR; PG8_MMA(0, 0, At, B0); PG8_MMA(0, 1, At, B1); PG8_BAR; PG8_SCHED;
            PG8_LDA(At, 0, 1); PG8_STAGE(PG8_SB(0, 0), b2, voffB); PG8_STAGE(PG8_SB(0, 1), b2 + hstep, voffB); PG8_STAGE(PG8_SA(0, 0), a2, voffA);
            PG8_WAIT_V(8); PG8_WAIT_L(0); PG8_BAR; PG8_MMA(1, 0, At, B0); PG8_MMA(1, 1, At, B1); PG8_BAR; PG8_SCHED;
            PG8_LDB(B0, 1, 0); PG8_LDB(B1, 1, 1); PG8_SCHED; PG8_LDA(At, 1, 0); PG8_STAGE(PG8_SA(0, 1), a2 + hstep, voffA);
            PG8_WAIT_V(8); PG8_WAIT_L(0); PG8_BAR; PG8_MMA(0, 0, At, B0); PG8_MMA(0, 1, At, B1); PG8_BAR; PG8_SCHED;
            PG8_LDA(At, 1, 1); PG8_STAGE(PG8_SB(1, 0), b3, voffB); PG8_STAGE(PG8_SB(1, 1), b3 + hstep, voffB); PG8_STAGE(PG8_SA(1, 0), a3, voffA);
            PG8_WAIT_V(8); PG8_WAIT_L(0); PG8_BAR; PG8_MMA(1, 0, At, B0); PG8_MMA(1, 1, At, B1); PG8_BAR; PG8_SCHED;
            } else {
            PG8_LDB(B0, 0, 0); PG8_SCHED; PG8_LDA(At, 0, 0); PG8_STAGE(PG8_SA(1, 1), a1 + hstep, voffA);
            PG8_WAIT_L(8); PG8_BAR; PG8_WAIT_L(0); PG8_MMA(0, 0, At, B0); PG8_BAR; PG8_SCHED;
            PG8_LDB(B1, 0, 1); PG8_STAGE(PG8_SB(0, 0), b2, voffB);
            PG8_BAR; PG8_WAIT_L(0); PG8_MMA(0, 1, At, B1); PG8_BAR;
            PG8_LDA(At, 0, 1); PG8_STAGE(PG8_SA(0, 0), a2, voffA);
            PG8_BAR; PG8_WAIT_L(0); PG8_MMA(1, 0, At, B0); PG8_BAR; PG8_SCHED;
            PG8_STAGE(PG8_SB(0, 1), b2 + hstep, voffB);
            PG8_WAIT_V(6); PG8_BAR; PG8_MMA(1, 1, At, B1); PG8_BAR;
            PG8_LDB(B0, 1, 0); PG8_SCHED; PG8_LDA(At, 1, 0); PG8_STAGE(PG8_SA(0, 1), a2 + hstep, voffA);
            PG8_WAIT_L(8); PG8_BAR; PG8_WAIT_L(0); PG8_MMA(0, 0, At, B0); PG8_BAR; PG8_SCHED;
            PG8_LDB(B1, 1, 1); PG8_STAGE(PG8_SB(1, 0), b3, voffB);
            PG8_BAR; PG8_WAIT_L(0); PG8_MMA(0, 1, At, B1); PG8_BAR;
            PG8_LDA(At, 1, 1); PG8_STAGE(PG8_SA(1, 0), a3, voffA);
            PG8_BAR; PG8_WAIT_L(0); PG8_MMA(1, 0, At, B0); PG8_BAR; PG8_SCHED;
            PG8_STAGE(PG8_SB(1, 1), b3 + hstep, voffB);
            PG8_WAIT_V(6); PG8_BAR; PG8_MMA(1, 1, At, B1); PG8_BAR;
            }
        }
        if constexpr (ALIGN_EPI) { if (wr == 0) PG8_BAR; }
        if constexpr (!Epi::AFTER_DRAIN) { E(acc, cur, wr, wc, fr, fq); S.done(cur); }
        if (!has_next) break;
#pragma unroll
        for (int a = 0; a < 2; ++a)
#pragma unroll
            for (int b = 0; b < 2; ++b)
#pragma unroll
                for (int m = 0; m < 4; ++m)
#pragma unroll
                    for (int n = 0; n < 2; ++n) acc[a][b][m][n] = (f32x4){0.f, 0.f, 0.f, 0.f};
        cur = nxt; cA = nA; cB = nB; ++ui;
        if constexpr (ALIGN_EPI) { if (wr == 1) PG8_BAR; }
    }
    PG8_WAIT_V(0);
    if constexpr (!ALIGN_EPI) { if (wr == 0) PG8_BAR; }
    PG8_BAR;
    if constexpr (Epi::AFTER_DRAIN) { E.fused(acc, cur, wr, wc, fr, fq, lds, wid, lane); S.done(cur); }
#undef PG8_SA
#undef PG8_SB
#undef PG8_STAGE
#undef PG8_LDA
#undef PG8_LDB
#undef PG8_MMA
#undef PG8_WAIT_V
#undef PG8_WAIT_L
#undef PG8_BAR
#undef PG8_SCHED
}
}

#ifndef PG8_SP2
#define PG8_SP2 true
#endif
#ifndef PG8_ALIGN
#define PG8_ALIGN true
#endif

#define LAS __attribute__((address_space(3)))
typedef unsigned short bf16_t;
typedef short bf16x8 __attribute__((ext_vector_type(8)));
typedef short s16x4 __attribute__((ext_vector_type(4)));
typedef float f32x4 __attribute__((ext_vector_type(4)));
typedef float f32x16 __attribute__((ext_vector_type(16)));
typedef unsigned u32x4 __attribute__((ext_vector_type(4)));
typedef unsigned u32x2 __attribute__((ext_vector_type(2)));

constexpr int NB = 32, SEQ = 2048, DM = 1024, CL = 256, MX = NB * SEQ, MC = NB * CL, MA = MX + MC, DFF = 2816;
constexpr float LOG2E = 1.4426950408889634f;
constexpr float EPSN = 1e-6f;
constexpr size_t MiB = (size_t)1 << 20;
constexpr size_t WS_WQKV0 = 1 * MiB, WS_WO0 = 4 * MiB, WS_WIN0 = 6 * MiB, WS_WOUT0 = 17 * MiB, WS_WR = 23 * MiB, WS_WRO = 35 * MiB, WS_WIN1 = 39 * MiB, WS_WOUT1 = 50 * MiB;
constexpr size_t WS_MOD = 56 * MiB, WS_TAB0 = 58 * MiB, WS_TAB1 = 58 * MiB + 65536;
constexpr size_t WS_GNS = 60 * MiB;
constexpr size_t WS_X = 64 * MiB;
constexpr size_t WS_H = 208 * MiB, WS_QKV0 = 352 * MiB, WS_ACT0 = 352 * MiB;
constexpr size_t WS_Q1 = 208 * MiB, WS_K1 = 352 * MiB, WS_V1 = 496 * MiB, WS_HL1 = 784 * MiB, WS_ACT1 = 352 * MiB, WS_END = 1024 * MiB;
constexpr int LDS_BYTES = 152 * 1024, XB_LDS_OFF = 150 * 1024;
constexpr size_t WS_BAR = 62 * MiB;
constexpr int NPHASE = 16;

__device__ __forceinline__ unsigned pkbf(float lo, float hi) { return pg8::cvt_pk_bf16(lo, hi); }
__device__ __forceinline__ float bf_lo(unsigned w) { return __builtin_bit_cast(float, w << 16); }
__device__ __forceinline__ float bf_hi(unsigned w) { return __builtin_bit_cast(float, w & 0xffff0000u); }
__device__ __forceinline__ float bf2f(bf16_t v) { return __builtin_bit_cast(float, (unsigned)v << 16); }
__device__ __forceinline__ float wave_sum(float v) {
#pragma unroll
    for (int o = 1; o < 64; o <<= 1) v += __shfl_xor(v, o);
    return v;
}
__device__ __forceinline__ float fast_silu(float x) { return x * __builtin_amdgcn_rcpf(1.0f + __expf(-x)); }

struct EpiSplit {
    static constexpr bool PERM = true, AFTER_DRAIN = false;
    bf16_t* d0; int ld0; int t1; bf16_t* d1; int ld1; int t2; bf16_t* d2; int ld2;
    __device__ __forceinline__ void operator()(const pg8::f32x4 (&acc)[2][2][4][2], const pg8::Unit& u, int wr, int wc, int fr, int fq) const {
        bf16_t* base; int ld, ct;
        if (u.pn < t1) { base = d0; ld = ld0; ct = u.pn; } else if (u.pn < t2) { base = d1; ld = ld1; ct = u.pn - t1; } else { base = d2; ld = ld2; ct = u.pn - t2; }
        const int row0 = u.pm * 256 + wr * 64 + fr, col0 = ct * 256 + wc * 32 + 8 * fq;
#pragma unroll
        for (int ai = 0; ai < 2; ++ai)
#pragma unroll
            for (int m = 0; m < 4; ++m) { bf16_t* rowp = base + (size_t)(row0 + ai * 128 + m * 16) * ld + col0;
#pragma unroll
                for (int bj = 0; bj < 2; ++bj) { const pg8::f32x4 v0 = acc[ai][bj][m][0], v1 = acc[ai][bj][m][1]; u32x4 w;
                    w.x = pkbf(v0[0], v0[1]); w.y = pkbf(v0[2], v0[3]); w.z = pkbf(v1[0], v1[1]); w.w = pkbf(v1[2], v1[3]);
                    *(u32x4*)(rowp + bj * 128) = w; } }
    }
};
struct EpiQKV0 {
    static constexpr bool PERM = true, AFTER_DRAIN = false;
    bf16_t* O; const float* qg; const float* kg; const float* tab0;
    __device__ __forceinline__ void operator()(const pg8::f32x4 (&acc)[2][2][4][2], const pg8::Unit& u, int wr, int wc, int fr, int fq) const {
        const int row0 = u.pm * 256 + wr * 64 + fr, col0 = u.pn * 256 + wc * 32 + 8 * fq;
        if (u.pn >= 5) {
#pragma unroll
            for (int ai = 0; ai < 2; ++ai)
#pragma unroll
                for (int m = 0; m < 4; ++m) { bf16_t* rowp = O + (size_t)(row0 + ai * 128 + m * 16) * 1536 + col0;
#pragma unroll
                    for (int bj = 0; bj < 2; ++bj) { const pg8::f32x4 v0 = acc[ai][bj][m][0], v1 = acc[ai][bj][m][1]; u32x4 w;
                        w.x = pkbf(v0[0], v0[1]); w.y = pkbf(v0[2], v0[3]); w.z = pkbf(v1[0], v1[1]); w.w = pkbf(v1[2], v1[3]); *(u32x4*)(rowp + bj * 128) = w; } }
            return;
        }
        const float* gp = (u.pn < 4 ? qg : kg) + 8 * fq + (fq >= 2 ? 16 : 0);
        const float qs = u.pn < 4 ? 0.125f * LOG2E : 1.0f;
        pg8::f32x4 g1[2], g2[2];
#pragma unroll
        for (int n = 0; n < 2; ++n) { g1[n] = *(const pg8::f32x4*)(gp + 4 * n) * qs; g2[n] = *(const pg8::f32x4*)(gp + 16 + 4 * n) * qs; }
        const bool lat = u.pm * 256 < MX;
#pragma unroll
        for (int ai = 0; ai < 2; ++ai)
#pragma unroll
            for (int m = 0; m < 4; ++m) { const int row = row0 + ai * 128 + m * 16;
                pg8::f32x4 x1[2] = {acc[ai][0][m][0], acc[ai][0][m][1]}, x2[2] = {acc[ai][1][m][0], acc[ai][1][m][1]};
                float ss = 0.f;
#pragma unroll
                for (int n = 0; n < 2; ++n) ss += (x1[n][0] * x1[n][0] + x1[n][1] * x1[n][1]) + (x1[n][2] * x1[n][2] + x1[n][3] * x1[n][3]) + (x2[n][0] * x2[n][0] + x2[n][1] * x2[n][1]) + (x2[n][2] * x2[n][2] + x2[n][3] * x2[n][3]);
                ss += __shfl_xor(ss, 16); ss += __shfl_xor(ss, 32);
                const float rstd = rsqrtf(ss * (1.0f / 64.0f) + EPSN);
#pragma unroll
                for (int n = 0; n < 2; ++n) { x1[n] = x1[n] * rstd * g1[n]; x2[n] = x2[n] * rstd * g2[n]; }
                if (lat) { const int s = row & (SEQ - 1), pos = (fq & 2) ? (s & 63) : (s >> 6);
                    const float* tp = tab0 + ((size_t)pos * 16 + 8 * (fq & 1)) * 2;
#pragma unroll
                    for (int n = 0; n < 2; ++n) { const pg8::f32x4 t0 = *(const pg8::f32x4*)(tp + 8 * n), t1 = *(const pg8::f32x4*)(tp + 8 * n + 4);
                        const pg8::f32x4 cs = {t0[0], t0[2], t1[0], t1[2]}, sn = {t0[1], t0[3], t1[1], t1[3]};
                        const pg8::f32x4 a = x1[n] * cs - x2[n] * sn, bb = x1[n] * sn + x2[n] * cs; x1[n] = a; x2[n] = bb; } }
                bf16_t* rowp = O + (size_t)row * 1536 + col0; u32x4 w;
                w.x = pkbf(x1[0][0], x1[0][1]); w.y = pkbf(x1[0][2], x1[0][3]); w.z = pkbf(x1[1][0], x1[1][1]); w.w = pkbf(x1[1][2], x1[1][3]); *(u32x4*)rowp = w;
                w.x = pkbf(x2[0][0], x2[0][1]); w.y = pkbf(x2[0][2], x2[0][3]); w.z = pkbf(x2[1][0], x2[1][1]); w.w = pkbf(x2[1][2], x2[1][3]); *(u32x4*)(rowp + 128) = w;
                asm volatile("" ::: "memory"); }
    }
};
struct EpiQKV1 {
    static constexpr bool PERM = true, AFTER_DRAIN = false;
    bf16_t* Qd; bf16_t* Kd; bf16_t* Vd; const float* tab1;
    __device__ __forceinline__ void operator()(const pg8::f32x4 (&acc)[2][2][4][2], const pg8::Unit& u, int wr, int wc, int fr, int fq) const {
        bf16_t* base; int ld, ct;
        if (u.pn < 4) { base = Qd; ld = 1024; ct = u.pn; } else if (u.pn < 8) { base = Kd; ld = 1024; ct = u.pn - 4; } else { base = Vd; ld = 2048; ct = u.pn - 8; }
        const int row0 = u.pm * 256 + wr * 64 + fr, col0 = ct * 256 + wc * 32 + 8 * fq;
        const bool rope = u.pn < 8 && u.pm * 256 < MX;
#pragma unroll
        for (int ai = 0; ai < 2; ++ai)
#pragma unroll
            for (int m = 0; m < 4; ++m) { const int row = row0 + ai * 128 + m * 16;
                pg8::f32x4 x1[2] = {acc[ai][0][m][0], acc[ai][0][m][1]}, x2[2] = {acc[ai][1][m][0], acc[ai][1][m][1]};
                if (rope) { const int s = row & (SEQ - 1), pos = (wc & 2) ? (s & 63) : (s >> 6);
                    const float* tp = tab1 + ((size_t)pos * 64 + 32 * (wc & 1) + 8 * fq) * 2;
#pragma unroll
                    for (int n = 0; n < 2; ++n) { const pg8::f32x4 t0 = *(const pg8::f32x4*)(tp + 8 * n), t1 = *(const pg8::f32x4*)(tp + 8 * n + 4);
                        const pg8::f32x4 cs = {t0[0], t0[2], t1[0], t1[2]}, sn = {t0[1], t0[3], t1[1], t1[3]};
                        const pg8::f32x4 a = x1[n] * cs - x2[n] * sn, bb = x1[n] * sn + x2[n] * cs; x1[n] = a; x2[n] = bb; } }
                bf16_t* rowp = base + (size_t)row * ld + col0; u32x4 w;
                w.x = pkbf(x1[0][0], x1[0][1]); w.y = pkbf(x1[0][2], x1[0][3]); w.z = pkbf(x1[1][0], x1[1][1]); w.w = pkbf(x1[1][2], x1[1][3]); *(u32x4*)rowp = w;
                w.x = pkbf(x2[0][0], x2[0][1]); w.y = pkbf(x2[0][2], x2[0][3]); w.z = pkbf(x2[1][0], x2[1][1]); w.w = pkbf(x2[1][2], x2[1][3]); *(u32x4*)(rowp + 128) = w;
                asm volatile("" ::: "memory"); }
    }
};
template <int MODE> struct EpiResid {
    static constexpr bool PERM = true, AFTER_DRAIN = false;
    const float* xin_lat; const float* xin_ctx; bf16_t* X; float* outf; const float* gate;
    __device__ __forceinline__ void operator()(const pg8::f32x4 (&acc)[2][2][4][2], const pg8::Unit& u, int wr, int wc, int fr, int fq) const {
        const int R = u.pm * 256; const int gr = R < MX ? R / SEQ : NB;
        const int col0 = u.pn * 256 + wc * 32 + 8 * fq; const float* gp = gate + (size_t)gr * 6144 + col0;
        const float* xi = R < MX ? xin_lat + (size_t)R * DM : xin_ctx + (size_t)(R - MX) * DM;
        pg8::f32x4 g[2][2];
#pragma unroll
        for (int bj = 0; bj < 2; ++bj)
#pragma unroll
            for (int n = 0; n < 2; ++n) g[bj][n] = *(const pg8::f32x4*)(gp + bj * 128 + 4 * n);
#pragma unroll
        for (int ai = 0; ai < 2; ++ai)
#pragma unroll
            for (int m = 0; m < 4; ++m) { const size_t off = (size_t)(wr * 64 + fr + ai * 128 + m * 16) * DM + col0;
#pragma unroll
                for (int bj = 0; bj < 2; ++bj) {
                    pg8::f32x4 x0, x1;
                    if (MODE == 0) { x0 = *(const pg8::f32x4*)(xi + off + bj * 128); x1 = *(const pg8::f32x4*)(xi + off + bj * 128 + 4); }
                    else { const u32x4 w = *(const u32x4*)(X + (size_t)R * DM + off + bj * 128); x0 = (pg8::f32x4){bf_lo(w.x), bf_hi(w.x), bf_lo(w.y), bf_hi(w.y)}; x1 = (pg8::f32x4){bf_lo(w.z), bf_hi(w.z), bf_lo(w.w), bf_hi(w.w)}; }
                    x0 = x0 + g[bj][0] * acc[ai][bj][m][0]; x1 = x1 + g[bj][1] * acc[ai][bj][m][1];
                    if (MODE == 2) { __builtin_nontemporal_store(x0, (pg8::f32x4*)(outf + (size_t)R * DM + off + bj * 128)); __builtin_nontemporal_store(x1, (pg8::f32x4*)(outf + (size_t)R * DM + off + bj * 128 + 4)); }
                    else { u32x4 w; w.x = pkbf(x0[0], x0[1]); w.y = pkbf(x0[2], x0[3]); w.z = pkbf(x1[0], x1[1]); w.w = pkbf(x1[2], x1[3]); *(u32x4*)(X + (size_t)R * DM + off + bj * 128) = w; } }
                asm volatile("" ::: "memory"); }
    }
};
struct EpiSwiglu {
    static constexpr bool PERM = true, AFTER_DRAIN = false;
    bf16_t* O;
    __device__ __forceinline__ void operator()(const pg8::f32x4 (&acc)[2][2][4][2], const pg8::Unit& u, int wr, int wc, int fr, int fq) const {
        const int row0 = u.pm * 256 + wr * 64 + fr, col0 = u.pn * 128 + wc * 32 + 8 * fq;
#pragma unroll
        for (int ai = 0; ai < 2; ++ai)
#pragma unroll
            for (int m = 0; m < 4; ++m) { const pg8::f32x4 g0 = acc[ai][0][m][0], g1 = acc[ai][0][m][1], u0 = acc[ai][1][m][0], u1 = acc[ai][1][m][1]; u32x4 w;
#define SWG(g_, u_) ((g_) * (u_) * __builtin_amdgcn_rcpf(1.0f + __builtin_amdgcn_exp2f(g_)))
                w.x = pkbf(SWG(g0[0], u0[0]), SWG(g0[1], u0[1])); w.y = pkbf(SWG(g0[2], u0[2]), SWG(g0[3], u0[3]));
                w.z = pkbf(SWG(g1[0], u1[0]), SWG(g1[1], u1[1])); w.w = pkbf(SWG(g1[2], u1[2]), SWG(g1[3], u1[3]));
#undef SWG
                __builtin_nontemporal_store(w, (u32x4*)(O + (size_t)(row0 + ai * 128 + m * 16) * DFF + col0)); }
    }
};
struct EpiGate {
    static constexpr bool PERM = true, AFTER_DRAIN = false;
    bf16_t* Y; const float* stats; const float* gain;
    __device__ __forceinline__ void operator()(const pg8::f32x4 (&acc)[2][2][4][2], const pg8::Unit& u, int wr, int wc, int fr, int fq) const {
        const int row0 = u.pm * 256 + wr * 64 + fr, col0 = u.pn * 256 + wc * 32 + 8 * fq, hg = u.pn >> 1;
        pg8::f32x4 g[2][2];
#pragma unroll
        for (int bj = 0; bj < 2; ++bj)
#pragma unroll
            for (int n = 0; n < 2; ++n) g[bj][n] = *(const pg8::f32x4*)(gain + col0 + bj * 128 + 4 * n);
#pragma unroll
        for (int ai = 0; ai < 2; ++ai)
#pragma unroll
            for (int m = 0; m < 4; ++m) { const int row = row0 + ai * 128 + m * 16; bf16_t* rowp = Y + (size_t)row * 2048 + col0;
                const float s0 = stats[((size_t)row * 4 + hg) * 2], s1 = stats[((size_t)row * 4 + hg) * 2 + 1];
                const float mu = s0 * (1.0f / 512.0f), rstd = rsqrtf(fmaxf(s1 * (1.0f / 512.0f) - mu * mu, 0.f) + EPSN);
#pragma unroll
                for (int bj = 0; bj < 2; ++bj) { const u32x4 y = *(const u32x4*)(rowp + bj * 128); const pg8::f32x4 v0 = acc[ai][bj][m][0], v1 = acc[ai][bj][m][1];
                    const pg8::f32x4 y0 = ((pg8::f32x4){bf_lo(y.x), bf_hi(y.x), bf_lo(y.y), bf_hi(y.y)} - mu) * rstd * g[bj][0], y1 = ((pg8::f32x4){bf_lo(y.z), bf_hi(y.z), bf_lo(y.w), bf_hi(y.w)} - mu) * rstd * g[bj][1];
                    u32x4 w;
                    w.x = pkbf(fast_silu(v0[0]) * y0[0], fast_silu(v0[1]) * y0[1]); w.y = pkbf(fast_silu(v0[2]) * y0[2], fast_silu(v0[3]) * y0[3]);
                    w.z = pkbf(fast_silu(v1[0]) * y1[0], fast_silu(v1[1]) * y1[1]); w.w = pkbf(fast_silu(v1[2]) * y1[2], fast_silu(v1[3]) * y1[3]);
                    *(u32x4*)(rowp + bj * 128) = w; }
                asm volatile("" ::: "memory"); }
    }
};

__device__ __forceinline__ int drow_map(int mode, int n) {
    if (mode == 1) return n < DFF ? (n / 128) * 256 + (n % 128) : ((n - DFF) / 128) * 256 + 128 + ((n - DFF) % 128);
    if (mode == 2) { if (n >= 2048) return n; const int o = n & 255, blk = o >> 6, nb = (blk == 1) ? 2 : (blk == 2 ? 1 : blk); return (n - o) + 64 * nb + (o & 63); }
    if (mode == 3) { if (n >= 1280) return n; const int o = n & 255, hd = o >> 6, d = o & 63, q16 = d >> 4; return (n - o) + 128 * (q16 & 1) + 32 * hd + 16 * (q16 >> 1) + (d & 15); }
    return n;
}
__device__ __forceinline__ void transpose_item(const float* W, int K, int N, bf16_t* WT, int k0, int n0, int mode, LAS float* scr, int lane) {
#pragma unroll 8
    for (int i = 0; i < 32; ++i) { const int kk = 2 * i + (lane >> 5); scr[kk * 33 + (lane & 31)] = W[(size_t)(k0 + kk) * N + n0 + (lane & 31)]; }
    asm volatile("s_waitcnt lgkmcnt(0)" ::: "memory");
    const int c = lane & 7;
    const float wsc = mode == 1 ? (n0 < DFF ? -LOG2E : -1.0f / LOG2E) : 1.0f;
#pragma unroll
    for (int j = 0; j < 4; ++j) { const int n = (lane >> 3) + 8 * j; const LAS float* s = scr + (8 * c) * 33 + n;
        u32x4 o; o.x = pkbf(s[0 * 33] * wsc, s[1 * 33] * wsc); o.y = pkbf(s[2 * 33] * wsc, s[3 * 33] * wsc); o.z = pkbf(s[4 * 33] * wsc, s[5 * 33] * wsc); o.w = pkbf(s[6 * 33] * wsc, s[7 * 33] * wsc);
        *(u32x4*)(WT + (size_t)drow_map(mode, n0 + n) * K + k0 + 8 * c) = o; }
    asm volatile("s_waitcnt lgkmcnt(0)" ::: "memory");
}

struct Args { const float* in[19]; float* out; unsigned char* ws; int ph_lo, ph_hi; };

__device__ __forceinline__ void phase0(const Args& a, LAS unsigned char* lds, int tid) {
    const int wave = tid >> 6, lane = tid & 63;
    const int gw = blockIdx.x * 8 + wave, NGW = gridDim.x * 8;
    unsigned char* ws = a.ws;
    {
        LAS float* scr = (LAS float*)(lds + wave * 16384);
        constexpr int I0 = 16 * 48, I1 = 16 * 32, I2 = 16 * 176, I3 = 44 * 32, I4 = 16 * 192, I5 = 32 * 32, I6 = I2, I7 = I3;
        constexpr int NIT = I0 + I1 + I2 + I3 + I4 + I5 + I6 + I7;
        for (int it = gw; it < NIT; it += NGW) {
            int r = it; const float* W; bf16_t* WT; int K, N; int mode = 0;
            if (r < I0) { W = a.in[10]; WT = (bf16_t*)(ws + WS_WQKV0); K = 1024; N = 1536; mode = 3; }
            else if ((r -= I0) < I1) { W = a.in[14]; WT = (bf16_t*)(ws + WS_WO0); K = 1024; N = 1024; }
            else if ((r -= I1) < I2) { W = a.in[8]; WT = (bf16_t*)(ws + WS_WIN0); K = 1024; N = 5632; mode = 1; }
            else if ((r -= I2) < I3) { W = a.in[9]; WT = (bf16_t*)(ws + WS_WOUT0); K = 2816; N = 1024; }
            else if ((r -= I3) < I4) { W = a.in[15]; WT = (bf16_t*)(ws + WS_WR); K = 1024; N = 6144; mode = 2; }
            else if ((r -= I4) < I5) { W = a.in[18]; WT = (bf16_t*)(ws + WS_WRO); K = 2048; N = 1024; }
            else if ((r -= I5) < I6) { W = a.in[8] + (size_t)1024 * 5632; WT = (bf16_t*)(ws + WS_WIN1); K = 1024; N = 5632; mode = 1; }
            else { r -= I6; W = a.in[9] + (size_t)2816 * 1024; WT = (bf16_t*)(ws + WS_WOUT1); K = 2816; N = 1024; }
            const int nblk = N / 32, kb = r / nblk, nb = r % nblk, n0 = 32 * nb;
            transpose_item(W, K, N, WT, 64 * kb, n0, mode, scr, lane);
        }
    }
    { f32x4* gs = (f32x4*)(ws + WS_GNS); for (int i = blockIdx.x * 512 + tid; i < MX * 8 / 4; i += gridDim.x * 512) gs[i] = (f32x4){0.f, 0.f, 0.f, 0.f}; }
    {
        const int gt = blockIdx.x * 512 + tid;
        if (gt < 64 * 16 + 64 * 64) {
            int pos, f; float expo; float* dst;
            if (gt < 1024) { pos = gt >> 4; f = gt & 15; expo = -(float)(2 * f) / 32.0f; dst = (float*)(ws + WS_TAB0) + (size_t)gt * 2; }
            else { const int g2 = gt - 1024; pos = g2 >> 6; f = g2 & 63; expo = -(float)(2 * f) / 128.0f; dst = (float*)(ws + WS_TAB1) + (size_t)g2 * 2; }
            const float inv = exp2f(expo * 13.287712379549449f);
            const float ang = (float)pos * inv;
            const double ad = (double)ang; const double kk = __builtin_rint(ad * 0.15915494309189535); const float red = (float)(ad - kk * 6.283185307179586);
            dst[0] = __cosf(red); dst[1] = __sinf(red);
        }
    }
    __syncthreads();
    {
        LAS float* sc = (LAS float*)lds + wave * (128 * 36);
        LAS float* red = (LAS float*)lds;
        float* mod = (float*)(ws + WS_MOD);
        for (int it = blockIdx.x; it < 192; it += gridDim.x) {
            const int l = it / 96, n0 = (it % 96) * 64;
            int lane_l = lane; asm volatile("" : "+v"(lane_l));
#pragma unroll
            for (int t0 = 0; t0 < 66; t0 += 22) {
                float tv[22];
#pragma unroll
                for (int t = 0; t < 22; ++t) { const int r = (t0 + t) >> 1, k = lane_l + 64 * (t & 1); tv[t] = r < 32 ? a.in[1][r * 1024 + wave * 128 + k] : a.in[3][wave * 128 + k]; }
#pragma unroll
                for (int t = 0; t < 22; ++t) { const int r = (t0 + t) >> 1, k = lane_l + 64 * (t & 1); sc[k * 36 + r] = tv[t] * __builtin_amdgcn_rcpf(1.0f + __expf(-tv[t])); }
                asm volatile("" ::: "memory");
            }
            asm volatile("s_waitcnt lgkmcnt(0)" ::: "memory");
            float acc[33];
#pragma unroll
            for (int r = 0; r < 33; ++r) acc[r] = 0.f;
            const float* Wp = a.in[4] + ((size_t)l * 1024 + wave * 128) * 6144 + n0 + lane_l;
#pragma unroll 1
            for (int k0 = 0; k0 < 128; k0 += 16) {
                float wv[16];
#pragma unroll
                for (int kk = 0; kk < 16; ++kk) wv[kk] = Wp[(size_t)(k0 + kk) * 6144];
#pragma unroll
                for (int kk = 0; kk < 16; ++kk) { const int k = k0 + kk;
#pragma unroll
                    for (int r4 = 0; r4 < 8; ++r4) { const f32x4 s = *(const LAS f32x4*)(sc + k * 36 + 4 * r4); acc[4 * r4] += s[0] * wv[kk]; acc[4 * r4 + 1] += s[1] * wv[kk]; acc[4 * r4 + 2] += s[2] * wv[kk]; acc[4 * r4 + 3] += s[3] * wv[kk]; }
                    acc[32] += sc[k * 36 + 32] * wv[kk];
                    if ((kk & 1) == 1) asm volatile("" ::: "memory"); }
            }
            __syncthreads();
#pragma unroll
            for (int r = 0; r < 33; ++r) red[(wave * 33 + r) * 64 + lane] = acc[r];
            __syncthreads();
            for (int idx = tid; idx < 33 * 64; idx += 512) { const int r = idx >> 6, cc = idx & 63; float s = 0.f;
#pragma unroll
                for (int w = 0; w < 8; ++w) s += red[(w * 33 + r) * 64 + cc];
                mod[((size_t)l * 33 + r) * 6144 + n0 + cc] = s + a.in[5][l * 6144 + n0 + cc]; }
            __syncthreads();
        }
    }
}

template <bool SRC_BF16>
__device__ __forceinline__ void norm_phase(const float* src_lat, const float* src_ctx, const bf16_t* srcb, const float* g, const float* shift, const float* scale, int nrows, bf16_t* dst, int tid) {
    const int lane = tid & 63, gw = blockIdx.x * 8 + (tid >> 6), NGW = gridDim.x * 8;
    for (int row = gw; row < nrows; row += NGW) {
        const int r = row < MX ? row / SEQ : NB;
        f32x4 v[4]; float ss = 0.f;
        if (SRC_BF16) {
            const u32x4 w0 = *(const u32x4*)(srcb + (size_t)row * DM + 8 * lane), w1 = *(const u32x4*)(srcb + (size_t)row * DM + 512 + 8 * lane);
            v[0] = (f32x4){bf_lo(w0.x), bf_hi(w0.x), bf_lo(w0.y), bf_hi(w0.y)}; v[1] = (f32x4){bf_lo(w0.z), bf_hi(w0.z), bf_lo(w0.w), bf_hi(w0.w)};
            v[2] = (f32x4){bf_lo(w1.x), bf_hi(w1.x), bf_lo(w1.y), bf_hi(w1.y)}; v[3] = (f32x4){bf_lo(w1.z), bf_hi(w1.z), bf_lo(w1.w), bf_hi(w1.w)};
        } else {
            const float* src = row < MX ? src_lat + (size_t)row * DM : src_ctx + (size_t)(row - MX) * DM;
#pragma unroll
            for (int j = 0; j < 4; ++j) v[j] = ((const f32x4*)src)[lane + 64 * j];
        }
#pragma unroll
        for (int j = 0; j < 4; ++j) ss += (v[j].x * v[j].x + v[j].y * v[j].y) + (v[j].z * v[j].z + v[j].w * v[j].w);
        const float rstd = rsqrtf(wave_sum(ss) * (1.0f / DM) + EPSN);
#pragma unroll
        for (int j = 0; j < 4; ++j) { const int col = SRC_BF16 ? 8 * lane + 512 * (j >> 1) + 4 * (j & 1) : 4 * lane + 256 * j;
            const f32x4 gg = *(const f32x4*)(g + col), sh = *(const f32x4*)(shift + (size_t)r * 6144 + col), sc = *(const f32x4*)(scale + (size_t)r * 6144 + col);
            const f32x4 y = v[j] * rstd * gg; const f32x4 h = y * (sc + 1.0f) + sh;
            u32x2 w; w.x = pkbf(h.x, h.y); w.y = pkbf(h.z, h.w);
            *(u32x2*)(dst + (size_t)row * DM + col) = w; }
    }
}

__device__ __forceinline__ void qknorm_phase(bf16_t* QKV, const float* qg, const float* kg, const float* tab0, int tid) {
    const long total = (long)MA * 160, stride = (long)gridDim.x * 512;
    for (long idx = (long)blockIdx.x * 512 + tid; idx < total; idx += stride) {
        const int ch = (int)(idx & 7), hd = (int)((idx >> 3) % 20), row = (int)(idx / 160);
        bf16_t* p = QKV + (size_t)row * 1536 + hd * 64 + ch * 8;
        const u32x4 w = *(const u32x4*)p;
        float v[8] = {bf_lo(w.x), bf_hi(w.x), bf_lo(w.y), bf_hi(w.y), bf_lo(w.z), bf_hi(w.z), bf_lo(w.w), bf_hi(w.w)};
        float ss = 0.f;
#pragma unroll
        for (int j = 0; j < 8; ++j) ss += v[j] * v[j];
        ss += __shfl_xor(ss, 1); ss += __shfl_xor(ss, 2); ss += __shfl_xor(ss, 4);
        const float rstd = rsqrtf(ss * (1.0f / 64.0f) + EPSN);
        const float* gp = (hd < 16 ? qg : kg) + ch * 8;
#pragma unroll
        for (int j = 0; j < 8; ++j) v[j] = v[j] * rstd * gp[j];
        float pv[8];
#pragma unroll
        for (int j = 0; j < 8; ++j) pv[j] = __shfl_xor(v[j], 2);
        if (row < MX) {
            const int s = row & (SEQ - 1), pos = (ch & 4) ? (s & 63) : (s >> 6);
            const float* tp = tab0 + ((size_t)pos * 16 + (ch & 1) * 8) * 2;
#pragma unroll
            for (int j = 0; j < 8; ++j) { const float cs = tp[2 * j], sn = tp[2 * j + 1];
                v[j] = (ch & 2) ? (pv[j] * sn + v[j] * cs) : (v[j] * cs - pv[j] * sn); }
        }
        const float qs = hd < 16 ? 0.125f * LOG2E : 1.0f;
        u32x4 o; o.x = pkbf(v[0] * qs, v[1] * qs); o.y = pkbf(v[2] * qs, v[3] * qs); o.z = pkbf(v[4] * qs, v[5] * qs); o.w = pkbf(v[6] * qs, v[7] * qs);
        *(u32x4*)p = o;
    }
}

__device__ __forceinline__ void rope1_phase(bf16_t* Q1, bf16_t* K1, const float* tab1, int tid) {
    const long total = (long)MX * 128, stride = (long)gridDim.x * 512;
    for (long idx = (long)blockIdx.x * 512 + tid; idx < total; idx += stride) {
        const int c8 = (int)(idx & 7), ax = (int)((idx >> 3) & 1), hd = (int)((idx >> 4) & 3), which = (int)((idx >> 6) & 1), row = (int)(idx >> 7);
        bf16_t* p = (which ? K1 : Q1) + (size_t)row * 1024 + hd * 256 + ax * 128 + c8 * 8;
        const u32x4 w1 = *(const u32x4*)p, w2 = *(const u32x4*)(p + 64);
        const float x1[8] = {bf_lo(w1.x), bf_hi(w1.x), bf_lo(w1.y), bf_hi(w1.y), bf_lo(w1.z), bf_hi(w1.z), bf_lo(w1.w), bf_hi(w1.w)};
        const float x2[8] = {bf_lo(w2.x), bf_hi(w2.x), bf_lo(w2.y), bf_hi(w2.y), bf_lo(w2.z), bf_hi(w2.z), bf_lo(w2.w), bf_hi(w2.w)};
        const int s = row & (SEQ - 1), pos = ax ? (s & 63) : (s >> 6);
        const float* tp = tab1 + ((size_t)pos * 64 + c8 * 8) * 2;
        float o1[8], o2[8];
#pragma unroll
        for (int j = 0; j < 8; ++j) { const float cs = tp[2 * j], sn = tp[2 * j + 1]; o1[j] = x1[j] * cs - x2[j] * sn; o2[j] = x1[j] * sn + x2[j] * cs; }
        u32x4 a, b; a.x = pkbf(o1[0], o1[1]); a.y = pkbf(o1[2], o1[3]); a.z = pkbf(o1[4], o1[5]); a.w = pkbf(o1[6], o1[7]);
        b.x = pkbf(o2[0], o2[1]); b.y = pkbf(o2[2], o2[3]); b.z = pkbf(o2[4], o2[5]); b.w = pkbf(o2[6], o2[7]);
        *(u32x4*)p = a; *(u32x4*)(p + 64) = b;
    }
}

__device__ __forceinline__ void gn_phase(bf16_t* Y, const float* gng, int tid) {
    const int lane = tid & 63, gw = blockIdx.x * 8 + (tid >> 6), NGW = gridDim.x * 8;
    for (int it = gw; it < MX * 4; it += NGW) {
        const int row = it >> 2, h = it & 3;
        bf16_t* p = Y + (size_t)row * 2048 + h * 512 + lane * 8;
        const u32x4 w = *(const u32x4*)p;
        float v[8] = {bf_lo(w.x), bf_hi(w.x), bf_lo(w.y), bf_hi(w.y), bf_lo(w.z), bf_hi(w.z), bf_lo(w.w), bf_hi(w.w)};
        float s = 0.f;
#pragma unroll
        for (int j = 0; j < 8; ++j) s += v[j];
        const float mu = wave_sum(s) * (1.0f / 512.0f); float q = 0.f;
#pragma unroll
        for (int j = 0; j < 8; ++j) { v[j] -= mu; q += v[j] * v[j]; }
        const float rstd = rsqrtf(wave_sum(q) * (1.0f / 512.0f) + EPSN);
        const float* gp = gng + h * 512 + lane * 8;
        const f32x4 g0 = *(const f32x4*)gp, g1 = *(const f32x4*)(gp + 4);
        u32x4 o; o.x = pkbf(v[0] * rstd * g0.x, v[1] * rstd * g0.y); o.y = pkbf(v[2] * rstd * g0.z, v[3] * rstd * g0.w);
        o.z = pkbf(v[4] * rstd * g1.x, v[5] * rstd * g1.y); o.w = pkbf(v[6] * rstd * g1.z, v[7] * rstd * g1.w);
        *(u32x4*)p = o;
    }
}

__device__ __forceinline__ f32x16 mfma32(bf16x8 a, bf16x8 b, f32x16 c) { return __builtin_amdgcn_mfma_f32_32x32x16_bf16(a, b, c, 0, 0, 0); }
__device__ __forceinline__ bf16x8 tr_pair(const LAS bf16_t* p0, const LAS bf16_t* p1) {
    const s16x4 a = __builtin_amdgcn_ds_read_tr16_b64_v4i16((LAS s16x4*)p0);
    const s16x4 b = __builtin_amdgcn_ds_read_tr16_b64_v4i16((LAS s16x4*)p1);
    return __builtin_shufflevector(a, b, 0, 1, 2, 3, 4, 5, 6, 7);
}
__device__ __forceinline__ bf16x8 pack8(const f32x16& v, int base) {
    u32x4 w; w.x = pkbf(v[base + 0], v[base + 1]); w.y = pkbf(v[base + 2], v[base + 3]); w.z = pkbf(v[base + 4], v[base + 5]); w.w = pkbf(v[base + 6], v[base + 7]);
    return __builtin_bit_cast(bf16x8, w);
}

constexpr int AKS = 72;
__device__ __forceinline__ void attn_phase(LAS unsigned char* lds, const bf16_t* QKV, bf16_t* O, const float* sink, const float* qg, const float* kg, int tid) {
    const int wid = __builtin_amdgcn_readfirstlane(tid >> 6), lane = tid & 63, r = lane & 31, hh = lane >> 5, blk = (lane >> 4) & 1, q4 = (lane & 15) >> 2, p4 = lane & 3;
    LAS bf16_t* Kl = (LAS bf16_t*)lds;
    LAS bf16_t* Vl = (LAS bf16_t*)(lds + 64 * AKS * 2);
    const int skey = tid >> 3, sch = tid & 7;
    float Bnd;
    { float gq = fabsf(qg[lane]), gk = fabsf(kg[lane]);
#pragma unroll
      for (int o = 1; o < 64; o <<= 1) { gq = fmaxf(gq, __shfl_xor(gq, o)); gk = fmaxf(gk, __shfl_xor(gk, o)); }
      Bnd = 8.0f * LOG2E * 1.02f * gq * gk; }
    for (int u0 = blockIdx.x; u0 < 2304; u0 += gridDim.x) {
        int u = u0;
        if (gridDim.x == 256 && u0 < 2048) { const int x = u0 & 7, idx = (u0 >> 3) & 31, rnd = u0 >> 8; u = ((rnd * 16 + x * 2 + (idx >> 4)) << 4) | (idx & 15); }
        int b, kvh, qb; bool isctx;
        if (u < 2048) { b = u >> 6; kvh = (u >> 4) & 3; qb = u & 15; isctx = false; } else { const int v = u - 2048; b = v >> 3; kvh = (v >> 1) & 3; qb = v & 1; isctx = true; }
        const int hq = kvh * 4 + (wid >> 1);
        const int qloc = qb * 128 + (wid & 1) * 64;
        const size_t qrow0 = isctx ? (size_t)MX + b * CL + qloc : (size_t)b * SEQ + qloc;
        bf16x8 qf[2][4];
#pragma unroll
        for (int qq = 0; qq < 2; ++qq)
#pragma unroll
            for (int s = 0; s < 4; ++s) qf[qq][s] = *(const bf16x8*)(QKV + (qrow0 + 32 * qq + r) * 1536 + (hq >> 2) * 256 + (s >> 1) * 128 + (hq & 3) * 32 + (s & 1) * 16 + 8 * hh);
        const float sl2 = sink[hq] * LOG2E;
        const float psink = hh == 0 ? __builtin_amdgcn_exp2f(sl2 - Bnd) : 0.0f;
        float lrun[2] = {psink, psink};
        f32x16 oacc[2][2];
#pragma unroll
        for (int i = 0; i < 2; ++i)
#pragma unroll
            for (int j = 0; j < 2; ++j)
#pragma unroll
                for (int e = 0; e < 16; ++e) oacc[i][j][e] = 0.f;
        int tlo = 2 - 2 * qb; if (tlo < 0) tlo = 0;
        int thi = 33 - 2 * qb; if (thi > 5) thi = 5;
        const int ntile = isctx ? 4 : 4 + (thi - tlo + 1);
        u32x4 kreg, vreg;
        {   const size_t row = (size_t)MX + b * CL + skey;
            kreg = *(const u32x4*)(QKV + row * 1536 + 1024 + (sch >> 2) * 128 + kvh * 32 + (sch & 3) * 8); vreg = *(const u32x4*)(QKV + row * 1536 + 1280 + kvh * 64 + sch * 8); }
        for (int it = 0; it < ntile; ++it) {
            __syncthreads();
            *(LAS u32x4*)(Kl + skey * AKS + sch * 8) = kreg; *(LAS u32x4*)(Vl + skey * AKS + sch * 8) = vreg;
            __syncthreads();
            if (it + 1 < ntile) { const int nt = it + 1;
                const size_t row = nt < 4 ? (size_t)MX + b * CL + 64 * nt + skey : (size_t)b * SEQ + qb * 128 - 128 + 64 * (tlo + nt - 4) + skey;
                kreg = *(const u32x4*)(QKV + row * 1536 + 1024 + (sch >> 2) * 128 + kvh * 32 + (sch & 3) * 8); vreg = *(const u32x4*)(QKV + row * 1536 + 1280 + kvh * 64 + sch * 8); }
            const int rel = it >= 4 ? (qb * 128 - 128 + 64 * (tlo + it - 4)) - qloc : 0;
            if (rel <= -192 || rel >= 192) continue;
            float nbnd = -Bnd; asm volatile("" : "+v"(nbnd));
            f32x16 st[2][2];
#pragma unroll
            for (int i = 0; i < 2; ++i)
#pragma unroll
                for (int j = 0; j < 2; ++j)
#pragma unroll
                    for (int e = 0; e < 16; ++e) st[i][j][e] = nbnd;
#pragma unroll
            for (int kb = 0; kb < 2; ++kb)
#pragma unroll
                for (int s = 0; s < 4; ++s) { const bf16x8 ka = *(const LAS bf16x8*)(Kl + (32 * kb + r) * AKS + 16 * s + 8 * hh);
                    st[kb][0] = mfma32(ka, qf[0][s], st[kb][0]); st[kb][1] = mfma32(ka, qf[1][s], st[kb][1]); }
            if (rel == -128 || rel == 128) {
                const int kbase = qb * 128 - 128 + 64 * (tlo + it - 4);
#pragma unroll
                for (int kb = 0; kb < 2; ++kb)
#pragma unroll
                    for (int qq = 0; qq < 2; ++qq) { const int qpos = qloc + 32 * qq + r;
#pragma unroll
                        for (int e = 0; e < 16; ++e) { const int key = kbase + 32 * kb + 8 * (e >> 2) + 4 * hh + (e & 3); int d = qpos - key; d = d < 0 ? -d : d;
                            st[kb][qq][e] = d <= 128 ? st[kb][qq][e] : -1e30f; } }
            }
            bf16x8 pf[2][2][2];
#pragma unroll
            for (int qq = 0; qq < 2; ++qq) {
                float ps = 0.f;
#pragma unroll
                for (int kb = 0; kb < 2; ++kb)
#pragma unroll
                    for (int s2 = 0; s2 < 2; ++s2) { float p[8];
#pragma unroll
                        for (int j = 0; j < 8; ++j) { p[j] = __builtin_amdgcn_exp2f(st[kb][qq][8 * s2 + j]); ps += p[j]; }
                        u32x4 w; w.x = pkbf(p[0], p[1]); w.y = pkbf(p[2], p[3]); w.z = pkbf(p[4], p[5]); w.w = pkbf(p[6], p[7]);
                        pf[kb][s2][qq] = __builtin_bit_cast(bf16x8, w); }
                lrun[qq] += ps;
            }
            __builtin_amdgcn_sched_barrier(0);
#pragma unroll
            for (int kb = 0; kb < 2; ++kb)
#pragma unroll
                for (int s2 = 0; s2 < 2; ++s2)
#pragma unroll
                    for (int db = 0; db < 2; ++db) {
                        const LAS bf16_t* vp = Vl + (32 * kb + 16 * s2 + 4 * hh + q4) * AKS + 32 * db + 16 * blk + 4 * p4;
                        const bf16x8 va = tr_pair(vp, vp + 8 * AKS);
                        oacc[db][0] = mfma32(va, pf[kb][s2][0], oacc[db][0]); oacc[db][1] = mfma32(va, pf[kb][s2][1], oacc[db][1]); }
        }
#pragma unroll
        for (int qq = 0; qq < 2; ++qq) {
            const float lt = lrun[qq] + __shfl_xor(lrun[qq], 32), inv = 1.0f / lt;
            bf16_t* op = O + (qrow0 + 32 * qq + r) * 1024 + hq * 64 + 4 * hh;
#pragma unroll
            for (int db = 0; db < 2; ++db)
#pragma unroll
                for (int g = 0; g < 4; ++g) { u32x2 w; w.x = pkbf(oacc[db][qq][4 * g] * inv, oacc[db][qq][4 * g + 1] * inv); w.y = pkbf(oacc[db][qq][4 * g + 2] * inv, oacc[db][qq][4 * g + 3] * inv);
                    *(u32x2*)(op + 32 * db + 8 * g) = w; }
        }
    }
}

constexpr int RS = 136;
__device__ __forceinline__ u32x4 scale8(const u32x4 w, const float f) {
    u32x4 o; o.x = pkbf(bf_lo(w.x) * f, bf_hi(w.x) * f); o.y = pkbf(bf_lo(w.y) * f, bf_hi(w.y) * f); o.z = pkbf(bf_lo(w.z) * f, bf_hi(w.z) * f); o.w = pkbf(bf_lo(w.w) * f, bf_hi(w.w) * f); return o;
}
__device__ __forceinline__ u32x4 add8(const u32x4 a, const u32x4 b) {
    u32x4 o; o.x = pkbf(bf_lo(a.x) + bf_lo(b.x), bf_hi(a.x) + bf_hi(b.x)); o.y = pkbf(bf_lo(a.y) + bf_lo(b.y), bf_hi(a.y) + bf_hi(b.y));
    o.z = pkbf(bf_lo(a.z) + bf_lo(b.z), bf_hi(a.z) + bf_hi(b.z)); o.w = pkbf(bf_lo(a.w) + bf_lo(b.w), bf_hi(a.w) + bf_hi(b.w)); return o;
}
template <int PM> __device__ __forceinline__ f32x16 rmf(bf16x8 a, bf16x8 b, f32x16 c) {
    if (PM == 1) { const u32x4 x = __builtin_bit_cast(u32x4, a), y = __builtin_bit_cast(u32x4, b); c[0] += __builtin_bit_cast(float, (x.x ^ y.x) & 0x3f800000u) + __builtin_bit_cast(float, (x.w ^ y.w) & 0x3f800000u); return c; }
    if (PM == 2) { const bf16x8 k = {0x3c00, 0x3c00, 0x3c00, 0x3c00, 0x3c00, 0x3c00, 0x3c00, 0x3c00}; return __builtin_amdgcn_mfma_f32_32x32x16_bf16(k, k, c, 0, 0, 0); }
    return __builtin_amdgcn_mfma_f32_32x32x16_bf16(a, b, c, 0, 0, 0);
}
template <int PM>
__device__ __forceinline__ void ret_phase(LAS unsigned char* lds, const bf16_t* Q1, const bf16_t* K1, bf16_t* V1, bf16_t* OF, float* gstats, unsigned* gsync, const float* decay_logit, int tid) {
    const int wid = tid >> 6, lane = tid & 63, r = lane & 31, hh = lane >> 5, blk = (lane >> 4) & 1, q4 = (lane & 15) >> 2, p4 = lane & 3;
    LAS bf16_t* QH = (LAS bf16_t*)lds;
    LAS bf16_t* KH = (LAS bf16_t*)(lds + 128 * RS * 2);
    LAS bf16_t* VL = (LAS bf16_t*)(lds + 2 * 128 * RS * 2);
    LAS bf16_t* SL = (LAS bf16_t*)(lds + 3 * 128 * RS * 2);
    LAS bf16_t* OL = KH;
    const int eb = wid & 3, dg = wid >> 2, nb = wid >> 1, mg = wid & 1;
    const int o_row = r * RS + 8 * hh;
    const int o_tr = (8 * hh + q4) * RS + 16 * blk + 4 * p4;
    const int sn = tid >> 4, scc = tid & 15;
    unsigned* gctr = (gsync != nullptr && gridDim.x == 256) ? gsync + ((blockIdx.x & 7) * 8 + ((blockIdx.x >> 5) & 7)) * 64 : nullptr;
    unsigned gtarget = 0u;
    for (int u0 = blockIdx.x; u0 < 512; u0 += gridDim.x) {
        int u = u0;
        if (gridDim.x == 256) { const int x = u0 & 7, idx = (u0 >> 3) & 31, rnd = u0 >> 8; u = ((rnd * 64 + x * 8 + (idx >> 2)) << 2) | (idx & 3); }
        const int b = u >> 4, h = (u >> 2) & 3, sl = u & 3;
        for (int dir = 0; dir < 2; ++dir) {
            const float logit = decay_logit[dir * 4 + h];
            const float lg2 = -log1pf(__expf(-logit)) * LOG2E;
            const float cd = exp2f(lg2 * 128.0f);
            f32x16 S[2][2];
#pragma unroll
            for (int i = 0; i < 2; ++i)
#pragma unroll
                for (int j = 0; j < 2; ++j)
#pragma unroll
                    for (int e = 0; e < 16; ++e) S[i][j][e] = 0.f;
            u32x4 rq[4], rk[4], rv[4];
#define RET_ROFF(i) (dir ? 127 - (sn + 32 * (i)) : (sn + 32 * (i)))
#define RET_ROFF2(i) (dir ? 127 - (sn2_ + 32 * (i)) : (sn2_ + 32 * (i)))
#define RET_TOK(base, i) ((base) + (size_t)RET_ROFF(i))
#define RET_LOAD_QK(stp, dhp) do { const bool cx_ = (stp) < 2; const int ci_ = cx_ ? (dir ? 1 - (stp) : (stp)) : (dir ? 17 - (stp) : (stp) - 2); \
        const size_t rb_ = cx_ ? (size_t)MX + b * CL + ci_ * 128 : (size_t)b * SEQ + ci_ * 128; \
        const bf16_t* qp_ = Q1 + rb_ * 1024 + h * 256 + (dhp) * 128; const bf16_t* kp_ = K1 + rb_ * 1024 + h * 256 + (dhp) * 128; \
        int sn2_ = sn; asm volatile("" : "+v"(sn2_)); \
        _Pragma("unroll") for (int i_ = 0; i_ < 4; ++i_) { const int o_ = RET_ROFF2(i_) * 1024 + scc * 8; \
            if (PM == 3) { rq[i_] = (u32x4){0x3c003c00u, 0x3c003c00u, 0x3c003c00u, 0x3c003c00u}; rk[i_] = rq[i_]; } else { \
            if (!cx_) rq[i_] = *(const u32x4*)(qp_ + o_); \
            rk[i_] = *(const u32x4*)(kp_ + o_); } } } while (0)
#define RET_LOAD_V(stp) do { const bool cx_ = (stp) < 2; const int ci_ = cx_ ? (dir ? 1 - (stp) : (stp)) : (dir ? 17 - (stp) : (stp) - 2); \
        const size_t rb_ = cx_ ? (size_t)MX + b * CL + ci_ * 128 : (size_t)b * SEQ + ci_ * 128; \
        const bf16_t* vp_ = V1 + rb_ * 2048 + h * 512 + sl * 128; \
        int sn2_ = sn; asm volatile("" : "+v"(sn2_)); \
        _Pragma("unroll") for (int i_ = 0; i_ < 4; ++i_) { const int o_ = RET_ROFF2(i_) * 2048 + scc * 8; if (PM == 3) rv[i_] = (u32x4){0x3c003c00u, 0x3c003c00u, 0x3c003c00u, 0x3c003c00u}; else rv[i_] = *(const u32x4*)(vp_ + o_); } } while (0)
            RET_LOAD_QK(0, 0); RET_LOAD_V(0);
            for (int st = 0; st < 18; ++st) {
                const bool isctx = st < 2;
                const int cidx = isctx ? (dir ? 1 - st : st) : (dir ? 17 - st : st - 2);
                gtarget += 4u;
                if (gctr != nullptr && tid == 0) { __hip_atomic_fetch_add(gctr, 1u, __ATOMIC_RELAXED, __HIP_MEMORY_SCOPE_AGENT);
                    for (int sp = 0; sp < 48 && __hip_atomic_load(gctr, __ATOMIC_RELAXED, __HIP_MEMORY_SCOPE_AGENT) < gtarget; ++sp) __builtin_amdgcn_s_sleep(2); }
                int r_l = r, hh_l = hh, sn_l = sn; float lg2_l = lg2; asm volatile("" : "+v"(r_l), "+v"(hh_l), "+v"(sn_l), "+v"(lg2_l));
                f32x16 sc[2], out[2];
#pragma unroll
                for (int i = 0; i < 2; ++i)
#pragma unroll
                    for (int e = 0; e < 16; ++e) { sc[i][e] = 0.f; out[i][e] = 0.f; }
#pragma unroll
                for (int dh = 0; dh < 2; ++dh) {
                    if (PM != 4) __syncthreads();
#pragma unroll
                    for (int i = 0; i < 4; ++i) { const int n = sn_l + 32 * i;
                        if (!isctx) *(LAS u32x4*)(QH + n * RS + scc * 8) = rq[i];
                        *(LAS u32x4*)(KH + n * RS + scc * 8) = rk[i];
                        if (dh == 0) *(LAS u32x4*)(VL + n * RS + scc * 8) = scale8(rv[i], 0.0625f * __builtin_amdgcn_exp2f(-lg2_l * (float)(n + 1))); }
                    if (!isctx) {
#pragma unroll
                        for (int i = 0; i < 2; ++i)
#pragma unroll
                            for (int g = 0; g < 4; ++g) { u32x2 w; w.x = pkbf(S[dh][i][4 * g], S[dh][i][4 * g + 1]); w.y = pkbf(S[dh][i][4 * g + 2], S[dh][i][4 * g + 3]);
                                *(LAS u32x2*)(SL + (32 * eb + r) * RS + 32 * (2 * dg + i) + 8 * g + 4 * hh) = w; }
                    }
                    if (PM != 4) __syncthreads();
                    if (dh == 0) RET_LOAD_QK(st, 1); else if (st + 1 < 18) RET_LOAD_QK(st + 1, 0);
                    if (!isctx) {
                        if (2 * mg <= nb) {
                            const bool two = 2 * mg + 1 <= nb;
#pragma unroll 2
                            for (int s = 0; s < 8; ++s) {
                                const bf16x8 qb_ = *(const LAS bf16x8*)(QH + o_row + 32 * nb * RS + 16 * s);
                                const bf16x8 k0 = *(const LAS bf16x8*)(KH + o_row + 32 * (2 * mg) * RS + 16 * s);
                                sc[0] = rmf<PM>(k0, qb_, sc[0]);
                                if (two) { const bf16x8 k1 = *(const LAS bf16x8*)(KH + o_row + 32 * (2 * mg + 1) * RS + 16 * s); sc[1] = rmf<PM>(k1, qb_, sc[1]); } }
                        }
#pragma unroll 2
                        for (int s = 0; s < 8; ++s) {
                            const bf16x8 sb = *(const LAS bf16x8*)(SL + o_row + 32 * eb * RS + 16 * s);
                            const bf16x8 q0 = *(const LAS bf16x8*)(QH + o_row + 32 * (2 * dg) * RS + 16 * s), q1 = *(const LAS bf16x8*)(QH + o_row + 32 * (2 * dg + 1) * RS + 16 * s);
                            out[0] = rmf<PM>(sb, q0, out[0]); out[1] = rmf<PM>(sb, q1, out[1]); }
                    }
#pragma unroll 2
                    for (int s = 0; s < 8; ++s) {
                        const LAS bf16_t* vp = VL + o_tr + 16 * s * RS + 32 * eb;
                        const bf16x8 vb = tr_pair(vp, vp + 4 * RS);
                        const LAS bf16_t* kp = KH + o_tr + 16 * s * RS + 32 * (2 * dg);
                        const bf16x8 ka0 = tr_pair(kp, kp + 4 * RS), ka1 = tr_pair(kp + 32, kp + 32 + 4 * RS);
                        S[dh][0] = rmf<PM>(ka0, vb, S[dh][0]); S[dh][1] = rmf<PM>(ka1, vb, S[dh][1]); }
                }
                if (!isctx) {
                    if (PM != 4) __syncthreads();
#pragma unroll
                    for (int i = 0; i < 2; ++i) { const bool diag = (2 * mg + i) == nb;
#pragma unroll
                        for (int g = 0; g < 4; ++g) { const int n = 32 * nb + r_l, m0 = 32 * (2 * mg + i) + 8 * g + 4 * hh_l;
                            float v0 = sc[i][4 * g], v1 = sc[i][4 * g + 1], v2 = sc[i][4 * g + 2], v3 = sc[i][4 * g + 3];
                            if (diag) { v0 = n >= m0 ? v0 : 0.f; v1 = n >= m0 + 1 ? v1 : 0.f; v2 = n >= m0 + 2 ? v2 : 0.f; v3 = n >= m0 + 3 ? v3 : 0.f; }
                            u32x2 w; w.x = pkbf(v0, v1); w.y = pkbf(v2, v3); *(LAS u32x2*)(QH + n * RS + m0) = w; } }
                    if (PM != 4) __syncthreads();
                }
                if (isctx) RET_LOAD_V(st + 1);
                if (!isctx) {
#pragma unroll 2
                    for (int s = 0; s < 4 * dg + 2; ++s) {
                        const LAS bf16_t* vp = VL + o_tr + 16 * s * RS + 32 * eb;
                        const bf16x8 vb = tr_pair(vp, vp + 4 * RS);
                        const bf16x8 p0 = *(const LAS bf16x8*)(QH + o_row + 32 * (2 * dg) * RS + 16 * s), p1 = *(const LAS bf16x8*)(QH + o_row + 32 * (2 * dg + 1) * RS + 16 * s);
                        out[0] = rmf<PM>(vb, p0, out[0]); out[1] = rmf<PM>(vb, p1, out[1]); }
#pragma unroll 2
                    for (int s = 4 * dg + 2; s < 4 * dg + 4; ++s) {
                        const LAS bf16_t* vp = VL + o_tr + 16 * s * RS + 32 * eb;
                        const bf16x8 vb = tr_pair(vp, vp + 4 * RS);
                        const bf16x8 p1 = *(const LAS bf16x8*)(QH + o_row + 32 * (2 * dg + 1) * RS + 16 * s);
                        out[1] = rmf<PM>(vb, p1, out[1]); }
#pragma unroll
                    for (int i = 0; i < 2; ++i) { const int n = 32 * (2 * dg + i) + r_l; const float f = __builtin_amdgcn_exp2f(lg2_l * (float)(n + 1));
#pragma unroll
                        for (int g = 0; g < 4; ++g) { u32x2 w; w.x = pkbf(out[i][4 * g] * f, out[i][4 * g + 1] * f); w.y = pkbf(out[i][4 * g + 2] * f, out[i][4 * g + 3] * f);
                            *(LAS u32x2*)(OL + n * RS + 32 * eb + 8 * g + 4 * hh_l) = w; } }
                    if (st + 1 < 18) RET_LOAD_V(st + 1);
                    if (PM != 4) __syncthreads();
                    const size_t lb = ((size_t)b * SEQ + cidx * 128) * 2048 + h * 512 + sl * 128;
                    bf16_t* ofb = OF + lb; bf16_t* vob = V1 + lb;
#pragma unroll
                    for (int i = 0; i < 4; ++i) { const int n = sn_l + 32 * i; const int off = (dir ? 127 - n : n) * 2048 + scc * 8;
                        const u32x4 v = *(const LAS u32x4*)(OL + n * RS + scc * 8);
                        if (dir == 0) *(u32x4*)(ofb + off) = v;
                        else { const u32x4 o = *(const u32x4*)(ofb + off);
                            const float t0 = bf_lo(v.x) + bf_lo(o.x), t1 = bf_hi(v.x) + bf_hi(o.x), t2 = bf_lo(v.y) + bf_lo(o.y), t3 = bf_hi(v.y) + bf_hi(o.y), t4 = bf_lo(v.z) + bf_lo(o.z), t5 = bf_hi(v.z) + bf_hi(o.z), t6 = bf_lo(v.w) + bf_lo(o.w), t7 = bf_hi(v.w) + bf_hi(o.w);
                            u32x4 w; w.x = pkbf(t0, t1); w.y = pkbf(t2, t3); w.z = pkbf(t4, t5); w.w = pkbf(t6, t7); *(u32x4*)(vob + off) = w;
                            float s0 = ((t0 + t1) + (t2 + t3)) + ((t4 + t5) + (t6 + t7)), s1 = ((t0 * t0 + t1 * t1) + (t2 * t2 + t3 * t3)) + ((t4 * t4 + t5 * t5) + (t6 * t6 + t7 * t7));
#pragma unroll
                            for (int o2 = 1; o2 < 16; o2 <<= 1) { s0 += __shfl_xor(s0, o2); s1 += __shfl_xor(s1, o2); }
                            if (scc == 0) { const int ro_ = dir ? 127 - (sn_l + 32 * i) : (sn_l + 32 * i); float* gp = gstats + ((size_t)b * SEQ + cidx * 128) * 8 + h * 2 + ro_ * 8; atomicAdd(gp, s0); atomicAdd(gp + 1, s1); } }
                        asm volatile("" ::: "memory"); }
                }
#pragma unroll
                for (int i = 0; i < 2; ++i)
#pragma unroll
                    for (int j = 0; j < 2; ++j)
#pragma unroll
                        for (int e = 0; e < 16; ++e) S[i][j][e] *= cd;
            }
#undef RET_TOK
#undef RET_ROFF
#undef RET_ROFF2
#undef RET_LOAD_QK
#undef RET_LOAD_V
        }
    }
}

#define XB_TMO      128
#define XB_XCNT(j)  (256  + 64 * (j))
#define XB_XSUB(j)  (1280 + 64 * (j))
#define XB_XGEN(j)  (2304 + 64 * (j))
#define XB_TOP      3328
#define XB_TOPGEN   3392
#define XCD_BAR_WORDS 3456
#define XB_SPIN_CAP (1u << 18)

__device__ __forceinline__ unsigned xb_ld(unsigned* p)              { return __hip_atomic_load(p, __ATOMIC_RELAXED, __HIP_MEMORY_SCOPE_AGENT); }
__device__ __forceinline__ unsigned xb_add(unsigned* p, unsigned v) { return __hip_atomic_fetch_add(p, v, __ATOMIC_RELAXED, __HIP_MEMORY_SCOPE_AGENT); }
__device__ __forceinline__ unsigned xb_xcc_id() { return (unsigned)__builtin_amdgcn_s_getreg((3 << 11) | 20) & 0xFu; }
#define XB_SPIN(cond, bar) do { unsigned _sp = 0; while (cond) { __builtin_amdgcn_s_sleep(1); \
    if ((++_sp & 255u) == 0u) { if (xb_ld(&(bar)[XB_TMO])) break; if (_sp > XB_SPIN_CAP) { atomicAdd(&(bar)[XB_TMO], 1u); break; } } } } while (0)

struct XcdBarrier {
    unsigned* bar; unsigned x;
    volatile LAS unsigned* st;
};

__device__ __forceinline__ XcdBarrier xcd_barrier_post(unsigned* bar, volatile LAS unsigned* st) {
    XcdBarrier b; b.bar = bar; b.x = xb_xcc_id(); b.st = st;
    if (threadIdx.x == 0) (void)xb_add(&bar[XB_XCNT(b.x)], 1u);
    return b;
}
__device__ __forceinline__ void xcd_barrier_complete(unsigned* bar, unsigned x, unsigned& nloc, unsigned& nx) {
    const unsigned G = gridDim.x * gridDim.y * gridDim.z;
    unsigned sum, cnt, mine, sp = 0u;
    for (;;) {
        sum = 0u; cnt = 0u; mine = 0u;
#pragma unroll
        for (unsigned j = 0; j < 16; ++j) { const unsigned c = xb_ld(&bar[XB_XCNT(j)]); sum += c; cnt += (c > 0u) ? 1u : 0u; mine = (j == x) ? c : mine; }
        if (sum == G) break;
        __builtin_amdgcn_s_sleep(1);
        if ((++sp & 255u) == 0u) { if (xb_ld(&bar[XB_TMO])) break; if (sp > XB_SPIN_CAP) { atomicAdd(&bar[XB_TMO], 1u); break; } }
    }
    nloc = mine > 0u ? mine : 1u; nx = cnt > 0u ? cnt : 1u;
}

__device__ __forceinline__ void xcd_barrier(const XcdBarrier& b) {
    asm volatile("s_waitcnt vmcnt(0)" ::: "memory");
    __syncthreads();
    if (threadIdx.x == 0) {
        unsigned* bar = b.bar;
        __builtin_amdgcn_s_waitcnt(0);
        unsigned nloc = b.st[0], nx = b.st[1];
        if (nloc == 0u) { xcd_barrier_complete(bar, b.x, nloc, nx); b.st[0] = nloc; b.st[1] = nx; }
        const unsigned old = xb_add(&bar[XB_XSUB(b.x)], 1u);
        const unsigned gen = old / nloc;
        if (old + 1u == (gen + 1u) * nloc) {
            __builtin_amdgcn_fence(__ATOMIC_RELEASE, "agent");
            asm volatile("s_waitcnt vmcnt(0)" ::: "memory");
            const unsigned og = xb_add(&bar[XB_TOP], 1u);
            const unsigned tg = og / nx;
            if (og + 1u == (tg + 1u) * nx) xb_add(&bar[XB_TOPGEN], 1u);
            else XB_SPIN(xb_ld(&bar[XB_TOPGEN]) == tg, bar);
            __builtin_amdgcn_fence(__ATOMIC_ACQUIRE, "agent");
            xb_add(&bar[XB_XGEN(b.x)], 1u);
            asm volatile("s_waitcnt vmcnt(0)" ::: "memory");
        } else {
            XB_SPIN(xb_ld(&bar[XB_XGEN(b.x)]) == gen, bar);
            __builtin_amdgcn_fence(__ATOMIC_ACQUIRE, "agent");
            asm volatile("s_waitcnt vmcnt(0)" ::: "memory");
        }
    }
    __syncthreads();
}

__global__ void __launch_bounds__(512, 2) mega_fwd(Args a) {
    extern __shared__ __attribute__((aligned(16))) unsigned char lds_raw[];
    LAS unsigned char* lds = (LAS unsigned char*)lds_raw;
    cg::grid_group grid = cg::this_grid();
    volatile LAS unsigned* xb_st = (volatile LAS unsigned*)(lds + XB_LDS_OFF);
    if (threadIdx.x < 4) xb_st[threadIdx.x] = 0u;
    __syncthreads();
    const XcdBarrier xbar = xcd_barrier_post((unsigned*)(a.ws + WS_BAR), xb_st);
    unsigned char* const ws = a.ws;
    const int lo = a.ph_lo, hi = a.ph_hi;
#ifndef NO_RET
#define NO_RET 0
#endif
#ifndef NO_ATTN
#define NO_ATTN 0
#endif
#ifndef NO_GEMM
#define NO_GEMM 0
#endif
#define IN(k) (lo <= (k) && (k) < hi)
#define TID ({ int t_ = threadIdx.x; asm volatile("" : "+v"(t_)); t_; })
#define SYNC(k) do { if (lo <= (k) && (k) + 1 < hi) { if ((k) == 0) grid.sync(); else xcd_barrier(xbar); } } while (0)
#define MODP ((float*)(ws + WS_MOD))
#define BF(off) ((bf16_t*)(ws + (off)))
#define GEMM(EpiT, Aoff, Boff, M_, N_, K_, E) do { const pg8::Gemm g_{BF(Aoff), BF(Boff), (M_), (N_), (K_)}; pg8::StaticOrder S_; S_.init((M_), (N_), (int)gridDim.x, (int)blockIdx.x); \
        if (!NO_GEMM) pg8::gemm_phase<EpiT, pg8::StaticOrder, PG8_ALIGN, PG8_SP2>(lds, g_, S_, E); } while (0)
    if (IN(0)) { phase0(a, lds, TID); } SYNC(0);
    if (IN(1)) { norm_phase<false>(a.in[0], a.in[2], nullptr, a.in[6], MODP, MODP + 1024, MA, BF(WS_H), TID); } SYNC(1);
    if (IN(2)) { const EpiQKV0 e{BF(WS_QKV0), a.in[11], a.in[12], (const float*)(ws + WS_TAB0)}; GEMM(EpiQKV0, WS_H, WS_WQKV0, MA, 1536, 1024, e); } SYNC(2);
    if (IN(3) && !NO_ATTN) { attn_phase(lds, BF(WS_QKV0), BF(WS_H), a.in[13], a.in[11], a.in[12], TID); } SYNC(3);
    if (IN(4)) { const EpiResid<0> e{a.in[0], a.in[2], BF(WS_X), nullptr, MODP + 2048}; GEMM(EpiResid<0>, WS_H, WS_WO0, MA, 1024, 1024, e); } SYNC(4);
    if (IN(5)) { norm_phase<true>(nullptr, nullptr, BF(WS_X), a.in[7], MODP + 3072, MODP + 4096, MA, BF(WS_H), TID); } SYNC(5);
    if (IN(6)) { const EpiSwiglu e{BF(WS_ACT0)}; GEMM(EpiSwiglu, WS_H, WS_WIN0, MA, 5632, 1024, e); } SYNC(6);
    if (IN(7)) { const EpiResid<1> e{nullptr, nullptr, BF(WS_X), nullptr, MODP + 5120}; GEMM(EpiResid<1>, WS_ACT0, WS_WOUT0, MA, 1024, 2816, e); } SYNC(7);
    if (IN(8)) { norm_phase<true>(nullptr, nullptr, BF(WS_X), a.in[6] + 1024, MODP + 33 * 6144, MODP + 33 * 6144 + 1024, MA, BF(WS_HL1), TID); } SYNC(8);
    if (IN(9)) { const EpiQKV1 e{BF(WS_Q1), BF(WS_K1), BF(WS_V1), (const float*)(ws + WS_TAB1)}; GEMM(EpiQKV1, WS_HL1, WS_WR, MA, 4096, 1024, e); } SYNC(9);
    if (IN(10) && !NO_RET) { ret_phase<0>(lds, BF(WS_Q1), BF(WS_K1), BF(WS_V1), (bf16_t*)a.out, (float*)(ws + WS_GNS), nullptr, a.in[16], TID); } SYNC(10);
    if (IN(11)) { const EpiGate e{BF(WS_V1), (const float*)(ws + WS_GNS), a.in[17]}; GEMM(EpiGate, WS_HL1, WS_WR + (size_t)4096 * 1024 * 2, MX, 2048, 1024, e); } SYNC(11);
    if (IN(12)) { const EpiResid<1> e{nullptr, nullptr, BF(WS_X), nullptr, MODP + 33 * 6144 + 2048}; GEMM(EpiResid<1>, WS_V1, WS_WRO, MX, 1024, 2048, e); } SYNC(12);
    if (IN(13)) { norm_phase<true>(nullptr, nullptr, BF(WS_X), a.in[7] + 1024, MODP + 33 * 6144 + 3072, MODP + 33 * 6144 + 4096, MX, BF(WS_Q1), TID); } SYNC(13);
    if (IN(14)) { const EpiSwiglu e{BF(WS_ACT1)}; GEMM(EpiSwiglu, WS_Q1, WS_WIN1, MX, 5632, 1024, e); } SYNC(14);
    if (IN(15)) { const EpiResid<2> e{nullptr, nullptr, BF(WS_X), a.out, MODP + 33 * 6144 + 5120}; GEMM(EpiResid<2>, WS_ACT1, WS_WOUT1, MX, 1024, 2816, e); }
#ifdef PROBE_UP1
    grid.sync();
    { const EpiSwiglu e{BF(WS_ACT1)}; GEMM(EpiSwiglu, WS_Q1, WS_WIN1, MX, 5632, 1024, e); }
#endif
#ifdef PROBE_RET
    grid.sync();
    ret_phase<PROBE_RET - 1>(lds, BF(WS_Q1), BF(WS_K1), BF(WS_V1), BF(WS_V1), (float*)(ws + WS_GNS), nullptr, a.in[16], TID);
#endif
#ifdef PROBE_SYNC
    for (int i = 0; i < 20; ++i) grid.sync();
#endif
#ifdef PROBE_RESID
    grid.sync();
    { const EpiResid<1> e{nullptr, nullptr, BF(WS_HL1), nullptr, MODP + 33 * 6144 + 2048}; GEMM(EpiResid<1>, WS_V1, WS_WRO, MX, 1024, 2048, e); }
    grid.sync();
    { const EpiResid<1> e{nullptr, nullptr, BF(WS_HL1), nullptr, MODP + 33 * 6144 + 5120}; GEMM(EpiResid<1>, WS_ACT1, WS_WOUT1, MX, 1024, 2816, e); }
#endif
#ifdef PROBE_NORM
    grid.sync();
    norm_phase<true>(nullptr, nullptr, BF(WS_X), a.in[7] + 1024, MODP + 33 * 6144 + 3072, MODP + 33 * 6144 + 4096, MX, BF(WS_Q1), TID);
    grid.sync();
    phase0(a, lds, TID);
#endif
}


#ifndef MK_MULTI
#define MK_MULTI 0
#endif
extern "C" void kernel_launch(void* const* d_in, const int* in_sizes, int n_in, void* d_out, int out_size, void* d_ws, size_t ws_size, hipStream_t stream) {
    static int grid = 0;
    if (grid == 0) {
        int dev = 0, cus = 0, per_cu = 0;
        (void)hipGetDevice(&dev); (void)hipDeviceGetAttribute(&cus, hipDeviceAttributeMultiprocessorCount, dev);
        if (hipFuncSetAttribute((const void*)mega_fwd, hipFuncAttributeMaxDynamicSharedMemorySize, LDS_BYTES) != hipSuccess) fprintf(stderr, "kernel_launch: hipFuncSetAttribute failed\n");
        if (hipOccupancyMaxActiveBlocksPerMultiprocessor(&per_cu, (const void*)mega_fwd, 512, LDS_BYTES) != hipSuccess || per_cu < 1) { fprintf(stderr, "kernel_launch: occupancy query says %d blocks/CU\n", per_cu); per_cu = 1; }
        (void)hipGetLastError();
        grid = cus > 0 ? cus : 256;
        if (n_in != 19 || ws_size < WS_END) fprintf(stderr, "kernel_launch: unexpected n_in %d / ws_size %zu (need %zu)\n", n_in, ws_size, (size_t)WS_END);
    }
    (void)hipMemsetAsync((unsigned char*)d_ws + WS_BAR, 0, 65536, stream);
    Args a{};
    for (int i = 0; i < 19; ++i) a.in[i] = (const float*)d_in[i];
    a.out = (float*)d_out; a.ws = (unsigned char*)d_ws;
#if MK_MULTI
    for (int ph = 0; ph < NPHASE; ++ph) { a.ph_lo = ph; a.ph_hi = ph + 1; hipLaunchKernelGGL(mega_fwd, dim3(grid), dim3(512), LDS_BYTES, stream, a); }
#else
    a.ph_lo = 0; a.ph_hi = NPHASE;
    void* args[] = {&a};
    const hipError_t e = hipLaunchCooperativeKernel((const void*)mega_fwd, dim3(grid), dim3(512), args, LDS_BYTES, stream);
    if (e != hipSuccess) fprintf(stderr, "kernel_launch: cooperative launch failed: %s (grid %d)\n", hipGetErrorString(e), grid);
#endif
}
```

```cpp
#include <hip/hip_runtime.h>
#include <hip/hip_cooperative_groups.h>
#include <cstdio>
#include <cstdint>
namespace cg = cooperative_groups;

namespace pg8 {
#define PG8_LAS __attribute__((address_space(3)))
typedef unsigned short bf16_t;
typedef short bf16x8 __attribute__((ext_vector_type(8)));
typedef float f32x4 __attribute__((ext_vector_type(4)));
typedef unsigned u32x4 __attribute__((ext_vector_type(4)));
constexpr int BM = 256, BK = 64, HALF = 128, HTB = HALF * BK * 2  , STAGE_BYTES = 8 * HTB, NXCD = 8, WGM = 8;

__host__ __device__ __forceinline__ int lds_byte(int r, int c) { const int st = (r >> 4) * 2 + (c >> 5), rr = r & 15, cc = c & 31, ob = rr * 64 + cc * 2; return st * 1024 + (ob ^ (((ob >> 9) & 1) << 5)); }
__host__ __device__ __forceinline__ void stage_rc(int b, int& R, int& C) { const int st = b / 1024, sb = b % 1024, swz = sb ^ (((sb >> 9) & 1) << 5); R = (st >> 1) * 16 + swz / 64; C = (st & 1) * 32 + (swz % 64) / 2; }
__host__ __device__ __forceinline__ int perm32(int rho) { const int n = rho >> 4, i = rho & 15; return 8 * (i >> 2) + 4 * n + (i & 3); }

struct Unit { int pm, pn; };
struct Gemm { const bf16_t* A; const bf16_t* Bt; int M, N, K; };

struct StaticOrder {
    int nM, nN, nwg, G, c;
    __host__ __device__ void init(int M, int N, int G_, int c_) { nM = M / BM; nN = N / BM; nwg = nM * nN; G = G_; c = c_; }
    __host__ __device__ bool next(int i, Unit& u) const {
        const long L = (long)i * G + c; if (L >= nwg) return false;
        int wgid = (int)L; { const int q = nwg / NXCD, r = nwg % NXCD, xcd = wgid % NXCD, off = wgid / NXCD; wgid = (xcd < r ? xcd * (q + 1) : r * (q + 1) + (xcd - r) * q) + off; }
        const int nig = WGM * nN, gid = wgid / nig, fm = gid * WGM, gsz = (nM - fm) < WGM ? (nM - fm) : WGM;
        u.pm = fm + ((wgid % nig) % gsz); u.pn = (wgid % nig) / gsz; return true;
    }
    __device__ __forceinline__ void a_ready(const Unit&) const {}
    __device__ __forceinline__ void done(const Unit&) const {}
};

__device__ __forceinline__ unsigned cvt_pk_bf16(float lo, float hi) { unsigned r; asm volatile("v_cvt_pk_bf16_f32 %0, %1, %2" : "=v"(r) : "v"(lo), "v"(hi)); return r; }
typedef float f32x2 __attribute__((ext_vector_type(2)));
template <class Epi, class Sched, bool ALIGN_EPI = false, bool SP2 = false>
__device__ __forceinline__ void gemm_phase(PG8_LAS unsigned char* lds, const Gemm g, const Sched& S, const Epi& E) {
    int tid_l = threadIdx.x; asm volatile("" : "+v"(tid_l));
    const int tid = tid_l, wid = __builtin_amdgcn_readfirstlane(tid >> 6), lane = tid & 63, wr = wid >> 2, wc = wid & 3, fr = lane & 15, fq = lane >> 4;
    const int K = g.K, nt = K / BK;
    unsigned voffA[2], voffB[2];
#pragma unroll
    for (int i = 0; i < 2; ++i) { int R, C; stage_rc(tid * 16 + i * 8192, R, C); const int Rb = Epi::PERM ? ((R & ~31) + perm32(R & 31)) : R;
        voffA[i] = (unsigned)(R * K + C) * 2u; voffB[i] = (unsigned)(Rb * K + C) * 2u; }
    const size_t kstep = (size_t)(BK * 2);
    const size_t hstep = (size_t)HALF * K * 2;
    const size_t tstep = 2 * hstep;
    const unsigned ldsw = (unsigned)wid * 1024u;
    const int aoff = lds_byte(wr * 64 + fr, fq * 8), boff = lds_byte(wc * 32 + fr, fq * 8);
#define PG8_SA(b, h) (((b) * 2 + (h)) * HTB)
#define PG8_SB(b, h) ((4 + (b) * 2 + (h)) * HTB)
#define PG8_STAGE(bufoff, gbase, voff) do { _Pragma("unroll") for (int _i = 0; _i < 2; ++_i) \
        __builtin_amdgcn_global_load_lds((const unsigned*)((const char*)(gbase) + (voff)[_i]), (PG8_LAS unsigned*)(lds + (bufoff) + ldsw + _i * 8192), 16, 0, 0); } while (0)
#define PG8_LDA(dst, b, h) do { _Pragma("unroll") for (int m = 0; m < 4; ++m) _Pragma("unroll") for (int k = 0; k < 2; ++k) dst[m][k] = *(const PG8_LAS bf16x8*)(lds + PG8_SA(b, h) + aoff + m * 2048 + k * 1024); } while (0)
#define PG8_LDB(dst, b, h) do { _Pragma("unroll") for (int n = 0; n < 2; ++n) _Pragma("unroll") for (int k = 0; k < 2; ++k) dst[n][k] = *(const PG8_LAS bf16x8*)(lds + PG8_SB(b, h) + boff + n * 2048 + k * 1024); } while (0)
#define PG8_MMA(ai, bj, At, Bt) do { __builtin_amdgcn_s_setprio(1); _Pragma("unroll") for (int m = 0; m < 4; ++m) _Pragma("unroll") for (int n = 0; n < 2; ++n) _Pragma("unroll") for (int k = 0; k < 2; ++k) \
        acc[ai][bj][m][n] = __builtin_amdgcn_mfma_f32_16x16x32_bf16(Bt[n][k], At[m][k], acc[ai][bj][m][n], 0, 0, 0); __builtin_amdgcn_s_setprio(0); } while (0)
#define PG8_WAIT_V(n) asm volatile("s_waitcnt vmcnt(" #n ")" ::: "memory")
#define PG8_WAIT_L(n) asm volatile("s_waitcnt lgkmcnt(" #n ")" ::: "memory")
#define PG8_BAR __builtin_amdgcn_s_barrier()
#define PG8_SCHED __builtin_amdgcn_sched_barrier(0)
    Unit cur, nxt; int ui = 0;
    if (!S.next(0, cur)) return;
    f32x4 acc[2][2][4][2];
#pragma unroll
    for (int a = 0; a < 2; ++a)
#pragma unroll
        for (int b = 0; b < 2; ++b)
#pragma unroll
            for (int m = 0; m < 4; ++m)
#pragma unroll
                for (int n = 0; n < 2; ++n) acc[a][b][m][n] = (f32x4){0.f, 0.f, 0.f, 0.f};
    bf16x8 At[4][2], B0[2][2], B1[2][2];
    const char* cA = (const char*)g.A + (size_t)cur.pm * tstep; const char* cB = (const char*)g.Bt + (size_t)cur.pn * tstep;
    S.a_ready(cur);
    if constexpr (SP2) {
        PG8_STAGE(PG8_SB(0, 0), cB, voffB); PG8_STAGE(PG8_SB(0, 1), cB + hstep, voffB); PG8_STAGE(PG8_SA(0, 0), cA, voffA); PG8_STAGE(PG8_SA(0, 1), cA + hstep, voffA);
        if (wr == 1) PG8_BAR;
        PG8_WAIT_V(2); PG8_BAR;
        PG8_STAGE(PG8_SB(1, 0), cB + kstep, voffB); PG8_STAGE(PG8_SA(1, 0), cA + kstep, voffA); PG8_STAGE(PG8_SB(1, 1), cB + hstep + kstep, voffB);
        PG8_WAIT_V(6); PG8_BAR;
    } else {
        PG8_STAGE(PG8_SB(0, 0), cB, voffB); PG8_STAGE(PG8_SA(0, 0), cA, voffA); PG8_STAGE(PG8_SB(0, 1), cB + hstep, voffB); PG8_STAGE(PG8_SA(0, 1), cA + hstep, voffA);
        if (wr == 1) PG8_BAR;
        PG8_WAIT_V(4); PG8_BAR;
        PG8_STAGE(PG8_SB(1, 0), cB + kstep, voffB); PG8_STAGE(PG8_SA(1, 0), cA + kstep, voffA); PG8_STAGE(PG8_SB(1, 1), cB + hstep + kstep, voffB);
        PG8_WAIT_V(6); PG8_BAR;
    }
    for (;;) {
        const bool has_next = S.next(ui + 1, nxt);
        const char* nA = has_next ? (const char*)g.A + (size_t)nxt.pm * tstep : cA; const char* nB = has_next ? (const char*)g.Bt + (size_t)nxt.pn * tstep : cB;
        for (int t = 0; t < nt; t += 2) {
            const bool last = (t == nt - 2);
            const char* a1 = cA + (size_t)(t + 1) * kstep;
            const char* a2 = last ? nA : cA + (size_t)(t + 2) * kstep; const char* b2 = last ? nB : cB + (size_t)(t + 2) * kstep;
            const char* a3 = a2 + kstep; const char* b3 = b2 + kstep;
            if (last && has_next) S.a_ready(nxt);
            if constexpr (SP2) {
            PG8_LDB(B0, 0, 0); PG8_LDB(B1, 0, 1); PG8_SCHED; PG8_LDA(At, 0, 0); PG8_STAGE(PG8_SA(1, 1), a1 + hstep, voffA);
            PG8_WAIT_V(8); PG8_WAIT_L(0); PG8_BAR; PG8_MMA(0, 0, At, B0); PG8_MMA(0, 1, At, B1); PG8_BAR; PG8_SCHED;
            PG8_LDA(At, 0, 1); PG8_STAGE(PG8_SB(0, 0), b2, voffB); PG8_STAGE(PG8_SB(0, 1), b2 + hstep, voffB); PG8_STAGE(PG8_SA(0, 0), a2, voffA);
            PG8_WAIT_V(8); PG8_WAIT_L(0); PG8_BAR; PG8_MMA(1, 0, At, B0); PG8_MMA(1, 1, At, B1); PG8_BAR; PG8_SCHED;
            PG8_LDB(B0, 1, 0); PG8_LDB(B1, 1, 1); PG8_SCHED; PG8_LDA(At, 1, 0); PG8_STAGE(PG8_SA(0, 1), a2 + hstep, voffA);
            PG8_WAIT_V(8); PG8_WAIT_L(0); PG8_BAR; PG8_MMA(0, 0, At, B0); PG8_MMA(0, 1, At, B1); PG8_BAR; PG8_SCHED;
            PG8_LDA(At, 1, 1); PG8_STAGE(PG8_SB(1, 0), b3, voffB); PG8_STAGE(PG8_SB(1, 1), b3 + hstep, voffB); PG8_STAGE(PG8_SA(1, 0), a3, voffA);
            PG8_WAIT_V(8); PG8_WAIT_L(0); PG8_BAR; PG8_MMA(1, 0, At, B0); PG8_MMA(1, 1, At, B1); PG8_BAR; PG8_SCHED;
            } else {
            PG8_LDB(B0, 0, 0); PG8_SCHED; PG8_LDA(At, 0, 0); PG8_STAGE(PG8_SA(1, 1), a1 + hstep, voffA);
            PG8_WAIT_L(8); PG8_BAR; PG8_WAIT_L(0); PG8_MMA(0, 0, At, B0); PG8_BAR; PG8_SCHED;
            PG8_LDB(B1, 0, 1); PG8_STAGE(PG8_SB(0, 0), b2, voffB);
            PG8_BAR; PG8_WAIT_L(0); PG8_MMA(0, 1, At, B1); PG8_BAR;
            PG8_LDA(At, 0, 1); PG8_STAGE(PG8_SA(0, 0), a2, voffA);
            PG8_BAR; PG8_WAIT_L(0); PG8_MMA(1, 0, At, B0); PG8_BAR; PG8_SCHED;
            PG8_STAGE(PG8_SB(0, 1), b2 + hstep, voffB);
            PG8_WAIT_V(6); PG8_BAR; PG8_MMA(1, 1, At, B1); PG8_BAR;
            PG8_LDB(B0, 1, 0); PG8_SCHED; PG8_LDA(At, 1, 0); PG8_STAGE(PG8_SA(0, 1), a2 + hstep, voffA);
            PG8_WAIT_L(8); PG8_BAR; PG8_WAIT_L(0); PG8_MMA(0, 0, At, B0); PG8_BAR; PG8_SCHED;
            PG8_LDB(B1, 1, 1); PG8_STAGE(PG8_SB(1, 0), b3, voffB);
            PG8_BAR; PG8_WAIT_L(0); PG8_MMA(0, 1, At, B1); PG8_BAR;
            PG8_LDA(At, 1, 1); PG8_STAGE(PG8_SA(1, 0), a3, voffA);
            PG8_BAR; PG8_WAIT_L(0); PG8_MMA(1, 0, At, B0); PG8_BAR; PG8_SCHED;
            PG8_STAGE(PG8_SB(1, 1), b3 + hstep, voffB);
            PG8_WAIT_V(6); PG8_BAR; PG8_MMA(1, 1, At, B1); PG8_BAR;
            }
        }
        if constexpr (ALIGN_EPI) { if (wr == 0) PG8_BAR; }
        if constexpr (!Epi::AFTER_DRAIN) { E(acc, cur, wr, wc, fr, fq); S.done(cur); }
        if (!has_next) break;
#pragma unroll
        for (int a = 0; a < 2; ++a)
#pragma unroll
            for (int b = 0; b < 2; ++b)
#pragma unroll
                for (int m = 0; m < 4; ++m)
#pragma unroll
                    for (int n = 0; n < 2; ++n) acc[a][b][m][n] = (f32x4){0.f, 0.f, 0.f, 0.f};
        cur = nxt; cA = nA; cB = nB; ++ui;
        if constexpr (ALIGN_EPI) { if (wr == 1) PG8_BAR; }
    }
    PG8_WAIT_V(0);
    if constexpr (!ALIGN_EPI) { if (wr == 0) PG8_BAR; }
    PG8_BAR;
    if constexpr (Epi::AFTER_DRAIN) { E.fused(acc, cur, wr, wc, fr, fq, lds, wid, lane); S.done(cur); }
#undef PG8_SA
#undef PG8_SB
#undef PG8_STAGE
#undef PG8_LDA
#undef PG8_LDB
#undef PG8_MMA
#undef PG8_WAIT_V
#undef PG8_WAIT_L
#undef PG8_BAR
#undef PG8_SCHED
}
}

#ifndef PG8_SP2
#define PG8_SP2 true
#endif
#ifndef PG8_ALIGN
#define PG8_ALIGN true
#endif

#define LAS __attribute__((address_space(3)))
typedef unsigned short bf16_t;
typedef short bf16x8 __attribute__((ext_vector_type(8)));
typedef short s16x4 __attribute__((ext_vector_type(4)));
typedef float f32x4 __attribute__((ext_vector_type(4)));
typedef float f32x16 __attribute__((ext_vector_type(16)));
typedef unsigned u32x4 __attribute__((ext_vector_type(4)));
typedef unsigned u32x2 __attribute__((ext_vector_type(2)));

constexpr int NB = 32, SEQ = 2048, DM = 1024, CL = 256, MX = NB * SEQ, MC = NB * CL, MA = MX + MC, DFF = 2816;
constexpr float LOG2E = 1.4426950408889634f;
constexpr float EPSN = 1e-6f;
constexpr size_t MiB = (size_t)1 << 20;
constexpr size_t WS_WQKV0 = 1 * MiB, WS_WO0 = 4 * MiB, WS_WIN0 = 6 * MiB, WS_WOUT0 = 17 * MiB, WS_WR = 23 * MiB, WS_WRO = 35 * MiB, WS_WIN1 = 39 * MiB, WS_WOUT1 = 50 * MiB;
constexpr size_t WS_MOD = 56 * MiB, WS_TAB0 = 58 * MiB, WS_TAB1 = 58 * MiB + 65536;
constexpr size_t WS_GNS = 60 * MiB;
constexpr size_t WS_X = 64 * MiB;
constexpr size_t WS_H = 208 * MiB, WS_QKV0 = 352 * MiB, WS_ACT0 = 352 * MiB;
constexpr size_t WS_Q1 = 208 * MiB, WS_K1 = 352 * MiB, WS_V1 = 496 * MiB, WS_HL1 = 784 * MiB, WS_ACT1 = 352 * MiB, WS_END = 1024 * MiB;
constexpr int LDS_BYTES = 152 * 1024, XB_LDS_OFF = 150 * 1024;
constexpr size_t WS_BAR = 62 * MiB;
constexpr int NPHASE = 16;

__device__ __forceinline__ unsigned pkbf(float lo, float hi) { return pg8::cvt_pk_bf16(lo, hi); }
__device__ __forceinline__ float bf_lo(unsigned w) { return __builtin_bit_cast(float, w << 16); }
__device__ __forceinline__ float bf_hi(unsigned w) { return __builtin_bit_cast(float, w & 0xffff0000u); }
__device__ __forceinline__ float bf2f(bf16_t v) { return __builtin_bit_cast(float, (unsigned)v << 16); }
__device__ __forceinline__ float wave_sum(float v) {
#pragma unroll
    for (int o = 1; o < 64; o <<= 1) v += __shfl_xor(v, o);
    return v;
}
__device__ __forceinline__ float fast_silu(float x) { return x * __builtin_amdgcn_rcpf(1.0f + __expf(-x)); }

struct EpiSplit {
    static constexpr bool PERM = true, AFTER_DRAIN = false;
    bf16_t* d0; int ld0; int t1; bf16_t* d1; int ld1; int t2; bf16_t* d2; int ld2;
    __device__ __forceinline__ void operator()(const pg8::f32x4 (&acc)[2][2][4][2], const pg8::Unit& u, int wr, int wc, int fr, int fq) const {
        bf16_t* base; int ld, ct;
        if (u.pn < t1) { base = d0; ld = ld0; ct = u.pn; } else if (u.pn < t2) { base = d1; ld = ld1; ct = u.pn - t1; } else { base = d2; ld = ld2; ct = u.pn - t2; }
        const int row0 = u.pm * 256 + wr * 64 + fr, col0 = ct * 256 + wc * 32 + 8 * fq;
#pragma unroll
        for (int ai = 0; ai < 2; ++ai)
#pragma unroll
            for (int m = 0; m < 4; ++m) { bf16_t* rowp = base + (size_t)(row0 + ai * 128 + m * 16) * ld + col0;
#pragma unroll
                for (int bj = 0; bj < 2; ++bj) { const pg8::f32x4 v0 = acc[ai][bj][m][0], v1 = acc[ai][bj][m][1]; u32x4 w;
                    w.x = pkbf(v0[0], v0[1]); w.y = pkbf(v0[2], v0[3]); w.z = pkbf(v1[0], v1[1]); w.w = pkbf(v1[2], v1[3]);
                    *(u32x4*)(rowp + bj * 128) = w; } }
    }
};
struct EpiQKV0 {
    static constexpr bool PERM = true, AFTER_DRAIN = false;
    bf16_t* O; const float* qg; const float* kg; const float* tab0;
    __device__ __forceinline__ void operator()(const pg8::f32x4 (&acc)[2][2][4][2], const pg8::Unit& u, int wr, int wc, int fr, int fq) const {
        const int row0 = u.pm * 256 + wr * 64 + fr, col0 = u.pn * 256 + wc * 32 + 8 * fq;
        if (u.pn >= 5) {
#pragma unroll
            for (int ai = 0; ai < 2; ++ai)
#pragma unroll
                for (int m = 0; m < 4; ++m) { bf16_t* rowp = O + (size_t)(row0 + ai * 128 + m * 16) * 1536 + col0;
#pragma unroll
                    for (int bj = 0; bj < 2; ++bj) { const pg8::f32x4 v0 = acc[ai][bj][m][0], v1 = acc[ai][bj][m][1]; u32x4 w;
                        w.x = pkbf(v0[0], v0[1]); w.y = pkbf(v0[2], v0[3]); w.z = pkbf(v1[0], v1[1]); w.w = pkbf(v1[2], v1[3]); *(u32x4*)(rowp + bj * 128) = w; } }
            return;
        }
        const float* gp = (u.pn < 4 ? qg : kg) + 8 * fq + (fq >= 2 ? 16 : 0);
        const float qs = u.pn < 4 ? 0.125f * LOG2E : 1.0f;
        pg8::f32x4 g1[2], g2[2];
#pragma unroll
        for (int n = 0; n < 2; ++n) { g1[n] = *(const pg8::f32x4*)(gp + 4 * n) * qs; g2[n] = *(const pg8::f32x4*)(gp + 16 + 4 * n) * qs; }
        const bool lat = u.pm * 256 < MX;
#pragma unroll
        for (int ai = 0; ai < 2; ++ai)
#pragma unroll
            for (int m = 0; m < 4; ++m) { const int row = row0 + ai * 128 + m * 16;
                pg8::f32x4 x1[2] = {acc[ai][0][m][0], acc[ai][0][m][1]}, x2[2] = {acc[ai][1][m][0], acc[ai][1][m][1]};
                float ss = 0.f;
#pragma unroll
                for (int n = 0; n < 2; ++n) ss += (x1[n][0] * x1[n][0] + x1[n][1] * x1[n][1]) + (x1[n][2] * x1[n][2] + x1[n][3] * x1[n][3]) + (x2[n][0] * x2[n][0] + x2[n][1] * x2[n][1]) + (x2[n][2] * x2[n][2] + x2[n][3] * x2[n][3]);
                ss += __shfl_xor(ss, 16); ss += __shfl_xor(ss, 32);
                const float rstd = rsqrtf(ss * (1.0f / 64.0f) + EPSN);
#pragma unroll
                for (int n = 0; n < 2; ++n) { x1[n] = x1[n] * rstd * g1[n]; x2[n] = x2[n] * rstd * g2[n]; }
                if (lat) { const int s = row & (SEQ - 1), pos = (fq & 2) ? (s & 63) : (s >> 6);
                    const float* tp = tab0 + ((size_t)pos * 16 + 8 * (fq & 1)) * 2;
#pragma unroll
                    for (int n = 0; n < 2; ++n) { const pg8::f32x4 t0 = *(const pg8::f32x4*)(tp + 8 * n), t1 = *(const pg8::f32x4*)(tp + 8 * n + 4);
                        const pg8::f32x4 cs = {t0[0], t0[2], t1[0], t1[2]}, sn = {t0[1], t0[3], t1[1], t1[3]};
                        const pg8::f32x4 a = x1[n] * cs - x2[n] * sn, bb = x1[n] * sn + x2[n] * cs; x1[n] = a; x2[n] = bb; } }
                bf16_t* rowp = O + (size_t)row * 1536 + col0; u32x4 w;
                w.x = pkbf(x1[0][0], x1[0][1]); w.y = pkbf(x1[0][2], x1[0][3]); w.z = pkbf(x1[1][0], x1[1][1]); w.w = pkbf(x1[1][2], x1[1][3]); *(u32x4*)rowp = w;
                w.x = pkbf(x2[0][0], x2[0][1]); w.y = pkbf(x2[0][2], x2[0][3]); w.z = pkbf(x2[1][0], x2[1][1]); w.w = pkbf(x2[1][2], x2[1][3]); *(u32x4*)(rowp + 128) = w;
                asm volatile("" ::: "memory"); }
    }
};
struct EpiQKV1 {
    static constexpr bool PERM = true, AFTER_DRAIN = false;
    bf16_t* Qd; bf16_t* Kd; bf16_t* Vd; const float* tab1;
    __device__ __forceinline__ void operator()(const pg8::f32x4 (&acc)[2][2][4][2], const pg8::Unit& u, int wr, int wc, int fr, int fq) const {
        bf16_t* base; int ld, ct;
        if (u.pn < 4) { base = Qd; ld = 1024; ct = u.pn; } else if (u.pn < 8) { base = Kd; ld = 1024; ct = u.pn - 4; } else { base = Vd; ld = 2048; ct = u.pn - 8; }
        const int row0 = u.pm * 256 + wr * 64 + fr, col0 = ct * 256 + wc * 32 + 8 * fq;
        const bool rope = u.pn < 8 && u.pm * 256 < MX;
#pragma unroll
        for (int ai = 0; ai < 2; ++ai)
#pragma unroll
            for (int m = 0; m < 4; ++m) { const int row = row0 + ai * 128 + m * 16;
                pg8::f32x4 x1[2] = {acc[ai][0][m][0], acc[ai][0][m][1]}, x2[2] = {acc[ai][1][m][0], acc[ai][1][m][1]};
                if (rope) { const int s = row & (SEQ - 1), pos = (wc & 2) ? (s & 63) : (s >> 6);
                    const float* tp = tab1 + ((size_t)pos * 64 + 32 * (wc & 1) + 8 * fq) * 2;
#pragma unroll
                    for (int n = 0; n < 2; ++n) { const pg8::f32x4 t0 = *(const pg8::f32x4*)(tp + 8 * n), t1 = *(const pg8::f32x4*)(tp + 8 * n + 4);
                        const pg8::f32x4 cs = {t0[0], t0[2], t1[0], t1[2]}, sn = {t0[1], t0[3], t1[1], t1[3]};
                        const pg8::f32x4 a = x1[n] * cs - x2[n] * sn, bb = x1[n] * sn + x2[n] * cs; x1[n] = a; x2[n] = bb; } }
                bf16_t* rowp = base + (size_t)row * ld + col0; u32x4 w;
                w.x = pkbf(x1[0][0], x1[0][1]); w.y = pkbf(x1[0][2], x1[0][3]); w.z = pkbf(x1[1][0], x1[1][1]); w.w = pkbf(x1[1][2], x1[1][3]); *(u32x4*)rowp = w;
                w.x = pkbf(x2[0][0], x2[0][1]); w.y = pkbf(x2[0][2], x2[0][3]); w.z = pkbf(x2[1][0], x2[1][1]); w.w = pkbf(x2[1][2], x2[1][3]); *(u32x4*)(rowp + 128) = w;
                asm volatile("" ::: "memory"); }
    }
};
template <int MODE> struct EpiResid {
    static constexpr bool PERM = true, AFTER_DRAIN = false;
    const float* xin_lat; const float* xin_ctx; bf16_t* X; float* outf; const float* gate;
    __device__ __forceinline__ void operator()(const pg8::f32x4 (&acc)[2][2][4][2], const pg8::Unit& u, int wr, int wc, int fr, int fq) const {
        const int R = u.pm * 256; const int gr = R < MX ? R / SEQ : NB;
        const int col0 = u.pn * 256 + wc * 32 + 8 * fq; const float* gp = gate + (size_t)gr * 6144 + col0;
        const float* xi = R < MX ? xin_lat + (size_t)R * DM : xin_ctx + (size_t)(R - MX) * DM;
        pg8::f32x4 g[2][2];
#pragma unroll
        for (int bj = 0; bj < 2; ++bj)
#pragma unroll
            for (int n = 0; n < 2; ++n) g[bj][n] = *(const pg8::f32x4*)(gp + bj * 128 + 4 * n);
#pragma unroll
        for (int ai = 0; ai < 2; ++ai)
#pragma unroll
            for (int m = 0; m < 4; ++m) { const size_t off = (size_t)(wr * 64 + fr + ai * 128 + m * 16) * DM + col0;
#pragma unroll
                for (int bj = 0; bj < 2; ++bj) {
                    pg8::f32x4 x0, x1;
                    if (MODE == 0) { x0 = *(const pg8::f32x4*)(xi + off + bj * 128); x1 = *(const pg8::f32x4*)(xi + off + bj * 128 + 4); }
                    else { const u32x4 w = *(const u32x4*)(X + (size_t)R * DM + off + bj * 128); x0 = (pg8::f32x4){bf_lo(w.x), bf_hi(w.x), bf_lo(w.y), bf_hi(w.y)}; x1 = (pg8::f32x4){bf_lo(w.z), bf_hi(w.z), bf_lo(w.w), bf_hi(w.w)}; }
                    x0 = x0 + g[bj][0] * acc[ai][bj][m][0]; x1 = x1 + g[bj][1] * acc[ai][bj][m][1];
                    if (MODE == 2) { __builtin_nontemporal_store(x0, (pg8::f32x4*)(outf + (size_t)R * DM + off + bj * 128)); __builtin_nontemporal_store(x1, (pg8::f32x4*)(outf + (size_t)R * DM + off + bj * 128 + 4)); }
                    else { u32x4 w; w.x = pkbf(x0[0], x0[1]); w.y = pkbf(x0[2], x0[3]); w.z = pkbf(x1[0], x1[1]); w.w = pkbf(x1[2], x1[3]); *(u32x4*)(X + (size_t)R * DM + off + bj * 128) = w; } }
                asm volatile("" ::: "memory"); }
    }
};
struct EpiSwiglu {
    static constexpr bool PERM = true, AFTER_DRAIN = false;
    bf16_t* O;
    __device__ __forceinline__ void operator()(const pg8::f32x4 (&acc)[2][2][4][2], const pg8::Unit& u, int wr, int wc, int fr, int fq) const {
        const int row0 = u.pm * 256 + wr * 64 + fr, col0 = u.pn * 128 + wc * 32 + 8 * fq;
#pragma unroll
        for (int ai = 0; ai < 2; ++ai)
#pragma unroll
            for (int m = 0; m < 4; ++m) { const pg8::f32x4 g0 = acc[ai][0][m][0], g1 = acc[ai][0][m][1], u0 = acc[ai][1][m][0], u1 = acc[ai][1][m][1]; u32x4 w;
#define SWG(g_, u_) ((g_) * (u_) * __builtin_amdgcn_rcpf(1.0f + __builtin_amdgcn_exp2f(g_)))
                w.x = pkbf(SWG(g0[0], u0[0]), SWG(g0[1], u0[1])); w.y = pkbf(SWG(g0[2], u0[2]), SWG(g0[3], u0[3]));
                w.z = pkbf(SWG(g1[0], u1[0]), SWG(g1[1], u1[1])); w.w = pkbf(SWG(g1[2], u1[2]), SWG(g1[3], u1[3]));
#undef SWG
                *(u32x4*)(O + (size_t)(row0 + ai * 128 + m * 16) * DFF + col0) = w; }
    }
};
struct EpiGate {
    static constexpr bool PERM = true, AFTER_DRAIN = false;
    bf16_t* Y; const float* stats; const float* gain;
    __device__ __forceinline__ void operator()(const pg8::f32x4 (&acc)[2][2][4][2], const pg8::Unit& u, int wr, int wc, int fr, int fq) const {
        const int row0 = u.pm * 256 + wr * 64 + fr, col0 = u.pn * 256 + wc * 32 + 8 * fq, hg = u.pn >> 1;
        pg8::f32x4 g[2][2];
#pragma unroll
        for (int bj = 0; bj < 2; ++bj)
#pragma unroll
            for (int n = 0; n < 2; ++n) g[bj][n] = *(const pg8::f32x4*)(gain + col0 + bj * 128 + 4 * n);
#pragma unroll
        for (int ai = 0; ai < 2; ++ai)
#pragma unroll
            for (int m = 0; m < 4; ++m) { const int row = row0 + ai * 128 + m * 16; bf16_t* rowp = Y + (size_t)row * 2048 + col0;
                const float s0 = stats[((size_t)row * 4 + hg) * 2], s1 = stats[((size_t)row * 4 + hg) * 2 + 1];
                const float mu = s0 * (1.0f / 512.0f), rstd = rsqrtf(fmaxf(s1 * (1.0f / 512.0f) - mu * mu, 0.f) + EPSN);
#pragma unroll
                for (int bj = 0; bj < 2; ++bj) { const u32x4 y = *(const u32x4*)(rowp + bj * 128); const pg8::f32x4 v0 = acc[ai][bj][m][0], v1 = acc[ai][bj][m][1];
                    const pg8::f32x4 y0 = ((pg8::f32x4){bf_lo(y.x), bf_hi(y.x), bf_lo(y.y), bf_hi(y.y)} - mu) * rstd * g[bj][0], y1 = ((pg8::f32x4){bf_lo(y.z), bf_hi(y.z), bf_lo(y.w), bf_hi(y.w)} - mu) * rstd * g[bj][1];
                    u32x4 w;
                    w.x = pkbf(fast_silu(v0[0]) * y0[0], fast_silu(v0[1]) * y0[1]); w.y = pkbf(fast_silu(v0[2]) * y0[2], fast_silu(v0[3]) * y0[3]);
                    w.z = pkbf(fast_silu(v1[0]) * y1[0], fast_silu(v1[1]) * y1[1]); w.w = pkbf(fast_silu(v1[2]) * y1[2], fast_silu(v1[3]) * y1[3]);
                    *(u32x4*)(rowp + bj * 128) = w; }
                asm volatile("" ::: "memory"); }
    }
};

__device__ __forceinline__ int drow_map(int mode, int n) {
    if (mode == 1) return n < DFF ? (n / 128) * 256 + (n % 128) : ((n - DFF) / 128) * 256 + 128 + ((n - DFF) % 128);
    if (mode == 2) { if (n >= 2048) return n; const int o = n & 255, blk = o >> 6, nb = (blk == 1) ? 2 : (blk == 2 ? 1 : blk); return (n - o) + 64 * nb + (o & 63); }
    if (mode == 3) { if (n >= 1280) return n; const int o = n & 255, hd = o >> 6, d = o & 63, q16 = d >> 4; return (n - o) + 128 * (q16 & 1) + 32 * hd + 16 * (q16 >> 1) + (d & 15); }
    return n;
}
__device__ __forceinline__ void transpose_item(const float* W, int K, int N, bf16_t* WT, int k0, int n0, int mode, LAS float* scr, int lane) {
#pragma unroll 8
    for (int i = 0; i < 32; ++i) { const int kk = 2 * i + (lane >> 5); scr[kk * 33 + (lane & 31)] = W[(size_t)(k0 + kk) * N + n0 + (lane & 31)]; }
    asm volatile("s_waitcnt lgkmcnt(0)" ::: "memory");
    const int c = lane & 7;
    const float wsc = mode == 1 ? (n0 < DFF ? -LOG2E : -1.0f / LOG2E) : 1.0f;
#pragma unroll
    for (int j = 0; j < 4; ++j) { const int n = (lane >> 3) + 8 * j; const LAS float* s = scr + (8 * c) * 33 + n;
        u32x4 o; o.x = pkbf(s[0 * 33] * wsc, s[1 * 33] * wsc); o.y = pkbf(s[2 * 33] * wsc, s[3 * 33] * wsc); o.z = pkbf(s[4 * 33] * wsc, s[5 * 33] * wsc); o.w = pkbf(s[6 * 33] * wsc, s[7 * 33] * wsc);
        *(u32x4*)(WT + (size_t)drow_map(mode, n0 + n) * K + k0 + 8 * c) = o; }
    asm volatile("s_waitcnt lgkmcnt(0)" ::: "memory");
}

struct Args { const float* in[19]; float* out; unsigned char* ws; int ph_lo, ph_hi; };

__device__ __forceinline__ void phase0(const Args& a, LAS unsigned char* lds, int tid) {
    const int wave = tid >> 6, lane = tid & 63;
    const int gw = blockIdx.x * 8 + wave, NGW = gridDim.x * 8;
    unsigned char* ws = a.ws;
    {
        LAS float* scr = (LAS float*)(lds + wave * 16384);
        constexpr int I0 = 16 * 48, I1 = 16 * 32, I2 = 16 * 176, I3 = 44 * 32, I4 = 16 * 192, I5 = 32 * 32, I6 = I2, I7 = I3;
        constexpr int NIT = I0 + I1 + I2 + I3 + I4 + I5 + I6 + I7;
        for (int it = gw; it < NIT; it += NGW) {
            int r = it; const float* W; bf16_t* WT; int K, N; int mode = 0;
            if (r < I0) { W = a.in[10]; WT = (bf16_t*)(ws + WS_WQKV0); K = 1024; N = 1536; mode = 3; }
            else if ((r -= I0) < I1) { W = a.in[14]; WT = (bf16_t*)(ws + WS_WO0); K = 1024; N = 1024; }
            else if ((r -= I1) < I2) { W = a.in[8]; WT = (bf16_t*)(ws + WS_WIN0); K = 1024; N = 5632; mode = 1; }
            else if ((r -= I2) < I3) { W = a.in[9]; WT = (bf16_t*)(ws + WS_WOUT0); K = 2816; N = 1024; }
            else if ((r -= I3) < I4) { W = a.in[15]; WT = (bf16_t*)(ws + WS_WR); K = 1024; N = 6144; mode = 2; }
            else if ((r -= I4) < I5) { W = a.in[18]; WT = (bf16_t*)(ws + WS_WRO); K = 2048; N = 1024; }
            else if ((r -= I5) < I6) { W = a.in[8] + (size_t)1024 * 5632; WT = (bf16_t*)(ws + WS_WIN1); K = 1024; N = 5632; mode = 1; }
            else { r -= I6; W = a.in[9] + (size_t)2816 * 1024; WT = (bf16_t*)(ws + WS_WOUT1); K = 2816; N = 1024; }
            const int nblk = N / 32, kb = r / nblk, nb = r % nblk, n0 = 32 * nb;
            transpose_item(W, K, N, WT, 64 * kb, n0, mode, scr, lane);
        }
    }
    { f32x4* gs = (f32x4*)(ws + WS_GNS); for (int i = blockIdx.x * 512 + tid; i < MX * 8 / 4; i += gridDim.x * 512) gs[i] = (f32x4){0.f, 0.f, 0.f, 0.f}; }
    {
        const int gt = blockIdx.x * 512 + tid;
        if (gt < 64 * 16 + 64 * 64) {
            int pos, f; float expo; float* dst;
            if (gt < 1024) { pos = gt >> 4; f = gt & 15; expo = -(float)(2 * f) / 32.0f; dst = (float*)(ws + WS_TAB0) + (size_t)gt * 2; }
            else { const int g2 = gt - 1024; pos = g2 >> 6; f = g2 & 63; expo = -(float)(2 * f) / 128.0f; dst = (float*)(ws + WS_TAB1) + (size_t)g2 * 2; }
            const float inv = exp2f(expo * 13.287712379549449f);
            const float ang = (float)pos * inv;
            const double ad = (double)ang; const double kk = __builtin_rint(ad * 0.15915494309189535); const float red = (float)(ad - kk * 6.283185307179586);
            dst[0] = __cosf(red); dst[1] = __sinf(red);
        }
    }
    __syncthreads();
    {
        LAS float* sc = (LAS float*)lds + wave * (128 * 36);
        LAS float* red = (LAS float*)lds;
        float* mod = (float*)(ws + WS_MOD);
        for (int it = blockIdx.x; it < 192; it += gridDim.x) {
            const int l = it / 96, n0 = (it % 96) * 64;
            int lane_l = lane; asm volatile("" : "+v"(lane_l));
#pragma unroll
            for (int t0 = 0; t0 < 66; t0 += 22) {
                float tv[22];
#pragma unroll
                for (int t = 0; t < 22; ++t) { const int r = (t0 + t) >> 1, k = lane_l + 64 * (t & 1); tv[t] = r < 32 ? a.in[1][r * 1024 + wave * 128 + k] : a.in[3][wave * 128 + k]; }
#pragma unroll
                for (int t = 0; t < 22; ++t) { const int r = (t0 + t) >> 1, k = lane_l + 64 * (t & 1); sc[k * 36 + r] = tv[t] * __builtin_amdgcn_rcpf(1.0f + __expf(-tv[t])); }
                asm volatile("" ::: "memory");
            }
            asm volatile("s_waitcnt lgkmcnt(0)" ::: "memory");
            float acc[33];
#pragma unroll
            for (int r = 0; r < 33; ++r) acc[r] = 0.f;
            const float* Wp = a.in[4] + ((size_t)l * 1024 + wave * 128) * 6144 + n0 + lane_l;
#pragma unroll 1
            for (int k0 = 0; k0 < 128; k0 += 16) {
                float wv[16];
#pragma unroll
                for (int kk = 0; kk < 16; ++kk) wv[kk] = Wp[(size_t)(k0 + kk) * 6144];
#pragma unroll
                for (int kk = 0; kk < 16; ++kk) { const int k = k0 + kk;
#pragma unroll
                    for (int r4 = 0; r4 < 8; ++r4) { const f32x4 s = *(const LAS f32x4*)(sc + k * 36 + 4 * r4); acc[4 * r4] += s[0] * wv[kk]; acc[4 * r4 + 1] += s[1] * wv[kk]; acc[4 * r4 + 2] += s[2] * wv[kk]; acc[4 * r4 + 3] += s[3] * wv[kk]; }
                    acc[32] += sc[k * 36 + 32] * wv[kk];
                    if ((kk & 1) == 1) asm volatile("" ::: "memory"); }
            }
            __syncthreads();
#pragma unroll
            for (int r = 0; r < 33; ++r) red[(wave * 33 + r) * 64 + lane] = acc[r];
            __syncthreads();
            for (int idx = tid; idx < 33 * 64; idx += 512) { const int r = idx >> 6, cc = idx & 63; float s = 0.f;
#pragma unroll
                for (int w = 0; w < 8; ++w) s += red[(w * 33 + r) * 64 + cc];
                mod[((size_t)l * 33 + r) * 6144 + n0 + cc] = s + a.in[5][l * 6144 + n0 + cc]; }
            __syncthreads();
        }
    }
}

template <bool SRC_BF16>
__device__ __forceinline__ void norm_phase(const float* src_lat, const float* src_ctx, const bf16_t* srcb, const float* g, const float* shift, const float* scale, int nrows, bf16_t* dst, int tid) {
    const int lane = tid & 63, gw = blockIdx.x * 8 + (tid >> 6), NGW = gridDim.x * 8;
    const int R = (nrows + NGW - 1) / NGW, row_lo = gw * R, row_hi = (row_lo + R < nrows) ? row_lo + R : nrows;
    int cols[4];
#pragma unroll
    for (int j = 0; j < 4; ++j) cols[j] = SRC_BF16 ? 8 * lane + 512 * (j >> 1) + 4 * (j & 1) : 4 * lane + 256 * j;
    f32x4 gg[4], A[4], sh[4];
#pragma unroll
    for (int j = 0; j < 4; ++j) gg[j] = *(const f32x4*)(g + cols[j]);
    int rcur = -1;
#define NORM_LOAD(v_, row_) do { if (SRC_BF16) { const u32x4 w0_ = *(const u32x4*)(srcb + (size_t)(row_) * DM + 8 * lane), w1_ = *(const u32x4*)(srcb + (size_t)(row_) * DM + 512 + 8 * lane); \
            v_[0] = (f32x4){bf_lo(w0_.x), bf_hi(w0_.x), bf_lo(w0_.y), bf_hi(w0_.y)}; v_[1] = (f32x4){bf_lo(w0_.z), bf_hi(w0_.z), bf_lo(w0_.w), bf_hi(w0_.w)}; \
            v_[2] = (f32x4){bf_lo(w1_.x), bf_hi(w1_.x), bf_lo(w1_.y), bf_hi(w1_.y)}; v_[3] = (f32x4){bf_lo(w1_.z), bf_hi(w1_.z), bf_lo(w1_.w), bf_hi(w1_.w)}; \
        } else { const float* src_ = (row_) < MX ? src_lat + (size_t)(row_) * DM : src_ctx + (size_t)((row_) - MX) * DM; \
            _Pragma("unroll") for (int j_ = 0; j_ < 4; ++j_) v_[j_] = ((const f32x4*)src_)[lane + 64 * j_]; } } while (0)
#define NORM_ROW(v_, row_) do { const int r_ = (row_) < MX ? (row_) / SEQ : NB; \
        if (r_ != rcur) { rcur = r_; _Pragma("unroll") for (int j_ = 0; j_ < 4; ++j_) { sh[j_] = *(const f32x4*)(shift + (size_t)r_ * 6144 + cols[j_]); A[j_] = gg[j_] * (*(const f32x4*)(scale + (size_t)r_ * 6144 + cols[j_]) + 1.0f); } } \
        float ss_ = 0.f; \
        _Pragma("unroll") for (int j_ = 0; j_ < 4; ++j_) ss_ += (v_[j_].x * v_[j_].x + v_[j_].y * v_[j_].y) + (v_[j_].z * v_[j_].z + v_[j_].w * v_[j_].w); \
        const float rstd_ = rsqrtf(wave_sum(ss_) * (1.0f / DM) + EPSN); \
        _Pragma("unroll") for (int j_ = 0; j_ < 4; ++j_) { const f32x4 h_ = v_[j_] * rstd_ * A[j_] + sh[j_]; u32x2 w_; w_.x = pkbf(h_.x, h_.y); w_.y = pkbf(h_.z, h_.w); \
            *(u32x2*)(dst + (size_t)(row_) * DM + cols[j_]) = w_; } } while (0)
    for (int row = row_lo; row < row_hi; row += 2) {
        f32x4 va[4], vb[4];
        const bool two = row + 1 < row_hi;
        NORM_LOAD(va, row);
        if (two) NORM_LOAD(vb, row + 1);
        NORM_ROW(va, row);
        if (two) NORM_ROW(vb, row + 1);
    }
#undef NORM_LOAD
#undef NORM_ROW
}

__device__ __forceinline__ void qknorm_phase(bf16_t* QKV, const float* qg, const float* kg, const float* tab0, int tid) {
    const long total = (long)MA * 160, stride = (long)gridDim.x * 512;
    for (long idx = (long)blockIdx.x * 512 + tid; idx < total; idx += stride) {
        const int ch = (int)(idx & 7), hd = (int)((idx >> 3) % 20), row = (int)(idx / 160);
        bf16_t* p = QKV + (size_t)row * 1536 + hd * 64 + ch * 8;
        const u32x4 w = *(const u32x4*)p;
        float v[8] = {bf_lo(w.x), bf_hi(w.x), bf_lo(w.y), bf_hi(w.y), bf_lo(w.z), bf_hi(w.z), bf_lo(w.w), bf_hi(w.w)};
        float ss = 0.f;
#pragma unroll
        for (int j = 0; j < 8; ++j) ss += v[j] * v[j];
        ss += __shfl_xor(ss, 1); ss += __shfl_xor(ss, 2); ss += __shfl_xor(ss, 4);
        const float rstd = rsqrtf(ss * (1.0f / 64.0f) + EPSN);
        const float* gp = (hd < 16 ? qg : kg) + ch * 8;
#pragma unroll
        for (int j = 0; j < 8; ++j) v[j] = v[j] * rstd * gp[j];
        float pv[8];
#pragma unroll
        for (int j = 0; j < 8; ++j) pv[j] = __shfl_xor(v[j], 2);
        if (row < MX) {
            const int s = row & (SEQ - 1), pos = (ch & 4) ? (s & 63) : (s >> 6);
            const float* tp = tab0 + ((size_t)pos * 16 + (ch & 1) * 8) * 2;
#pragma unroll
            for (int j = 0; j < 8; ++j) { const float cs = tp[2 * j], sn = tp[2 * j + 1];
                v[j] = (ch & 2) ? (pv[j] * sn + v[j] * cs) : (v[j] * cs - pv[j] * sn); }
        }
        const float qs = hd < 16 ? 0.125f * LOG2E : 1.0f;
        u32x4 o; o.x = pkbf(v[0] * qs, v[1] * qs); o.y = pkbf(v[2] * qs, v[3] * qs); o.z = pkbf(v[4] * qs, v[5] * qs); o.w = pkbf(v[6] * qs, v[7] * qs);
        *(u32x4*)p = o;
    }
}

__device__ __forceinline__ void rope1_phase(bf16_t* Q1, bf16_t* K1, const float* tab1, int tid) {
    const long total = (long)MX * 128, stride = (long)gridDim.x * 512;
    for (long idx = (long)blockIdx.x * 512 + tid; idx < total; idx += stride) {
        const int c8 = (int)(idx & 7), ax = (int)((idx >> 3) & 1), hd = (int)((idx >> 4) & 3), which = (int)((idx >> 6) & 1), row = (int)(idx >> 7);
        bf16_t* p = (which ? K1 : Q1) + (size_t)row * 1024 + hd * 256 + ax * 128 + c8 * 8;
        const u32x4 w1 = *(const u32x4*)p, w2 = *(const u32x4*)(p + 64);
        const float x1[8] = {bf_lo(w1.x), bf_hi(w1.x), bf_lo(w1.y), bf_hi(w1.y), bf_lo(w1.z), bf_hi(w1.z), bf_lo(w1.w), bf_hi(w1.w)};
        const float x2[8] = {bf_lo(w2.x), bf_hi(w2.x), bf_lo(w2.y), bf_hi(w2.y), bf_lo(w2.z), bf_hi(w2.z), bf_lo(w2.w), bf_hi(w2.w)};
        const int s = row & (SEQ - 1), pos = ax ? (s & 63) : (s >> 6);
        const float* tp = tab1 + ((size_t)pos * 64 + c8 * 8) * 2;
        float o1[8], o2[8];
#pragma unroll
        for (int j = 0; j < 8; ++j) { const float cs = tp[2 * j], sn = tp[2 * j + 1]; o1[j] = x1[j] * cs - x2[j] * sn; o2[j] = x1[j] * sn + x2[j] * cs; }
        u32x4 a, b; a.x = pkbf(o1[0], o1[1]); a.y = pkbf(o1[2], o1[3]); a.z = pkbf(o1[4], o1[5]); a.w = pkbf(o1[6], o1[7]);
        b.x = pkbf(o2[0], o2[1]); b.y = pkbf(o2[2], o2[3]); b.z = pkbf(o2[4], o2[5]); b.w = pkbf(o2[6], o2[7]);
        *(u32x4*)p = a; *(u32x4*)(p + 64) = b;
    }
}

__device__ __forceinline__ void gn_phase(bf16_t* Y, const float* gng, int tid) {
    const int lane = tid & 63, gw = blockIdx.x * 8 + (tid >> 6), NGW = gridDim.x * 8;
    for (int it = gw; it < MX * 4; it += NGW) {
        const int row = it >> 2, h = it & 3;
        bf16_t* p = Y + (size_t)row * 2048 + h * 512 + lane * 8;
        const u32x4 w = *(const u32x4*)p;
        float v[8] = {bf_lo(w.x), bf_hi(w.x), bf_lo(w.y), bf_hi(w.y), bf_lo(w.z), bf_hi(w.z), bf_lo(w.w), bf_hi(w.w)};
        float s = 0.f;
#pragma unroll
        for (int j = 0; j < 8; ++j) s += v[j];
        const float mu = wave_sum(s) * (1.0f / 512.0f); float q = 0.f;
#pragma unroll
        for (int j = 0; j < 8; ++j) { v[j] -= mu; q += v[j] * v[j]; }
        const float rstd = rsqrtf(wave_sum(q) * (1.0f / 512.0f) + EPSN);
        const float* gp = gng + h * 512 + lane * 8;
        const f32x4 g0 = *(const f32x4*)gp, g1 = *(const f32x4*)(gp + 4);
        u32x4 o; o.x = pkbf(v[0] * rstd * g0.x, v[1] * rstd * g0.y); o.y = pkbf(v[2] * rstd * g0.z, v[3] * rstd * g0.w);
        o.z = pkbf(v[4] * rstd * g1.x, v[5] * rstd * g1.y); o.w = pkbf(v[6] * rstd * g1.z, v[7] * rstd * g1.w);
        *(u32x4*)p = o;
    }
}

__device__ __forceinline__ f32x16 mfma32(bf16x8 a, bf16x8 b, f32x16 c) { return __builtin_amdgcn_mfma_f32_32x32x16_bf16(a, b, c, 0, 0, 0); }
__device__ __forceinline__ bf16x8 tr_pair(const LAS bf16_t* p0, const LAS bf16_t* p1) {
    const s16x4 a = __builtin_amdgcn_ds_read_tr16_b64_v4i16((LAS s16x4*)p0);
    const s16x4 b = __builtin_amdgcn_ds_read_tr16_b64_v4i16((LAS s16x4*)p1);
    return __builtin_shufflevector(a, b, 0, 1, 2, 3, 4, 5, 6, 7);
}
__device__ __forceinline__ bf16x8 pack8(const f32x16& v, int base) {
    u32x4 w; w.x = pkbf(v[base + 0], v[base + 1]); w.y = pkbf(v[base + 2], v[base + 3]); w.z = pkbf(v[base + 4], v[base + 5]); w.w = pkbf(v[base + 6], v[base + 7]);
    return __builtin_bit_cast(bf16x8, w);
}

constexpr int AKS = 72;
__device__ __forceinline__ void attn_phase(LAS unsigned char* lds, const bf16_t* QKV, bf16_t* O, const float* sink, const float* qg, const float* kg, int tid) {
    const int wid = __builtin_amdgcn_readfirstlane(tid >> 6), lane = tid & 63, r = lane & 31, hh = lane >> 5, blk = (lane >> 4) & 1, q4 = (lane & 15) >> 2, p4 = lane & 3;
    LAS bf16_t* Kl = (LAS bf16_t*)lds;
    LAS bf16_t* Vl = (LAS bf16_t*)(lds + 64 * AKS * 2);
    const int skey = tid >> 3, sch = tid & 7;
    float Bnd;
    { float gq = fabsf(qg[lane]), gk = fabsf(kg[lane]);
#pragma unroll
      for (int o = 1; o < 64; o <<= 1) { gq = fmaxf(gq, __shfl_xor(gq, o)); gk = fmaxf(gk, __shfl_xor(gk, o)); }
      Bnd = 8.0f * LOG2E * 1.02f * gq * gk; }
    for (int u0 = blockIdx.x; u0 < 2304; u0 += gridDim.x) {
        int u = u0;
        if (gridDim.x == 256 && u0 < 2048) { const int x = u0 & 7, idx = (u0 >> 3) & 31, rnd = u0 >> 8; u = ((rnd * 16 + x * 2 + (idx >> 4)) << 4) | (idx & 15); }
        int b, kvh, qb; bool isctx;
        if (u < 2048) { b = u >> 6; kvh = (u >> 4) & 3; qb = u & 15; isctx = false; } else { const int v = u - 2048; b = v >> 3; kvh = (v >> 1) & 3; qb = v & 1; isctx = true; }
        const int hq = kvh * 4 + (wid >> 1);
        const int qloc = qb * 128 + (wid & 1) * 64;
        const size_t qrow0 = isctx ? (size_t)MX + b * CL + qloc : (size_t)b * SEQ + qloc;
        bf16x8 qf[2][4];
#pragma unroll
        for (int qq = 0; qq < 2; ++qq)
#pragma unroll
            for (int s = 0; s < 4; ++s) qf[qq][s] = *(const bf16x8*)(QKV + (qrow0 + 32 * qq + r) * 1536 + (hq >> 2) * 256 + (s >> 1) * 128 + (hq & 3) * 32 + (s & 1) * 16 + 8 * hh);
        const float sl2 = sink[hq] * LOG2E;
        const float psink = hh == 0 ? __builtin_amdgcn_exp2f(sl2 - Bnd) : 0.0f;
        float lrun[2] = {psink, psink};
        f32x16 oacc[2][2];
#pragma unroll
        for (int i = 0; i < 2; ++i)
#pragma unroll
            for (int j = 0; j < 2; ++j)
#pragma unroll
                for (int e = 0; e < 16; ++e) oacc[i][j][e] = 0.f;
        int tlo = 2 - 2 * qb; if (tlo < 0) tlo = 0;
        int thi = 33 - 2 * qb; if (thi > 5) thi = 5;
        const int ntile = isctx ? 4 : 4 + (thi - tlo + 1);
        u32x4 kreg, vreg;
        {   const size_t row = (size_t)MX + b * CL + skey;
            kreg = *(const u32x4*)(QKV + row * 1536 + 1024 + (sch >> 2) * 128 + kvh * 32 + (sch & 3) * 8); vreg = *(const u32x4*)(QKV + row * 1536 + 1280 + kvh * 64 + sch * 8); }
        for (int it = 0; it < ntile; ++it) {
            __syncthreads();
            *(LAS u32x4*)(Kl + skey * AKS + sch * 8) = kreg; *(LAS u32x4*)(Vl + skey * AKS + sch * 8) = vreg;
            __syncthreads();
            if (it + 1 < ntile) { const int nt = it + 1;
                const size_t row = nt < 4 ? (size_t)MX + b * CL + 64 * nt + skey : (size_t)b * SEQ + qb * 128 - 128 + 64 * (tlo + nt - 4) + skey;
                kreg = *(const u32x4*)(QKV + row * 1536 + 1024 + (sch >> 2) * 128 + kvh * 32 + (sch & 3) * 8); vreg = *(const u32x4*)(QKV + row * 1536 + 1280 + kvh * 64 + sch * 8); }
            const int rel = it >= 4 ? (qb * 128 - 128 + 64 * (tlo + it - 4)) - qloc : 0;
            if (rel <= -192 || rel >= 192) continue;
            float nbnd = -Bnd; asm volatile("" : "+v"(nbnd));
            f32x16 st[2][2];
#pragma unroll
            for (int i = 0; i < 2; ++i)
#pragma unroll
                for (int j = 0; j < 2; ++j)
#pragma unroll
                    for (int e = 0; e < 16; ++e) st[i][j][e] = nbnd;
#pragma unroll
            for (int kb = 0; kb < 2; ++kb)
#pragma unroll
                for (int s = 0; s < 4; ++s) { const bf16x8 ka = *(const LAS bf16x8*)(Kl + (32 * kb + r) * AKS + 16 * s + 8 * hh);
                    st[kb][0] = mfma32(ka, qf[0][s], st[kb][0]); st[kb][1] = mfma32(ka, qf[1][s], st[kb][1]); }
            if (rel == -128 || rel == 128) {
                const int kbase = qb * 128 - 128 + 64 * (tlo + it - 4);
#pragma unroll
                for (int kb = 0; kb < 2; ++kb)
#pragma unroll
                    for (int qq = 0; qq < 2; ++qq) { const int qpos = qloc + 32 * qq + r;
#pragma unroll
                        for (int e = 0; e < 16; ++e) { const int key = kbase + 32 * kb + 8 * (e >> 2) + 4 * hh + (e & 3); int d = qpos - key; d = d < 0 ? -d : d;
                            st[kb][qq][e] = d <= 128 ? st[kb][qq][e] : -1e30f; } }
            }
            bf16x8 pf[2][2][2];
#pragma unroll
            for (int qq = 0; qq < 2; ++qq) {
                float ps = 0.f;
#pragma unroll
                for (int kb = 0; kb < 2; ++kb)
#pragma unroll
                    for (int s2 = 0; s2 < 2; ++s2) { float p[8];
#pragma unroll
                        for (int j = 0; j < 8; ++j) { p[j] = __builtin_amdgcn_exp2f(st[kb][qq][8 * s2 + j]); ps += p[j]; }
                        u32x4 w; w.x = pkbf(p[0], p[1]); w.y = pkbf(p[2], p[3]); w.z = pkbf(p[4], p[5]); w.w = pkbf(p[6], p[7]);
                        pf[kb][s2][qq] = __builtin_bit_cast(bf16x8, w); }
                lrun[qq] += ps;
            }
            __builtin_amdgcn_sched_barrier(0);
#pragma unroll
            for (int kb = 0; kb < 2; ++kb)
#pragma unroll
                for (int s2 = 0; s2 < 2; ++s2)
#pragma unroll
                    for (int db = 0; db < 2; ++db) {
                        const LAS bf16_t* vp = Vl + (32 * kb + 16 * s2 + 4 * hh + q4) * AKS + 32 * db + 16 * blk + 4 * p4;
                        const bf16x8 va = tr_pair(vp, vp + 8 * AKS);
                        oacc[db][0] = mfma32(va, pf[kb][s2][0], oacc[db][0]); oacc[db][1] = mfma32(va, pf[kb][s2][1], oacc[db][1]); }
        }
#pragma unroll
        for (int qq = 0; qq < 2; ++qq) {
            const float lt = lrun[qq] + __shfl_xor(lrun[qq], 32), inv = 1.0f / lt;
            bf16_t* op = O + (qrow0 + 32 * qq + r) * 1024 + hq * 64 + 4 * hh;
#pragma unroll
            for (int db = 0; db < 2; ++db)
#pragma unroll
                for (int g = 0; g < 4; ++g) { u32x2 w; w.x = pkbf(oacc[db][qq][4 * g] * inv, oacc[db][qq][4 * g + 1] * inv); w.y = pkbf(oacc[db][qq][4 * g + 2] * inv, oacc[db][qq][4 * g + 3] * inv);
                    *(u32x2*)(op + 32 * db + 8 * g) = w; }
        }
    }
}

constexpr int RS = 136;
__device__ __forceinline__ u32x4 scale8(const u32x4 w, const float f) {
    u32x4 o; o.x = pkbf(bf_lo(w.x) * f, bf_hi(w.x) * f); o.y = pkbf(bf_lo(w.y) * f, bf_hi(w.y) * f); o.z = pkbf(bf_lo(w.z) * f, bf_hi(w.z) * f); o.w = pkbf(bf_lo(w.w) * f, bf_hi(w.w) * f); return o;
}
__device__ __forceinline__ u32x4 add8(const u32x4 a, const u32x4 b) {
    u32x4 o; o.x = pkbf(bf_lo(a.x) + bf_lo(b.x), bf_hi(a.x) + bf_hi(b.x)); o.y = pkbf(bf_lo(a.y) + bf_lo(b.y), bf_hi(a.y) + bf_hi(b.y));
    o.z = pkbf(bf_lo(a.z) + bf_lo(b.z), bf_hi(a.z) + bf_hi(b.z)); o.w = pkbf(bf_lo(a.w) + bf_lo(b.w), bf_hi(a.w) + bf_hi(b.w)); return o;
}
template <int PM> __device__ __forceinline__ f32x16 rmf(bf16x8 a, bf16x8 b, f32x16 c) {
    if (PM == 1) { const u32x4 x = __builtin_bit_cast(u32x4, a), y = __builtin_bit_cast(u32x4, b); c[0] += __builtin_bit_cast(float, (x.x ^ y.x) & 0x3f800000u) + __builtin_bit_cast(float, (x.w ^ y.w) & 0x3f800000u); return c; }
    if (PM == 2) { const bf16x8 k = {0x3c00, 0x3c00, 0x3c00, 0x3c00, 0x3c00, 0x3c00, 0x3c00, 0x3c00}; return __builtin_amdgcn_mfma_f32_32x32x16_bf16(k, k, c, 0, 0, 0); }
    return __builtin_amdgcn_mfma_f32_32x32x16_bf16(a, b, c, 0, 0, 0);
}
template <int PM>
__device__ __forceinline__ void ret_phase(LAS unsigned char* lds, const bf16_t* Q1, const bf16_t* K1, bf16_t* V1, bf16_t* OF, float* gstats, unsigned* gsync, const float* decay_logit, int tid) {
    const int wid = tid >> 6, lane = tid & 63, r = lane & 31, hh = lane >> 5, blk = (lane >> 4) & 1, q4 = (lane & 15) >> 2, p4 = lane & 3;
    LAS bf16_t* QH = (LAS bf16_t*)lds;
    LAS bf16_t* KH = (LAS bf16_t*)(lds + 128 * RS * 2);
    LAS bf16_t* VL = (LAS bf16_t*)(lds + 2 * 128 * RS * 2);
    LAS bf16_t* SL = (LAS bf16_t*)(lds + 3 * 128 * RS * 2);
    LAS bf16_t* OL = KH;
    const int eb = wid & 3, dg = wid >> 2, nb = wid >> 1, mg = wid & 1;
    const int o_row = r * RS + 8 * hh;
    const int o_tr = (8 * hh + q4) * RS + 16 * blk + 4 * p4;
    const int sn = tid >> 4, scc = tid & 15;
    unsigned* gctr = (gsync != nullptr && gridDim.x == 256) ? gsync + ((blockIdx.x & 7) * 8 + ((blockIdx.x >> 5) & 7)) * 64 : nullptr;
    unsigned gtarget = 0u;
    for (int u0 = blockIdx.x; u0 < 512; u0 += gridDim.x) {
        int u = u0;
        if (gridDim.x == 256) { const int x = u0 & 7, idx = (u0 >> 3) & 31, rnd = u0 >> 8; u = ((rnd * 64 + x * 8 + (idx >> 2)) << 2) | (idx & 3); }
        const int b = u >> 4, h = (u >> 2) & 3, sl = u & 3;
        for (int dir = 0; dir < 2; ++dir) {
            const float logit = decay_logit[dir * 4 + h];
            const float lg2 = -log1pf(__expf(-logit)) * LOG2E;
            const float cd = exp2f(lg2 * 128.0f);
            f32x16 S[2][2];
#pragma unroll
            for (int i = 0; i < 2; ++i)
#pragma unroll
                for (int j = 0; j < 2; ++j)
#pragma unroll
                    for (int e = 0; e < 16; ++e) S[i][j][e] = 0.f;
            u32x4 rq[4], rk[4], rv[4];
#define RET_ROFF(i) (dir ? 127 - (sn + 32 * (i)) : (sn + 32 * (i)))
#define RET_ROFF2(i) (dir ? 127 - (sn2_ + 32 * (i)) : (sn2_ + 32 * (i)))
#define RET_TOK(base, i) ((base) + (size_t)RET_ROFF(i))
#define RET_LOAD_QK(stp, dhp) do { const bool cx_ = (stp) < 2; const int ci_ = cx_ ? (dir ? 1 - (stp) : (stp)) : (dir ? 17 - (stp) : (stp) - 2); \
        const size_t rb_ = cx_ ? (size_t)MX + b * CL + ci_ * 128 : (size_t)b * SEQ + ci_ * 128; \
        const bf16_t* qp_ = Q1 + rb_ * 1024 + h * 256 + (dhp) * 128; const bf16_t* kp_ = K1 + rb_ * 1024 + h * 256 + (dhp) * 128; \
        int sn2_ = sn; asm volatile("" : "+v"(sn2_)); \
        _Pragma("unroll") for (int i_ = 0; i_ < 4; ++i_) { const int o_ = RET_ROFF2(i_) * 1024 + scc * 8; \
            if (PM == 3) { rq[i_] = (u32x4){0x3c003c00u, 0x3c003c00u, 0x3c003c00u, 0x3c003c00u}; rk[i_] = rq[i_]; } else { \
            if (!cx_) rq[i_] = *(const u32x4*)(qp_ + o_); \
            rk[i_] = *(const u32x4*)(kp_ + o_); } } } while (0)
#define RET_LOAD_V(stp) do { const bool cx_ = (stp) < 2; const int ci_ = cx_ ? (dir ? 1 - (stp) : (stp)) : (dir ? 17 - (stp) : (stp) - 2); \
        const size_t rb_ = cx_ ? (size_t)MX + b * CL + ci_ * 128 : (size_t)b * SEQ + ci_ * 128; \
        const bf16_t* vp_ = V1 + rb_ * 2048 + h * 512 + sl * 128; \
        int sn2_ = sn; asm volatile("" : "+v"(sn2_)); \
        _Pragma("unroll") for (int i_ = 0; i_ < 4; ++i_) { const int o_ = RET_ROFF2(i_) * 2048 + scc * 8; if (PM == 3) rv[i_] = (u32x4){0x3c003c00u, 0x3c003c00u, 0x3c003c00u, 0x3c003c00u}; else rv[i_] = *(const u32x4*)(vp_ + o_); } } while (0)
            RET_LOAD_QK(0, 0); RET_LOAD_V(0);
            for (int st = 0; st < 18; ++st) {
                const bool isctx = st < 2;
                const int cidx = isctx ? (dir ? 1 - st : st) : (dir ? 17 - st : st - 2);
                gtarget += 4u;
                if (gctr != nullptr && tid == 0) { __hip_atomic_fetch_add(gctr, 1u, __ATOMIC_RELAXED, __HIP_MEMORY_SCOPE_AGENT);
                    for (int sp = 0; sp < 48 && __hip_atomic_load(gctr, __ATOMIC_RELAXED, __HIP_MEMORY_SCOPE_AGENT) < gtarget; ++sp) __builtin_amdgcn_s_sleep(2); }
                int r_l = r, hh_l = hh, sn_l = sn; float lg2_l = lg2; asm volatile("" : "+v"(r_l), "+v"(hh_l), "+v"(sn_l), "+v"(lg2_l));
                f32x16 sc[2], out[2];
#pragma unroll
                for (int i = 0; i < 2; ++i)
#pragma unroll
                    for (int e = 0; e < 16; ++e) { sc[i][e] = 0.f; out[i][e] = 0.f; }
#pragma unroll
                for (int dh = 0; dh < 2; ++dh) {
                    if (PM != 4) __syncthreads();
#pragma unroll
                    for (int i = 0; i < 4; ++i) { const int n = sn_l + 32 * i;
                        if (!isctx) *(LAS u32x4*)(QH + n * RS + scc * 8) = rq[i];
                        *(LAS u32x4*)(KH + n * RS + scc * 8) = rk[i];
                        if (dh == 0) *(LAS u32x4*)(VL + n * RS + scc * 8) = scale8(rv[i], 0.0625f * __builtin_amdgcn_exp2f(-lg2_l * (float)(n + 1))); }
                    if (!isctx) {
#pragma unroll
                        for (int i = 0; i < 2; ++i)
#pragma unroll
                            for (int g = 0; g < 4; ++g) { u32x2 w; w.x = pkbf(S[dh][i][4 * g], S[dh][i][4 * g + 1]); w.y = pkbf(S[dh][i][4 * g + 2], S[dh][i][4 * g + 3]);
                                *(LAS u32x2*)(SL + (32 * eb + r) * RS + 32 * (2 * dg + i) + 8 * g + 4 * hh) = w; }
                    }
                    if (PM != 4) __syncthreads();
                    if (dh == 0) RET_LOAD_QK(st, 1); else if (st + 1 < 18) RET_LOAD_QK(st + 1, 0);
                    if (!isctx) {
                        if (2 * mg <= nb) {
                            const bool two = 2 * mg + 1 <= nb;
#pragma unroll 2
                            for (int s = 0; s < 8; ++s) {
                                const bf16x8 qb_ = *(const LAS bf16x8*)(QH + o_row + 32 * nb * RS + 16 * s);
                                const bf16x8 k0 = *(const LAS bf16x8*)(KH + o_row + 32 * (2 * mg) * RS + 16 * s);
                                sc[0] = rmf<PM>(k0, qb_, sc[0]);
                                if (two) { const bf16x8 k1 = *(const LAS bf16x8*)(KH + o_row + 32 * (2 * mg + 1) * RS + 16 * s); sc[1] = rmf<PM>(k1, qb_, sc[1]); } }
                        }
#pragma unroll 2
                        for (int s = 0; s < 8; ++s) {
                            const bf16x8 sb = *(const LAS bf16x8*)(SL + o_row + 32 * eb * RS + 16 * s);
                            const bf16x8 q0 = *(const LAS bf16x8*)(QH + o_row + 32 * (2 * dg) * RS + 16 * s), q1 = *(const LAS bf16x8*)(QH + o_row + 32 * (2 * dg + 1) * RS + 16 * s);
                            out[0] = rmf<PM>(sb, q0, out[0]); out[1] = rmf<PM>(sb, q1, out[1]); }
                    }
#pragma unroll 2
                    for (int s = 0; s < 8; ++s) {
                        const LAS bf16_t* vp = VL + o_tr + 16 * s * RS + 32 * eb;
                        const bf16x8 vb = tr_pair(vp, vp + 4 * RS);
                        const LAS bf16_t* kp = KH + o_tr + 16 * s * RS + 32 * (2 * dg);
                        const bf16x8 ka0 = tr_pair(kp, kp + 4 * RS), ka1 = tr_pair(kp + 32, kp + 32 + 4 * RS);
                        S[dh][0] = rmf<PM>(ka0, vb, S[dh][0]); S[dh][1] = rmf<PM>(ka1, vb, S[dh][1]); }
                }
                if (!isctx) {
                    if (PM != 4) __syncthreads();
#pragma unroll
                    for (int i = 0; i < 2; ++i) { const bool diag = (2 * mg + i) == nb;
#pragma unroll
                        for (int g = 0; g < 4; ++g) { const int n = 32 * nb + r_l, m0 = 32 * (2 * mg + i) + 8 * g + 4 * hh_l;
                            float v0 = sc[i][4 * g], v1 = sc[i][4 * g + 1], v2 = sc[i][4 * g + 2], v3 = sc[i][4 * g + 3];
                            if (diag) { v0 = n >= m0 ? v0 : 0.f; v1 = n >= m0 + 1 ? v1 : 0.f; v2 = n >= m0 + 2 ? v2 : 0.f; v3 = n >= m0 + 3 ? v3 : 0.f; }
                            u32x2 w; w.x = pkbf(v0, v1); w.y = pkbf(v2, v3); *(LAS u32x2*)(QH + n * RS + m0) = w; } }
                    if (PM != 4) __syncthreads();
                }
                if (isctx) RET_LOAD_V(st + 1);
                if (!isctx) {
#pragma unroll 2
                    for (int s = 0; s < 4 * dg + 2; ++s) {
                        const LAS bf16_t* vp = VL + o_tr + 16 * s * RS + 32 * eb;
                        const bf16x8 vb = tr_pair(vp, vp + 4 * RS);
                        const bf16x8 p0 = *(const LAS bf16x8*)(QH + o_row + 32 * (2 * dg) * RS + 16 * s), p1 = *(const LAS bf16x8*)(QH + o_row + 32 * (2 * dg + 1) * RS + 16 * s);
                        out[0] = rmf<PM>(vb, p0, out[0]); out[1] = rmf<PM>(vb, p1, out[1]); }
#pragma unroll 2
                    for (int s = 4 * dg + 2; s < 4 * dg + 4; ++s) {
                        const LAS bf16_t* vp = VL + o_tr + 16 * s * RS + 32 * eb;
                        const bf16x8 vb = tr_pair(vp, vp + 4 * RS);
                        const bf16x8 p1 = *(const LAS bf16x8*)(QH + o_row + 32 * (2 * dg + 1) * RS + 16 * s);
                        out[1] = rmf<PM>(vb, p1, out[1]); }
#pragma unroll
                    for (int i = 0; i < 2; ++i) { const int n = 32 * (2 * dg + i) + r_l; const float f = __builtin_amdgcn_exp2f(lg2_l * (float)(n + 1));
#pragma unroll
                        for (int g = 0; g < 4; ++g) { u32x2 w; w.x = pkbf(out[i][4 * g] * f, out[i][4 * g + 1] * f); w.y = pkbf(out[i][4 * g + 2] * f, out[i][4 * g + 3] * f);
                            *(LAS u32x2*)(OL + n * RS + 32 * eb + 8 * g + 4 * hh_l) = w; } }
                    if (st + 1 < 18) RET_LOAD_V(st + 1);
                    if (PM != 4) __syncthreads();
                    const size_t lb = ((size_t)b * SEQ + cidx * 128) * 2048 + h * 512 + sl * 128;
                    bf16_t* ofb = OF + lb; bf16_t* vob = V1 + lb;
#pragma unroll
                    for (int i = 0; i < 4; ++i) { const int n = sn_l + 32 * i; const int off = (dir ? 127 - n : n) * 2048 + scc * 8;
                        const u32x4 v = *(const LAS u32x4*)(OL + n * RS + scc * 8);
                        if (dir == 0) *(u32x4*)(ofb + off) = v;
                        else { const u32x4 o = *(const u32x4*)(ofb + off);
                            const float t0 = bf_lo(v.x) + bf_lo(o.x), t1 = bf_hi(v.x) + bf_hi(o.x), t2 = bf_lo(v.y) + bf_lo(o.y), t3 = bf_hi(v.y) + bf_hi(o.y), t4 = bf_lo(v.z) + bf_lo(o.z), t5 = bf_hi(v.z) + bf_hi(o.z), t6 = bf_lo(v.w) + bf_lo(o.w), t7 = bf_hi(v.w) + bf_hi(o.w);
                            u32x4 w; w.x = pkbf(t0, t1); w.y = pkbf(t2, t3); w.z = pkbf(t4, t5); w.w = pkbf(t6, t7); *(u32x4*)(vob + off) = w;
                            float s0 = ((t0 + t1) + (t2 + t3)) + ((t4 + t5) + (t6 + t7)), s1 = ((t0 * t0 + t1 * t1) + (t2 * t2 + t3 * t3)) + ((t4 * t4 + t5 * t5) + (t6 * t6 + t7 * t7));
#pragma unroll
                            for (int o2 = 1; o2 < 16; o2 <<= 1) { s0 += __shfl_xor(s0, o2); s1 += __shfl_xor(s1, o2); }
                            if (scc == 0) { const int ro_ = dir ? 127 - (sn_l + 32 * i) : (sn_l + 32 * i); float* gp = gstats + ((size_t)b * SEQ + cidx * 128) * 8 + h * 2 + ro_ * 8; atomicAdd(gp, s0); atomicAdd(gp + 1, s1); } }
                        asm volatile("" ::: "memory"); }
                }
#pragma unroll
                for (int i = 0; i < 2; ++i)
#pragma unroll
                    for (int j = 0; j < 2; ++j)
#pragma unroll
                        for (int e = 0; e < 16; ++e) S[i][j][e] *= cd;
            }
#undef RET_TOK
#undef RET_ROFF
#undef RET_ROFF2
#undef RET_LOAD_QK
#undef RET_LOAD_V
        }
    }
}

#define XB_TMO      128
#define XB_XCNT(j)  (256  + 64 * (j))
#define XB_XSUB(j)  (1280 + 64 * (j))
#define XB_XGEN(j)  (2304 + 64 * (j))
#define XB_TOP      3328
#define XB_TOPGEN   3392
#define XCD_BAR_WORDS 3456
#define XB_SPIN_CAP (1u << 18)

__device__ __forceinline__ unsigned xb_ld(unsigned* p)              { return __hip_atomic_load(p, __ATOMIC_RELAXED, __HIP_MEMORY_SCOPE_AGENT); }
__device__ __forceinline__ unsigned xb_add(unsigned* p, unsigned v) { return __hip_atomic_fetch_add(p, v, __ATOMIC_RELAXED, __HIP_MEMORY_SCOPE_AGENT); }
__device__ __forceinline__ unsigned xb_xcc_id() { return (unsigned)__builtin_amdgcn_s_getreg((3 << 11) | 20) & 0xFu; }
#define XB_SPIN(cond, bar) do { unsigned _sp = 0; while (cond) { __builtin_amdgcn_s_sleep(1); \
    if ((++_sp & 255u) == 0u) { if (xb_ld(&(bar)[XB_TMO])) break; if (_sp > XB_SPIN_CAP) { atomicAdd(&(bar)[XB_TMO], 1u); break; } } } } while (0)

struct XcdBarrier {
    unsigned* bar; unsigned x;
    volatile LAS unsigned* st;
};

__device__ __forceinline__ XcdBarrier xcd_barrier_post(unsigned* bar, volatile LAS unsigned* st) {
    XcdBarrier b; b.bar = bar; b.x = xb_xcc_id(); b.st = st;
    if (threadIdx.x == 0) (void)xb_add(&bar[XB_XCNT(b.x)], 1u);
    return b;
}
__device__ __forceinline__ void xcd_barrier_complete(unsigned* bar, unsigned x, unsigned& nloc, unsigned& nx) {
    const unsigned G = gridDim.x * gridDim.y * gridDim.z;
    unsigned sum, cnt, mine, sp = 0u;
    for (;;) {
        sum = 0u; cnt = 0u; mine = 0u;
#pragma unroll
        for (unsigned j = 0; j < 16; ++j) { const unsigned c = xb_ld(&bar[XB_XCNT(j)]); sum += c; cnt += (c > 0u) ? 1u : 0u; mine = (j == x) ? c : mine; }
        if (sum == G) break;
        __builtin_amdgcn_s_sleep(1);
        if ((++sp & 255u) == 0u) { if (xb_ld(&bar[XB_TMO])) break; if (sp > XB_SPIN_CAP) { atomicAdd(&bar[XB_TMO], 1u); break; } }
    }
    nloc = mine > 0u ? mine : 1u; nx = cnt > 0u ? cnt : 1u;
}

__device__ __forceinline__ void xcd_barrier(const XcdBarrier& b) {
    asm volatile("s_waitcnt vmcnt(0)" ::: "memory");
    __syncthreads();
    if (threadIdx.x == 0) {
        unsigned* bar = b.bar;
        __builtin_amdgcn_s_waitcnt(0);
        unsigned nloc = b.st[0], nx = b.st[1];
        if (nloc == 0u) { xcd_barrier_complete(bar, b.x, nloc, nx); b.st[0] = nloc; b.st[1] = nx; }
        const unsigned old = xb_add(&bar[XB_XSUB(b.x)], 1u);
        const unsigned gen = old / nloc;
        if (old + 1u == (gen + 1u) * nloc) {
            __builtin_amdgcn_fence(__ATOMIC_RELEASE, "agent");
            asm volatile("s_waitcnt vmcnt(0)" ::: "memory");
            const unsigned og = xb_add(&bar[XB_TOP], 1u);
            const unsigned tg = og / nx;
            if (og + 1u == (tg + 1u) * nx) xb_add(&bar[XB_TOPGEN], 1u);
            else XB_SPIN(xb_ld(&bar[XB_TOPGEN]) == tg, bar);
            __builtin_amdgcn_fence(__ATOMIC_ACQUIRE, "agent");
            xb_add(&bar[XB_XGEN(b.x)], 1u);
            asm volatile("s_waitcnt vmcnt(0)" ::: "memory");
        } else {
            XB_SPIN(xb_ld(&bar[XB_XGEN(b.x)]) == gen, bar);
            __builtin_amdgcn_fence(__ATOMIC_ACQUIRE, "agent");
            asm volatile("s_waitcnt vmcnt(0)" ::: "memory");
        }
    }
    __syncthreads();
}

__global__ void __launch_bounds__(512, 2) mega_fwd(Args a) {
    extern __shared__ __attribute__((aligned(16))) unsigned char lds_raw[];
    LAS unsigned char* lds = (LAS unsigned char*)lds_raw;
    cg::grid_group grid = cg::this_grid();
    volatile LAS unsigned* xb_st = (volatile LAS unsigned*)(lds + XB_LDS_OFF);
    if (threadIdx.x < 4) xb_st[threadIdx.x] = 0u;
    __syncthreads();
    const XcdBarrier xbar = xcd_barrier_post((unsigned*)(a.ws + WS_BAR), xb_st);
    unsigned char* const ws = a.ws;
    const int lo = a.ph_lo, hi = a.ph_hi;
#ifndef NO_RET
#define NO_RET 0
#endif
#ifndef NO_ATTN
#define NO_ATTN 0
#endif
#ifndef NO_GEMM
#define NO_GEMM 0
#endif
#define IN(k) (lo <= (k) && (k) < hi)
#define TID ({ int t_ = threadIdx.x; asm volatile("" : "+v"(t_)); t_; })
#define SYNC(k) do { if (lo <= (k) && (k) + 1 < hi) { if ((k) == 0) grid.sync(); else xcd_barrier(xbar); } } while (0)
#define MODP ((float*)(ws + WS_MOD))
#define BF(off) ((bf16_t*)(ws + (off)))
#define GEMM(EpiT, Aoff, Boff, M_, N_, K_, E) do { const pg8::Gemm g_{BF(Aoff), BF(Boff), (M_), (N_), (K_)}; pg8::StaticOrder S_; S_.init((M_), (N_), (int)gridDim.x, (int)blockIdx.x); \
        if (!NO_GEMM) pg8::gemm_phase<EpiT, pg8::StaticOrder, PG8_ALIGN, PG8_SP2>(lds, g_, S_, E); } while (0)
    if (IN(0)) { phase0(a, lds, TID); } SYNC(0);
    if (IN(1)) { norm_phase<false>(a.in[0], a.in[2], nullptr, a.in[6], MODP, MODP + 1024, MA, BF(WS_H), TID); } SYNC(1);
    if (IN(2)) { const EpiQKV0 e{BF(WS_QKV0), a.in[11], a.in[12], (const float*)(ws + WS_TAB0)}; GEMM(EpiQKV0, WS_H, WS_WQKV0, MA, 1536, 1024, e); } SYNC(2);
    if (IN(3) && !NO_ATTN) { attn_phase(lds, BF(WS_QKV0), BF(WS_H), a.in[13], a.in[11], a.in[12], TID); } SYNC(3);
    if (IN(4)) { const EpiResid<0> e{a.in[0], a.in[2], BF(WS_X), nullptr, MODP + 2048}; GEMM(EpiResid<0>, WS_H, WS_WO0, MA, 1024, 1024, e); } SYNC(4);
    if (IN(5)) { norm_phase<true>(nullptr, nullptr, BF(WS_X), a.in[7], MODP + 3072, MODP + 4096, MA, BF(WS_H), TID); } SYNC(5);
    if (IN(6)) { const EpiSwiglu e{BF(WS_ACT0)}; GEMM(EpiSwiglu, WS_H, WS_WIN0, MA, 5632, 1024, e); } SYNC(6);
    if (IN(7)) { const EpiResid<1> e{nullptr, nullptr, BF(WS_X), nullptr, MODP + 5120}; GEMM(EpiResid<1>, WS_ACT0, WS_WOUT0, MA, 1024, 2816, e); } SYNC(7);
    if (IN(8)) { norm_phase<true>(nullptr, nullptr, BF(WS_X), a.in[6] + 1024, MODP + 33 * 6144, MODP + 33 * 6144 + 1024, MA, BF(WS_HL1), TID); } SYNC(8);
    if (IN(9)) { const EpiQKV1 e{BF(WS_Q1), BF(WS_K1), BF(WS_V1), (const float*)(ws + WS_TAB1)}; GEMM(EpiQKV1, WS_HL1, WS_WR, MA, 4096, 1024, e); } SYNC(9);
    if (IN(10) && !NO_RET) { ret_phase<0>(lds, BF(WS_Q1), BF(WS_K1), BF(WS_V1), (bf16_t*)a.out, (float*)(ws + WS_GNS), nullptr, a.in[16], TID); } SYNC(10);
    if (IN(11)) { const EpiGate e{BF(WS_V1), (const float*)(ws + WS_GNS), a.in[17]}; GEMM(EpiGate, WS_HL1, WS_WR + (size_t)4096 * 1024 * 2, MX, 2048, 1024, e); } SYNC(11);
    if (IN(12)) { const EpiResid<1> e{nullptr, nullptr, BF(WS_X), nullptr, MODP + 33 * 6144 + 2048}; GEMM(EpiResid<1>, WS_V1, WS_WRO, MX, 1024, 2048, e); } SYNC(12);
    if (IN(13)) { norm_phase<true>(nullptr, nullptr, BF(WS_X), a.in[7] + 1024, MODP + 33 * 6144 + 3072, MODP + 33 * 6144 + 4096, MX, BF(WS_Q1), TID); } SYNC(13);
    if (IN(14)) { const EpiSwiglu e{BF(WS_ACT1)}; GEMM(EpiSwiglu, WS_Q1, WS_WIN1, MX, 5632, 1024, e); } SYNC(14);
    if (IN(15)) { const EpiResid<2> e{nullptr, nullptr, BF(WS_X), a.out, MODP + 33 * 6144 + 5120}; GEMM(EpiResid<2>, WS_ACT1, WS_WOUT1, MX, 1024, 2816, e); }
#ifdef PROBE_UP1
    grid.sync();
    { const EpiSwiglu e{BF(WS_ACT1)}; GEMM(EpiSwiglu, WS_Q1, WS_WIN1, MX, 5632, 1024, e); }
#endif
#ifdef PROBE_RET
    grid.sync();
    ret_phase<PROBE_RET - 1>(lds, BF(WS_Q1), BF(WS_K1), BF(WS_V1), BF(WS_V1), (float*)(ws + WS_GNS), nullptr, a.in[16], TID);
#endif
#ifdef PROBE_SYNC
    for (int i = 0; i < 20; ++i) grid.sync();
#endif
#ifdef PROBE_RESID
    grid.sync();
    { const EpiResid<1> e{nullptr, nullptr, BF(WS_HL1), nullptr, MODP + 33 * 6144 + 2048}; GEMM(EpiResid<1>, WS_V1, WS_WRO, MX, 1024, 2048, e); }
    grid.sync();
    { const EpiResid<1> e{nullptr, nullptr, BF(WS_HL1), nullptr, MODP + 33 * 6144 + 5120}; GEMM(EpiResid<1>, WS_ACT1, WS_WOUT1, MX, 1024, 2816, e); }
#endif
#ifdef PROBE_NORM
    grid.sync();
    norm_phase<true>(nullptr, nullptr, BF(WS_X), a.in[7] + 1024, MODP + 33 * 6144 + 3072, MODP + 33 * 6144 + 4096, MX, BF(WS_Q1), TID);
    grid.sync();
    phase0(a, lds, TID);
#endif
}


#ifndef MK_MULTI
#define MK_MULTI 0
#endif
extern "C" void kernel_launch(void* const* d_in, const int* in_sizes, int n_in, void* d_out, int out_size, void* d_ws, size_t ws_size, hipStream_t stream) {
    static int grid = 0;
    if (grid == 0) {
        int dev = 0, cus = 0, per_cu = 0;
        (void)hipGetDevice(&dev); (void)hipDeviceGetAttribute(&cus, hipDeviceAttributeMultiprocessorCount, dev);
        if (hipFuncSetAttribute((const void*)mega_fwd, hipFuncAttributeMaxDynamicSharedMemorySize, LDS_BYTES) != hipSuccess) fprintf(stderr, "kernel_launch: hipFuncSetAttribute failed\n");
        if (hipOccupancyMaxActiveBlocksPerMultiprocessor(&per_cu, (const void*)mega_fwd, 512, LDS_BYTES) != hipSuccess || per_cu < 1) { fprintf(stderr, "kernel_launch: occupancy query says %d blocks/CU\n", per_cu); per_cu = 1; }
        (void)hipGetLastError();
        grid = cus > 0 ? cus : 256;
        if (n_in != 19 || ws_size < WS_END) fprintf(stderr, "kernel_launch: unexpected n_in %d / ws_size %zu (need %zu)\n", n_in, ws_size, (size_t)WS_END);
    }
    (void)hipMemsetAsync((unsigned char*)d_ws + WS_BAR, 0, 65536, stream);
    Args a{};
    for (int i = 0; i < 19; ++i) a.in[i] = (const float*)d_in[i];
    a.out = (float*)d_out; a.ws = (unsigned char*)d_ws;
#if MK_MULTI
    for (int ph = 0; ph < NPHASE; ++ph) { a.ph_lo = ph; a.ph_hi = ph + 1; hipLaunchKernelGGL(mega_fwd, dim3(grid), dim3(512), LDS_BYTES, stream, a); }
#else
    a.ph_lo = 0; a.ph_hi = NPHASE;
    void* args[] = {&a};
    const hipError_t e = hipLaunchCooperativeKernel((const void*)mega_fwd, dim3(grid), dim3(512), args, LDS_BYTES, stream);
    if (e != hipSuccess) fprintf(stderr, "kernel_launch: cooperative launch failed: %s (grid %d)\n", hipGetErrorString(e), grid);
#endif
}
```

```cpp
#include <hip/hip_runtime.h>
#include <hip/hip_cooperative_groups.h>
#include <cstdio>
#include <cstdint>
namespace cg = cooperative_groups;

namespace pg8 {
#define PG8_LAS __attribute__((address_space(3)))
typedef unsigned short bf16_t;
typedef short bf16x8 __attribute__((ext_vector_type(8)));
typedef float f32x4 __attribute__((ext_vector_type(4)));
typedef unsigned u32x4 __attribute__((ext_vector_type(4)));
constexpr int BM = 256, BK = 64, HALF = 128, HTB = HALF * BK * 2  , STAGE_BYTES = 8 * HTB, NXCD = 8, WGM = 8;

__host__ __device__ __forceinline__ int lds_byte(int r, int c) { const int st = (r >> 4) * 2 + (c >> 5), rr = r & 15, cc = c & 31, ob = rr * 64 + cc * 2; return st * 1024 + (ob ^ (((ob >> 9) & 1) << 5)); }
__host__ __device__ __forceinline__ void stage_rc(int b, int& R, int& C) { const int st = b / 1024, sb = b % 1024, swz = sb ^ (((sb >> 9) & 1) << 5); R = (st >> 1) * 16 + swz / 64; C = (st & 1) * 32 + (swz % 64) / 2; }
__host__ __device__ __forceinline__ int perm32(int rho) { const int n = rho >> 4, i = rho & 15; return 8 * (i >> 2) + 4 * n + (i & 3); }

struct Unit { int pm, pn; };
struct Gemm { const bf16_t* A; const bf16_t* Bt; int M, N, K; };

struct StaticOrder {
    int nM, nN, nwg, G, c;
    __host__ __device__ void init(int M, int N, int G_, int c_) { nM = M / BM; nN = N / BM; nwg = nM * nN; G = G_; c = c_; }
    __host__ __device__ bool next(int i, Unit& u) const {
        const long L = (long)i * G + c; if (L >= nwg) return false;
        int wgid = (int)L; { const int q = nwg / NXCD, r = nwg % NXCD, xcd = wgid % NXCD, off = wgid / NXCD; wgid = (xcd < r ? xcd * (q + 1) : r * (q + 1) + (xcd - r) * q) + off; }
        const int nig = WGM * nN, gid = wgid / nig, fm = gid * WGM, gsz = (nM - fm) < WGM ? (nM - fm) : WGM;
        u.pm = fm + ((wgid % nig) % gsz); u.pn = (wgid % nig) / gsz; return true;
    }
    __device__ __forceinline__ void a_ready(const Unit&) const {}
    __device__ __forceinline__ void done(const Unit&) const {}
};

__device__ __forceinline__ unsigned cvt_pk_bf16(float lo, float hi) { unsigned r; asm volatile("v_cvt_pk_bf16_f32 %0, %1, %2" : "=v"(r) : "v"(lo), "v"(hi)); return r; }
typedef float f32x2 __attribute__((ext_vector_type(2)));
template <class Epi, class Sched, bool ALIGN_EPI = false, bool SP2 = false>
__device__ __forceinline__ void gemm_phase(PG8_LAS unsigned char* lds, const Gemm g, const Sched& S, const Epi& E) {
    int tid_l = threadIdx.x; asm volatile("" : "+v"(tid_l));
    const int tid = tid_l, wid = __builtin_amdgcn_readfirstlane(tid >> 6), lane = tid & 63, wr = wid >> 2, wc = wid & 3, fr = lane & 15, fq = lane >> 4;
    const int K = g.K, nt = K / BK;
    unsigned voffA[2], voffB[2];
#pragma unroll
    for (int i = 0; i < 2; ++i) { int R, C; stage_rc(tid * 16 + i * 8192, R, C); const int Rb = Epi::PERM ? ((R & ~31) + perm32(R & 31)) : R;
        voffA[i] = (unsigned)(R * K + C) * 2u; voffB[i] = (unsigned)(Rb * K + C) * 2u; }
    const size_t kstep = (size_t)(BK * 2);
    const size_t hstep = (size_t)HALF * K * 2;
    const size_t tstep = 2 * hstep;
    const unsigned ldsw = (unsigned)wid * 1024u;
    const int aoff = lds_byte(wr * 64 + fr, fq * 8), boff = lds_byte(wc * 32 + fr, fq * 8);
#define PG8_SA(b, h) (((b) * 2 + (h)) * HTB)
#define PG8_SB(b, h) ((4 + (b) * 2 + (h)) * HTB)
#define PG8_STAGE(bufoff, gbase, voff) do { _Pragma("unroll") for (int _i = 0; _i < 2; ++_i) \
        __builtin_amdgcn_global_load_lds((const unsigned*)((const char*)(gbase) + (voff)[_i]), (PG8_LAS unsigned*)(lds + (bufoff) + ldsw + _i * 8192), 16, 0, 0); } while (0)
#define PG8_LDA(dst, b, h) do { _Pragma("unroll") for (int m = 0; m < 4; ++m) _Pragma("unroll") for (int k = 0; k < 2; ++k) dst[m][k] = *(const PG8_LAS bf16x8*)(lds + PG8_SA(b, h) + aoff + m * 2048 + k * 1024); } while (0)
#define PG8_LDB(dst, b, h) do { _Pragma("unroll") for (int n = 0; n < 2; ++n) _Pragma("unroll") for (int k = 0; k < 2; ++k) dst[n][k] = *(const PG8_LAS bf16x8*)(lds + PG8_SB(b, h) + boff + n * 2048 + k * 1024); } while (0)
#define PG8_MMA(ai, bj, At, Bt) do { __builtin_amdgcn_s_setprio(1); _Pragma("unroll") for (int m = 0; m < 4; ++m) _Pragma("unroll") for (int n = 0; n < 2; ++n) _Pragma("unroll") for (int k = 0; k < 2; ++k) \
        acc[ai][bj][m][n] = __builtin_amdgcn_mfma_f32_16x16x32_bf16(Bt[n][k], At[m][k], acc[ai][bj][m][n], 0, 0, 0); __builtin_amdgcn_s_setprio(0); } while (0)
#define PG8_WAIT_V(n) asm volatile("s_waitcnt vmcnt(" #n ")" ::: "memory")
#define PG8_WAIT_L(n) asm volatile("s_waitcnt lgkmcnt(" #n ")" ::: "memory")
#define PG8_BAR __builtin_amdgcn_s_barrier()
#define PG8_SCHED __builtin_amdgcn_sched_barrier(0)
    Unit cur, nxt; int ui = 0;
    if (!S.next(0, cur)) return;
    f32x4 acc[2][2][4][2];
#pragma unroll
    for (int a = 0; a < 2; ++a)
#pragma unroll
        for (int b = 0; b < 2; ++b)
#pragma unroll
            for (int m = 0; m < 4; ++m)
#pragma unroll
                for (int n = 0; n < 2; ++n) acc[a][b][m][n] = (f32x4){0.f, 0.f, 0.f, 0.f};
    bf16x8 At[4][2], B0[2][2], B1[2][2];
    const char* cA = (const char*)g.A + (size_t)cur.pm * tstep; const char* cB = (const char*)g.Bt + (size_t)cur.pn * tstep;
    S.a_ready(cur);
    if constexpr (SP2) {
        PG8_STAGE(PG8_SB(0, 0), cB, voffB); PG8_STAGE(PG8_SB(0, 1), cB + hstep, voffB); PG8_STAGE(PG8_SA(0, 0), cA, voffA); PG8_STAGE(PG8_SA(0, 1), cA + hstep, voffA);
        if (wr == 1) PG8_BAR;
        PG8_WAIT_V(2); PG8_BAR;
        PG8_STAGE(PG8_SB(1, 0), cB + kstep, voffB); PG8_STAGE(PG8_SA(1, 0), cA + kstep, voffA); PG8_STAGE(PG8_SB(1, 1), cB + hstep + kstep, voffB);
        PG8_WAIT_V(6); PG8_BAR;
    } else {
        PG8_STAGE(PG8_SB(0, 0), cB, voffB); PG8_STAGE(PG8_SA(0, 0), cA, voffA); PG8_STAGE(PG8_SB(0, 1), cB + hstep, voffB); PG8_STAGE(PG8_SA(0, 1), cA + hstep, voffA);
        if (wr == 1) PG8_BAR;
        PG8_WAIT_V(4); PG8_BAR;
        PG8_STAGE(PG8_SB(1, 0), cB + kstep, voffB); PG8_STAGE(PG8_SA(1, 0), cA + kstep, voffA); PG8_STAGE(PG8_SB(1, 1), cB + hstep + kstep, voffB);
        PG8_WAIT_V(6); PG8_BAR;
    }
    for (;;) {
        const bool has_next = S.next(ui + 1, nxt);
        const char* nA = has_next ? (const char*)g.A + (size_t)nxt.pm * tstep : cA; const char* nB = has_next ? (const char*)g.Bt + (size_t)nxt.pn * tstep : cB;
        for (int t = 0; t < nt; t += 2) {
            const bool last = (t == nt - 2);
            const char* a1 = cA + (size_t)(t + 1) * kstep;
            const char* a2 = last ? nA : cA + (size_t)(t + 2) * kstep; const char* b2 = last ? nB : cB + (size_t)(t + 2) * kstep;
            const char* a3 = a2 + kstep; const char* b3 = b2 + kstep;
            if (last && has_next) S.a_ready(nxt);
            if constexpr (SP2) {
            PG8_LDB(B0, 0, 0); PG8_LDB(B1, 0, 1); PG8_SCHED; PG8_LDA(At, 0, 0); PG8_STAGE(PG8_SA(1, 1), a1 + hstep, voffA);
            PG8_WAIT_V(8); PG8_WAIT_L(0); PG8_BAR; PG8_MMA(0, 0, At, B0); PG8_MMA(0, 1, At, B1); PG8_BAR; PG8_SCHED;
            PG8_LDA(At, 0, 1); PG8_STAGE(PG8_SB(0, 0), b2, voffB); PG8_STAGE(PG8_SB(0, 1), b2 + hstep, voffB); PG8_STAGE(PG8_SA(0, 0), a2, voffA);
            PG8_WAIT_V(8); PG8_WAIT_L(0); PG8_BAR; PG8_MMA(1, 0, At, B0); PG8_MMA(1, 1, At, B1); PG8_BAR; PG8_SCHED;
            PG8_LDB(B0, 1, 0); PG8_LDB(B1, 1, 1); PG8_SCHED; PG8_LDA(At, 1, 0); PG8_STAGE(PG8_SA(0, 1), a2 + hstep, voffA);
            PG8_WAIT_V(8); PG8_WAIT_L(0); PG8_BAR; PG8_MMA(0, 0, At, B0); PG8_MMA(0, 1, At, B1); PG8_BAR; PG8_SCHED;
            PG8_LDA(At, 1, 1); PG8_STAGE(PG8_SB(1, 0), b3, voffB); PG8_STAGE(PG8_SB(1, 1), b3 + hstep, voffB); PG8_STAGE(PG8_SA(1, 0), a3, voffA);
            PG8_WAIT_V(8); PG8_WAIT_L(0); PG8_BAR; PG8_MMA(1, 0, At, B0); PG8_MMA(1, 1, At, B1); PG8_BAR; PG8_SCHED;
            } else {
            PG8_LDB(B0, 0, 0); PG8_SCHED; PG8_LDA(At, 0, 0); PG8_STAGE(PG8_SA(1, 1), a1 + hstep, voffA);
            PG8_WAIT_L(8); PG8_BAR; PG8_WAIT_L(0); PG8_MMA(0, 0, At, B0); PG8_BAR; PG8_SCHED;
            PG8_LDB(B1, 0, 1); PG8_STAGE(PG8_SB(0, 0), b2, voffB);
            PG8_BAR; PG8_WAIT_L(0); PG8_MMA(0, 1, At, B1); PG8_BAR;
            PG8_LDA(At, 0, 1); PG8_STAGE(PG8_SA(0, 0), a2, voffA);
            PG8_BAR; PG8_WAIT_L(0); PG8_MMA(1, 0, At, B0); PG8_BAR; PG8_SCHED;
            PG8_STAGE(PG8_SB(0, 1), b2 + hstep, voffB);
            PG8_WAIT_V(6); PG8_BAR; PG8_MMA(1, 1, At, B1); PG8_BAR;
            PG8_LDB(B0, 1, 0); PG8_SCHED; PG8_LDA(At, 1, 0); PG8_STAGE(PG8_SA(0, 1), a2 + hstep, voffA);
            PG8_WAIT_L(8); PG8_BAR; PG8_WAIT_L(0); PG8_MMA(0, 0, At, B0); PG8_BAR; PG8_SCHED;
            PG8_LDB(B1, 1, 1); PG8_STAGE(PG8_SB(1, 0), b3, voffB);
            PG8_BAR; PG8_WAIT_L(0); PG8_MMA(0, 1, At, B1); PG8_BAR;
            PG8_LDA(At, 1, 1); PG8_STAGE(PG8_SA(1, 0), a3, voffA);
            PG8_BAR; PG8_WAIT_L(0); PG8_MMA(1, 0, At, B0); PG8_BAR; PG8_SCHED;
            PG8_STAGE(PG8_SB(1, 1), b3 + hstep, voffB);
            PG8_WAIT_V(6); PG8_BAR; PG8_MMA(1, 1, At, B1); PG8_BAR;
            }
        }
        if constexpr (ALIGN_EPI) { if (wr == 0) PG8_BAR; }
        if constexpr (!Epi::AFTER_DRAIN) { E(acc, cur, wr, wc, fr, fq); S.done(cur); }
        if (!has_next) break;
#pragma unroll
        for (int a = 0; a < 2; ++a)
#pragma unroll
            for (int b = 0; b < 2; ++b)
#pragma unroll
                for (int m = 0; m < 4; ++m)
#pragma unroll
                    for (int n = 0; n < 2; ++n) acc[a][b][m][n] = (f32x4){0.f, 0.f, 0.f, 0.f};
        cur = nxt; cA = nA; cB = nB; ++ui;
        if constexpr (ALIGN_EPI) { if (wr == 1) PG8_BAR; }
    }
    PG8_WAIT_V(0);
    if constexpr (!ALIGN_EPI) { if (wr == 0) PG8_BAR; }
    PG8_BAR;
    if constexpr (Epi::AFTER_DRAIN) { E.fused(acc, cur, wr, wc, fr, fq, lds, wid, lane); S.done(cur); }
#undef PG8_SA
#undef PG8_SB
#undef PG8_STAGE
#undef PG8_LDA
#undef PG8_LDB
#undef PG8_MMA
#undef PG8_WAIT_V
#undef PG8_WAIT_L
#undef PG8_BAR
#undef PG8_SCHED
}
}

#ifndef PG8_SP2
#define PG8_SP2 true
#endif
#ifndef PG8_ALIGN
#define PG8_ALIGN true
#endif

#define LAS __attribute__((address_space(3)))
typedef unsigned short bf16_t;
typedef short bf16x8 __attribute__((ext_vector_type(8)));
typedef short s16x4 __attribute__((ext_vector_type(4)));
typedef float f32x4 __attribute__((ext_vector_type(4)));
typedef float f32x16 __attribute__((ext_vector_type(16)));
typedef unsigned u32x4 __attribute__((ext_vector_type(4)));
typedef unsigned u32x2 __attribute__((ext_vector_type(2)));

constexpr int NB = 32, SEQ = 2048, DM = 1024, CL = 256, MX = NB * SEQ, MC = NB * CL, MA = MX + MC, DFF = 2816;
constexpr float LOG2E = 1.4426950408889634f;
constexpr float EPSN = 1e-6f;
constexpr size_t MiB = (size_t)1 << 20;
constexpr size_t WS_WQKV0 = 1 * MiB, WS_WO0 = 4 * MiB, WS_WIN0 = 6 * MiB, WS_WOUT0 = 17 * MiB, WS_WR = 23 * MiB, WS_WRO = 35 * MiB, WS_WIN1 = 39 * MiB, WS_WOUT1 = 50 * MiB;
constexpr size_t WS_MOD = 56 * MiB, WS_TAB0 = 58 * MiB, WS_TAB1 = 58 * MiB + 65536;
constexpr size_t WS_GNS = 60 * MiB;
constexpr size_t WS_X = 64 * MiB;
constexpr size_t WS_H = 208 * MiB, WS_QKV0 = 352 * MiB, WS_ACT0 = 352 * MiB;
constexpr size_t WS_Q1 = 208 * MiB, WS_K1 = 352 * MiB, WS_V1 = 496 * MiB, WS_HL1 = 784 * MiB, WS_ACT1 = 352 * MiB, WS_END = 1024 * MiB;
constexpr int LDS_BYTES = 152 * 1024, XB_LDS_OFF = 150 * 1024;
constexpr size_t WS_BAR = 62 * MiB;
constexpr int NPHASE = 16;

__device__ __forceinline__ unsigned pkbf(float lo, float hi) { return pg8::cvt_pk_bf16(lo, hi); }
__device__ __forceinline__ float bf_lo(unsigned w) { return __builtin_bit_cast(float, w << 16); }
__device__ __forceinline__ float bf_hi(unsigned w) { return __builtin_bit_cast(float, w & 0xffff0000u); }
__device__ __forceinline__ float bf2f(bf16_t v) { return __builtin_bit_cast(float, (unsigned)v << 16); }
__device__ __forceinline__ float wave_sum(float v) {
#pragma unroll
    for (int o = 1; o < 64; o <<= 1) v += __shfl_xor(v, o);
    return v;
}
__device__ __forceinline__ float fast_silu(float x) { return x * __builtin_amdgcn_rcpf(1.0f + __expf(-x)); }

struct EpiSplit {
    static constexpr bool PERM = true, AFTER_DRAIN = false;
    bf16_t* d0; int ld0; int t1; bf16_t* d1; int ld1; int t2; bf16_t* d2; int ld2;
    __device__ __forceinline__ void operator()(const pg8::f32x4 (&acc)[2][2][4][2], const pg8::Unit& u, int wr, int wc, int fr, int fq) const {
        bf16_t* base; int ld, ct;
        if (u.pn < t1) { base = d0; ld = ld0; ct = u.pn; } else if (u.pn < t2) { base = d1; ld = ld1; ct = u.pn - t1; } else { base = d2; ld = ld2; ct = u.pn - t2; }
        const int row0 = u.pm * 256 + wr * 64 + fr, col0 = ct * 256 + wc * 32 + 8 * fq;
#pragma unroll
        for (int ai = 0; ai < 2; ++ai)
#pragma unroll
            for (int m = 0; m < 4; ++m) { bf16_t* rowp = base + (size_t)(row0 + ai * 128 + m * 16) * ld + col0;
#pragma unroll
                for (int bj = 0; bj < 2; ++bj) { const pg8::f32x4 v0 = acc[ai][bj][m][0], v1 = acc[ai][bj][m][1]; u32x4 w;
                    w.x = pkbf(v0[0], v0[1]); w.y = pkbf(v0[2], v0[3]); w.z = pkbf(v1[0], v1[1]); w.w = pkbf(v1[2], v1[3]);
                    *(u32x4*)(rowp + bj * 128) = w; } }
    }
};
struct EpiQKV0 {
    static constexpr bool PERM = true, AFTER_DRAIN = false;
    bf16_t* O; const float* qg; const float* kg; const float* tab0;
    __device__ __forceinline__ void operator()(const pg8::f32x4 (&acc)[2][2][4][2], const pg8::Unit& u, int wr, int wc, int fr, int fq) const {
        const int row0 = u.pm * 256 + wr * 64 + fr, col0 = u.pn * 256 + wc * 32 + 8 * fq;
        if (u.pn >= 5) {
#pragma unroll
            for (int ai = 0; ai < 2; ++ai)
#pragma unroll
                for (int m = 0; m < 4; ++m) { bf16_t* rowp = O + (size_t)(row0 + ai * 128 + m * 16) * 1536 + col0;
#pragma unroll
                    for (int bj = 0; bj < 2; ++bj) { const pg8::f32x4 v0 = acc[ai][bj][m][0], v1 = acc[ai][bj][m][1]; u32x4 w;
                        w.x = pkbf(v0[0], v0[1]); w.y = pkbf(v0[2], v0[3]); w.z = pkbf(v1[0], v1[1]); w.w = pkbf(v1[2], v1[3]); *(u32x4*)(rowp + bj * 128) = w; } }
            return;
        }
        const float* gp = (u.pn < 4 ? qg : kg) + 8 * fq + (fq >= 2 ? 16 : 0);
        const float qs = u.pn < 4 ? 0.125f * LOG2E : 1.0f;
        pg8::f32x4 g1[2], g2[2];
#pragma unroll
        for (int n = 0; n < 2; ++n) { g1[n] = *(const pg8::f32x4*)(gp + 4 * n) * qs; g2[n] = *(const pg8::f32x4*)(gp + 16 + 4 * n) * qs; }
        const bool lat = u.pm * 256 < MX;
#pragma unroll
        for (int ai = 0; ai < 2; ++ai)
#pragma unroll
            for (int m = 0; m < 4; ++m) { const int row = row0 + ai * 128 + m * 16;
                pg8::f32x4 x1[2] = {acc[ai][0][m][0], acc[ai][0][m][1]}, x2[2] = {acc[ai][1][m][0], acc[ai][1][m][1]};
                float ss = 0.f;
#pragma unroll
                for (int n = 0; n < 2; ++n) ss += (x1[n][0] * x1[n][0] + x1[n][1] * x1[n][1]) + (x1[n][2] * x1[n][2] + x1[n][3] * x1[n][3]) + (x2[n][0] * x2[n][0] + x2[n][1] * x2[n][1]) + (x2[n][2] * x2[n][2] + x2[n][3] * x2[n][3]);
                ss += __shfl_xor(ss, 16); ss += __shfl_xor(ss, 32);
                const float rstd = rsqrtf(ss * (1.0f / 64.0f) + EPSN);
#pragma unroll
                for (int n = 0; n < 2; ++n) { x1[n] = x1[n] * rstd * g1[n]; x2[n] = x2[n] * rstd * g2[n]; }
                if (lat) { const int s = row & (SEQ - 1), pos = (fq & 2) ? (s & 63) : (s >> 6);
                    const float* tp = tab0 + ((size_t)pos * 16 + 8 * (fq & 1)) * 2;
#pragma unroll
                    for (int n = 0; n < 2; ++n) { const pg8::f32x4 t0 = *(const pg8::f32x4*)(tp + 8 * n), t1 = *(const pg8::f32x4*)(tp + 8 * n + 4);
                        const pg8::f32x4 cs = {t0[0], t0[2], t1[0], t1[2]}, sn = {t0[1], t0[3], t1[1], t1[3]};
                        const pg8::f32x4 a = x1[n] * cs - x2[n] * sn, bb = x1[n] * sn + x2[n] * cs; x1[n] = a; x2[n] = bb; } }
                bf16_t* rowp = O + (size_t)row * 1536 + col0; u32x4 w;
                w.x = pkbf(x1[0][0], x1[0][1]); w.y = pkbf(x1[0][2], x1[0][3]); w.z = pkbf(x1[1][0], x1[1][1]); w.w = pkbf(x1[1][2], x1[1][3]); *(u32x4*)rowp = w;
                w.x = pkbf(x2[0][0], x2[0][1]); w.y = pkbf(x2[0][2], x2[0][3]); w.z = pkbf(x2[1][0], x2[1][1]); w.w = pkbf(x2[1][2], x2[1][3]); *(u32x4*)(rowp + 128) = w;
                asm volatile("" ::: "memory"); }
    }
};
struct EpiQKV1 {
    static constexpr bool PERM = true, AFTER_DRAIN = false;
    bf16_t* Qd; bf16_t* Kd; bf16_t* Vd; const float* tab1;
    __device__ __forceinline__ void operator()(const pg8::f32x4 (&acc)[2][2][4][2], const pg8::Unit& u, int wr, int wc, int fr, int fq) const {
        bf16_t* base; int ld, ct;
        if (u.pn < 4) { base = Qd; ld = 1024; ct = u.pn; } else if (u.pn < 8) { base = Kd; ld = 1024; ct = u.pn - 4; } else { base = Vd; ld = 2048; ct = u.pn - 8; }
        const int row0 = u.pm * 256 + wr * 64 + fr, col0 = ct * 256 + wc * 32 + 8 * fq;
        const bool rope = u.pn < 8 && u.pm * 256 < MX;
#pragma unroll
        for (int ai = 0; ai < 2; ++ai)
#pragma unroll
            for (int m = 0; m < 4; ++m) { const int row = row0 + ai * 128 + m * 16;
                pg8::f32x4 x1[2] = {acc[ai][0][m][0], acc[ai][0][m][1]}, x2[2] = {acc[ai][1][m][0], acc[ai][1][m][1]};
                if (rope) { const int s = row & (SEQ - 1), pos = (wc & 2) ? (s & 63) : (s >> 6);
                    const float* tp = tab1 + ((size_t)pos * 64 + 32 * (wc & 1) + 8 * fq) * 2;
#pragma unroll
                    for (int n = 0; n < 2; ++n) { const pg8::f32x4 t0 = *(const pg8::f32x4*)(tp + 8 * n), t1 = *(const pg8::f32x4*)(tp + 8 * n + 4);
                        const pg8::f32x4 cs = {t0[0], t0[2], t1[0], t1[2]}, sn = {t0[1], t0[3], t1[1], t1[3]};
                        const pg8::f32x4 a = x1[n] * cs - x2[n] * sn, bb = x1[n] * sn + x2[n] * cs; x1[n] = a; x2[n] = bb; } }
                bf16_t* rowp = base + (size_t)row * ld + col0; u32x4 w;
                w.x = pkbf(x1[0][0], x1[0][1]); w.y = pkbf(x1[0][2], x1[0][3]); w.z = pkbf(x1[1][0], x1[1][1]); w.w = pkbf(x1[1][2], x1[1][3]); *(u32x4*)rowp = w;
                w.x = pkbf(x2[0][0], x2[0][1]); w.y = pkbf(x2[0][2], x2[0][3]); w.z = pkbf(x2[1][0], x2[1][1]); w.w = pkbf(x2[1][2], x2[1][3]); *(u32x4*)(rowp + 128) = w;
                asm volatile("" ::: "memory"); }
    }
};
template <int MODE> struct EpiResid {
    static constexpr bool PERM = true, AFTER_DRAIN = false;
    const float* xin_lat; const float* xin_ctx; bf16_t* X; float* outf; const float* gate;
    __device__ __forceinline__ void operator()(const pg8::f32x4 (&acc)[2][2][4][2], const pg8::Unit& u, int wr, int wc, int fr, int fq) const {
        const int R = u.pm * 256; const int gr = R < MX ? R / SEQ : NB;
        const int col0 = u.pn * 256 + wc * 32 + 8 * fq; const float* gp = gate + (size_t)gr * 6144 + col0;
        const float* xi = R < MX ? xin_lat + (size_t)R * DM : xin_ctx + (size_t)(R - MX) * DM;
        pg8::f32x4 g[2][2];
#pragma unroll
        for (int bj = 0; bj < 2; ++bj)
#pragma unroll
            for (int n = 0; n < 2; ++n) g[bj][n] = *(const pg8::f32x4*)(gp + bj * 128 + 4 * n);
#pragma unroll
        for (int ai = 0; ai < 2; ++ai)
#pragma unroll
            for (int m = 0; m < 4; ++m) { const size_t off = (size_t)(wr * 64 + fr + ai * 128 + m * 16) * DM + col0;
#pragma unroll
                for (int bj = 0; bj < 2; ++bj) {
                    pg8::f32x4 x0, x1;
                    if (MODE == 0) { x0 = *(const pg8::f32x4*)(xi + off + bj * 128); x1 = *(const pg8::f32x4*)(xi + off + bj * 128 + 4); }
                    else { const u32x4 w = *(const u32x4*)(X + (size_t)R * DM + off + bj * 128); x0 = (pg8::f32x4){bf_lo(w.x), bf_hi(w.x), bf_lo(w.y), bf_hi(w.y)}; x1 = (pg8::f32x4){bf_lo(w.z), bf_hi(w.z), bf_lo(w.w), bf_hi(w.w)}; }
                    x0 = x0 + g[bj][0] * acc[ai][bj][m][0]; x1 = x1 + g[bj][1] * acc[ai][bj][m][1];
                    if (MODE == 2) { __builtin_nontemporal_store(x0, (pg8::f32x4*)(outf + (size_t)R * DM + off + bj * 128)); __builtin_nontemporal_store(x1, (pg8::f32x4*)(outf + (size_t)R * DM + off + bj * 128 + 4)); }
                    else { u32x4 w; w.x = pkbf(x0[0], x0[1]); w.y = pkbf(x0[2], x0[3]); w.z = pkbf(x1[0], x1[1]); w.w = pkbf(x1[2], x1[3]); *(u32x4*)(X + (size_t)R * DM + off + bj * 128) = w; } }
                asm volatile("" ::: "memory"); }
    }
};
struct EpiSwiglu {
    static constexpr bool PERM = true, AFTER_DRAIN = false;
    bf16_t* O;
    __device__ __forceinline__ void operator()(const pg8::f32x4 (&acc)[2][2][4][2], const pg8::Unit& u, int wr, int wc, int fr, int fq) const {
        const int row0 = u.pm * 256 + wr * 64 + fr, col0 = u.pn * 128 + wc * 32 + 8 * fq;
#pragma unroll
        for (int ai = 0; ai < 2; ++ai)
#pragma unroll
            for (int m = 0; m < 4; ++m) { const pg8::f32x4 g0 = acc[ai][0][m][0], g1 = acc[ai][0][m][1], u0 = acc[ai][1][m][0], u1 = acc[ai][1][m][1]; u32x4 w;
#define SWG(g_, u_) ((g_) * (u_) * __builtin_amdgcn_rcpf(1.0f + __builtin_amdgcn_exp2f(g_)))
                w.x = pkbf(SWG(g0[0], u0[0]), SWG(g0[1], u0[1])); w.y = pkbf(SWG(g0[2], u0[2]), SWG(g0[3], u0[3]));
                w.z = pkbf(SWG(g1[0], u1[0]), SWG(g1[1], u1[1])); w.w = pkbf(SWG(g1[2], u1[2]), SWG(g1[3], u1[3]));
#undef SWG
                *(u32x4*)(O + (size_t)(row0 + ai * 128 + m * 16) * DFF + col0) = w; }
    }
};
struct EpiGate {
    static constexpr bool PERM = true, AFTER_DRAIN = false;
    bf16_t* Y; const float* stats; const float* gain;
    __device__ __forceinline__ void operator()(const pg8::f32x4 (&acc)[2][2][4][2], const pg8::Unit& u, int wr, int wc, int fr, int fq) const {
        const int row0 = u.pm * 256 + wr * 64 + fr, col0 = u.pn * 256 + wc * 32 + 8 * fq, hg = u.pn >> 1;
        pg8::f32x4 g[2][2];
#pragma unroll
        for (int bj = 0; bj < 2; ++bj)
#pragma unroll
            for (int n = 0; n < 2; ++n) g[bj][n] = *(const pg8::f32x4*)(gain + col0 + bj * 128 + 4 * n);
#pragma unroll
        for (int ai = 0; ai < 2; ++ai)
#pragma unroll
            for (int m = 0; m < 4; ++m) { const int row = row0 + ai * 128 + m * 16; bf16_t* rowp = Y + (size_t)row * 2048 + col0;
                const float s0 = stats[((size_t)row * 4 + hg) * 2], s1 = stats[((size_t)row * 4 + hg) * 2 + 1];
                const float mu = s0 * (1.0f / 512.0f), rstd = rsqrtf(fmaxf(s1 * (1.0f / 512.0f) - mu * mu, 0.f) + EPSN);
#pragma unroll
                for (int bj = 0; bj < 2; ++bj) { const u32x4 y = *(const u32x4*)(rowp + bj * 128); const pg8::f32x4 v0 = acc[ai][bj][m][0], v1 = acc[ai][bj][m][1];
                    const pg8::f32x4 y0 = ((pg8::f32x4){bf_lo(y.x), bf_hi(y.x), bf_lo(y.y), bf_hi(y.y)} - mu) * rstd * g[bj][0], y1 = ((pg8::f32x4){bf_lo(y.z), bf_hi(y.z), bf_lo(y.w), bf_hi(y.w)} - mu) * rstd * g[bj][1];
                    u32x4 w;
                    w.x = pkbf(fast_silu(v0[0]) * y0[0], fast_silu(v0[1]) * y0[1]); w.y = pkbf(fast_silu(v0[2]) * y0[2], fast_silu(v0[3]) * y0[3]);
                    w.z = pkbf(fast_silu(v1[0]) * y1[0], fast_silu(v1[1]) * y1[1]); w.w = pkbf(fast_silu(v1[2]) * y1[2], fast_silu(v1[3]) * y1[3]);
                    *(u32x4*)(rowp + bj * 128) = w; }
                asm volatile("" ::: "memory"); }
    }
};

__device__ __forceinline__ int drow_map(int mode, int n) {
    if (mode == 1) return n < DFF ? (n / 128) * 256 + (n % 128) : ((n - DFF) / 128) * 256 + 128 + ((n - DFF) % 128);
    if (mode == 2) { if (n >= 2048) return n; const int o = n & 255, blk = o >> 6, nb = (blk == 1) ? 2 : (blk == 2 ? 1 : blk); return (n - o) + 64 * nb + (o & 63); }
    if (mode == 3) { if (n >= 1280) return n; const int o = n & 255, hd = o >> 6, d = o & 63, q16 = d >> 4; return (n - o) + 128 * (q16 & 1) + 32 * hd + 16 * (q16 >> 1) + (d & 15); }
    return n;
}
__device__ __forceinline__ void transpose_item(const float* W, int K, int N, bf16_t* WT, int k0, int n0, int mode, LAS float* scr, int lane) {
    {
        float t[32];
        const float* wp = W + (size_t)(k0 + (lane >> 5)) * N + n0 + (lane & 31);
#pragma unroll
        for (int i = 0; i < 32; ++i) t[i] = wp[(size_t)(2 * i) * N];
#pragma unroll
        for (int i = 0; i < 32; ++i) scr[(2 * i + (lane >> 5)) * 33 + (lane & 31)] = t[i];
    }
    asm volatile("s_waitcnt lgkmcnt(0)" ::: "memory");
    const int c = lane & 7;
    const float wsc = mode == 1 ? (n0 < DFF ? -LOG2E : -1.0f / LOG2E) : 1.0f;
#pragma unroll
    for (int j = 0; j < 4; ++j) { const int n = (lane >> 3) + 8 * j; const LAS float* s = scr + (8 * c) * 33 + n;
        u32x4 o; o.x = pkbf(s[0 * 33] * wsc, s[1 * 33] * wsc); o.y = pkbf(s[2 * 33] * wsc, s[3 * 33] * wsc); o.z = pkbf(s[4 * 33] * wsc, s[5 * 33] * wsc); o.w = pkbf(s[6 * 33] * wsc, s[7 * 33] * wsc);
        *(u32x4*)(WT + (size_t)drow_map(mode, n0 + n) * K + k0 + 8 * c) = o; }
    asm volatile("s_waitcnt lgkmcnt(0)" ::: "memory");
}

struct Args { const float* in[19]; float* out; unsigned char* ws; int ph_lo, ph_hi; };

__device__ __forceinline__ void phase0(const Args& a, LAS unsigned char* lds, int tid) {
    const int wave = tid >> 6, lane = tid & 63;
    const int gw = blockIdx.x * 8 + wave, NGW = gridDim.x * 8;
    unsigned char* ws = a.ws;
    {
        LAS float* scr = (LAS float*)(lds + wave * 16384);
        constexpr int I0 = 16 * 48, I1 = 16 * 32, I2 = 16 * 176, I3 = 44 * 32, I4 = 16 * 192, I5 = 32 * 32, I6 = I2, I7 = I3;
        constexpr int NIT = I0 + I1 + I2 + I3 + I4 + I5 + I6 + I7;
        for (int it = gw; it < NIT; it += NGW) {
            int r = it; const float* W; bf16_t* WT; int K, N; int mode = 0;
            if (r < I0) { W = a.in[10]; WT = (bf16_t*)(ws + WS_WQKV0); K = 1024; N = 1536; mode = 3; }
            else if ((r -= I0) < I1) { W = a.in[14]; WT = (bf16_t*)(ws + WS_WO0); K = 1024; N = 1024; }
            else if ((r -= I1) < I2) { W = a.in[8]; WT = (bf16_t*)(ws + WS_WIN0); K = 1024; N = 5632; mode = 1; }
            else if ((r -= I2) < I3) { W = a.in[9]; WT = (bf16_t*)(ws + WS_WOUT0); K = 2816; N = 1024; }
            else if ((r -= I3) < I4) { W = a.in[15]; WT = (bf16_t*)(ws + WS_WR); K = 1024; N = 6144; mode = 2; }
            else if ((r -= I4) < I5) { W = a.in[18]; WT = (bf16_t*)(ws + WS_WRO); K = 2048; N = 1024; }
            else if ((r -= I5) < I6) { W = a.in[8] + (size_t)1024 * 5632; WT = (bf16_t*)(ws + WS_WIN1); K = 1024; N = 5632; mode = 1; }
            else { r -= I6; W = a.in[9] + (size_t)2816 * 1024; WT = (bf16_t*)(ws + WS_WOUT1); K = 2816; N = 1024; }
            const int nblk = N / 32, kb = r / nblk, nb = r % nblk, n0 = 32 * nb;
            transpose_item(W, K, N, WT, 64 * kb, n0, mode, scr, lane);
        }
    }
    { f32x4* gs = (f32x4*)(ws + WS_GNS); for (int i = blockIdx.x * 512 + tid; i < MX * 8 / 4; i += gridDim.x * 512) gs[i] = (f32x4){0.f, 0.f, 0.f, 0.f}; }
    {
        const int gt = blockIdx.x * 512 + tid;
        if (gt < 64 * 16 + 64 * 64) {
            int pos, f; float expo; float* dst;
            if (gt < 1024) { pos = gt >> 4; f = gt & 15; expo = -(float)(2 * f) / 32.0f; dst = (float*)(ws + WS_TAB0) + (size_t)gt * 2; }
            else { const int g2 = gt - 1024; pos = g2 >> 6; f = g2 & 63; expo = -(float)(2 * f) / 128.0f; dst = (float*)(ws + WS_TAB1) + (size_t)g2 * 2; }
            const float inv = exp2f(expo * 13.287712379549449f);
            const float ang = (float)pos * inv;
            const double ad = (double)ang; const double kk = __builtin_rint(ad * 0.15915494309189535); const float red = (float)(ad - kk * 6.283185307179586);
            dst[0] = __cosf(red); dst[1] = __sinf(red);
        }
    }
    __syncthreads();
    {
        LAS float* sc = (LAS float*)lds + wave * (128 * 36);
        LAS float* red = (LAS float*)lds;
        float* mod = (float*)(ws + WS_MOD);
        for (int it = blockIdx.x; it < 192; it += gridDim.x) {
            const int l = it / 96, n0 = (it % 96) * 64;
            int lane_l = lane; asm volatile("" : "+v"(lane_l));
#pragma unroll
            for (int t0 = 0; t0 < 66; t0 += 22) {
                float tv[22];
#pragma unroll
                for (int t = 0; t < 22; ++t) { const int r = (t0 + t) >> 1, k = lane_l + 64 * (t & 1); tv[t] = r < 32 ? a.in[1][r * 1024 + wave * 128 + k] : a.in[3][wave * 128 + k]; }
#pragma unroll
                for (int t = 0; t < 22; ++t) { const int r = (t0 + t) >> 1, k = lane_l + 64 * (t & 1); sc[k * 36 + r] = tv[t] * __builtin_amdgcn_rcpf(1.0f + __expf(-tv[t])); }
                asm volatile("" ::: "memory");
            }
            asm volatile("s_waitcnt lgkmcnt(0)" ::: "memory");
            float acc[33];
#pragma unroll
            for (int r = 0; r < 33; ++r) acc[r] = 0.f;
            const float* Wp = a.in[4] + ((size_t)l * 1024 + wave * 128) * 6144 + n0 + lane_l;
#pragma unroll 1
            for (int k0 = 0; k0 < 128; k0 += 16) {
                float wv[16];
#pragma unroll
                for (int kk = 0; kk < 16; ++kk) wv[kk] = Wp[(size_t)(k0 + kk) * 6144];
#pragma unroll
                for (int kk = 0; kk < 16; ++kk) { const int k = k0 + kk;
#pragma unroll
                    for (int r4 = 0; r4 < 8; ++r4) { const f32x4 s = *(const LAS f32x4*)(sc + k * 36 + 4 * r4); acc[4 * r4] += s[0] * wv[kk]; acc[4 * r4 + 1] += s[1] * wv[kk]; acc[4 * r4 + 2] += s[2] * wv[kk]; acc[4 * r4 + 3] += s[3] * wv[kk]; }
                    acc[32] += sc[k * 36 + 32] * wv[kk];
                    if ((kk & 1) == 1) asm volatile("" ::: "memory"); }
            }
            __syncthreads();
#pragma unroll
            for (int r = 0; r < 33; ++r) red[(wave * 33 + r) * 64 + lane] = acc[r];
            __syncthreads();
            for (int idx = tid; idx < 33 * 64; idx += 512) { const int r = idx >> 6, cc = idx & 63; float s = 0.f;
#pragma unroll
                for (int w = 0; w < 8; ++w) s += red[(w * 33 + r) * 64 + cc];
                mod[((size_t)l * 33 + r) * 6144 + n0 + cc] = s + a.in[5][l * 6144 + n0 + cc]; }
            __syncthreads();
        }
    }
}

template <bool SRC_BF16>
__device__ __forceinline__ void norm_phase(const float* src_lat, const float* src_ctx, const bf16_t* srcb, const float* g, const float* shift, const float* scale, int nrows, bf16_t* dst, int tid) {
    const int lane = tid & 63, gw = blockIdx.x * 8 + (tid >> 6), NGW = gridDim.x * 8;
    const int R = (nrows + NGW - 1) / NGW, row_lo = gw * R, row_hi = (row_lo + R < nrows) ? row_lo + R : nrows;
    int cols[4];
#pragma unroll
    for (int j = 0; j < 4; ++j) cols[j] = 8 * lane + 512 * (j >> 1) + 4 * (j & 1);
    f32x4 gg[4], A[4], sh[4];
#pragma unroll
    for (int j = 0; j < 4; ++j) gg[j] = *(const f32x4*)(g + cols[j]);
    int rcur = -1;
#define NORM_LOAD(v_, row_) do { if (SRC_BF16) { const u32x4 w0_ = *(const u32x4*)(srcb + (size_t)(row_) * DM + 8 * lane), w1_ = *(const u32x4*)(srcb + (size_t)(row_) * DM + 512 + 8 * lane); \
            v_[0] = (f32x4){bf_lo(w0_.x), bf_hi(w0_.x), bf_lo(w0_.y), bf_hi(w0_.y)}; v_[1] = (f32x4){bf_lo(w0_.z), bf_hi(w0_.z), bf_lo(w0_.w), bf_hi(w0_.w)}; \
            v_[2] = (f32x4){bf_lo(w1_.x), bf_hi(w1_.x), bf_lo(w1_.y), bf_hi(w1_.y)}; v_[3] = (f32x4){bf_lo(w1_.z), bf_hi(w1_.z), bf_lo(w1_.w), bf_hi(w1_.w)}; \
        } else { const float* src_ = (row_) < MX ? src_lat + (size_t)(row_) * DM : src_ctx + (size_t)((row_) - MX) * DM; \
            _Pragma("unroll") for (int j_ = 0; j_ < 4; ++j_) v_[j_] = *(const f32x4*)(src_ + cols[j_]); } } while (0)
#define NORM_ROW(v_, row_) do { const int r_ = (row_) < MX ? (row_) / SEQ : NB; \
        if (r_ != rcur) { rcur = r_; _Pragma("unroll") for (int j_ = 0; j_ < 4; ++j_) { sh[j_] = *(const f32x4*)(shift + (size_t)r_ * 6144 + cols[j_]); A[j_] = gg[j_] * (*(const f32x4*)(scale + (size_t)r_ * 6144 + cols[j_]) + 1.0f); } } \
        float ss_ = 0.f; \
        _Pragma("unroll") for (int j_ = 0; j_ < 4; ++j_) ss_ += (v_[j_].x * v_[j_].x + v_[j_].y * v_[j_].y) + (v_[j_].z * v_[j_].z + v_[j_].w * v_[j_].w); \
        const float rstd_ = rsqrtf(wave_sum(ss_) * (1.0f / DM) + EPSN); \
        _Pragma("unroll") for (int j_ = 0; j_ < 4; j_ += 2) { const f32x4 h_ = v_[j_] * rstd_ * A[j_] + sh[j_], h2_ = v_[j_ + 1] * rstd_ * A[j_ + 1] + sh[j_ + 1]; \
            u32x4 w_; w_.x = pkbf(h_.x, h_.y); w_.y = pkbf(h_.z, h_.w); w_.z = pkbf(h2_.x, h2_.y); w_.w = pkbf(h2_.z, h2_.w); \
            *(u32x4*)(dst + (size_t)(row_) * DM + cols[j_]) = w_; } } while (0)
    for (int row = row_lo; row < row_hi; row += 4) {
        f32x4 va[4], vb[4], vc[4], vd[4];
        const int nr = row_hi - row;
        NORM_LOAD(va, row);
        if (nr > 1) NORM_LOAD(vb, row + 1);
        if (nr > 2) NORM_LOAD(vc, row + 2);
        if (nr > 3) NORM_LOAD(vd, row + 3);
        NORM_ROW(va, row);
        if (nr > 1) NORM_ROW(vb, row + 1);
        if (nr > 2) NORM_ROW(vc, row + 2);
        if (nr > 3) NORM_ROW(vd, row + 3);
    }
#undef NORM_LOAD
#undef NORM_ROW
}

__device__ __forceinline__ void qknorm_phase(bf16_t* QKV, const float* qg, const float* kg, const float* tab0, int tid) {
    const long total = (long)MA * 160, stride = (long)gridDim.x * 512;
    for (long idx = (long)blockIdx.x * 512 + tid; idx < total; idx += stride) {
        const int ch = (int)(idx & 7), hd = (int)((idx >> 3) % 20), row = (int)(idx / 160);
        bf16_t* p = QKV + (size_t)row * 1536 + hd * 64 + ch * 8;
        const u32x4 w = *(const u32x4*)p;
        float v[8] = {bf_lo(w.x), bf_hi(w.x), bf_lo(w.y), bf_hi(w.y), bf_lo(w.z), bf_hi(w.z), bf_lo(w.w), bf_hi(w.w)};
        float ss = 0.f;
#pragma unroll
        for (int j = 0; j < 8; ++j) ss += v[j] * v[j];
        ss += __shfl_xor(ss, 1); ss += __shfl_xor(ss, 2); ss += __shfl_xor(ss, 4);
        const float rstd = rsqrtf(ss * (1.0f / 64.0f) + EPSN);
        const float* gp = (hd < 16 ? qg : kg) + ch * 8;
#pragma unroll
        for (int j = 0; j < 8; ++j) v[j] = v[j] * rstd * gp[j];
        float pv[8];
#pragma unroll
        for (int j = 0; j < 8; ++j) pv[j] = __shfl_xor(v[j], 2);
        if (row < MX) {
            const int s = row & (SEQ - 1), pos = (ch & 4) ? (s & 63) : (s >> 6);
            const float* tp = tab0 + ((size_t)pos * 16 + (ch & 1) * 8) * 2;
#pragma unroll
            for (int j = 0; j < 8; ++j) { const float cs = tp[2 * j], sn = tp[2 * j + 1];
                v[j] = (ch & 2) ? (pv[j] * sn + v[j] * cs) : (v[j] * cs - pv[j] * sn); }
        }
        const float qs = hd < 16 ? 0.125f * LOG2E : 1.0f;
        u32x4 o; o.x = pkbf(v[0] * qs, v[1] * qs); o.y = pkbf(v[2] * qs, v[3] * qs); o.z = pkbf(v[4] * qs, v[5] * qs); o.w = pkbf(v[6] * qs, v[7] * qs);
        *(u32x4*)p = o;
    }
}

__device__ __forceinline__ void rope1_phase(bf16_t* Q1, bf16_t* K1, const float* tab1, int tid) {
    const long total = (long)MX * 128, stride = (long)gridDim.x * 512;
    for (long idx = (long)blockIdx.x * 512 + tid; idx < total; idx += stride) {
        const int c8 = (int)(idx & 7), ax = (int)((idx >> 3) & 1), hd = (int)((idx >> 4) & 3), which = (int)((idx >> 6) & 1), row = (int)(idx >> 7);
        bf16_t* p = (which ? K1 : Q1) + (size_t)row * 1024 + hd * 256 + ax * 128 + c8 * 8;
        const u32x4 w1 = *(const u32x4*)p, w2 = *(const u32x4*)(p + 64);
        const float x1[8] = {bf_lo(w1.x), bf_hi(w1.x), bf_lo(w1.y), bf_hi(w1.y), bf_lo(w1.z), bf_hi(w1.z), bf_lo(w1.w), bf_hi(w1.w)};
        const float x2[8] = {bf_lo(w2.x), bf_hi(w2.x), bf_lo(w2.y), bf_hi(w2.y), bf_lo(w2.z), bf_hi(w2.z), bf_lo(w2.w), bf_hi(w2.w)};
        const int s = row & (SEQ - 1), pos = ax ? (s & 63) : (s >> 6);
        const float* tp = tab1 + ((size_t)pos * 64 + c8 * 8) * 2;
        float o1[8], o2[8];
#pragma unroll
        for (int j = 0; j < 8; ++j) { const float cs = tp[2 * j], sn = tp[2 * j + 1]; o1[j] = x1[j] * cs - x2[j] * sn; o2[j] = x1[j] * sn + x2[j] * cs; }
        u32x4 a, b; a.x = pkbf(o1[0], o1[1]); a.y = pkbf(o1[2], o1[3]); a.z = pkbf(o1[4], o1[5]); a.w = pkbf(o1[6], o1[7]);
        b.x = pkbf(o2[0], o2[1]); b.y = pkbf(o2[2], o2[3]); b.z = pkbf(o2[4], o2[5]); b.w = pkbf(o2[6], o2[7]);
        *(u32x4*)p = a; *(u32x4*)(p + 64) = b;
    }
}

__device__ __forceinline__ void gn_phase(bf16_t* Y, const float* gng, int tid) {
    const int lane = tid & 63, gw = blockIdx.x * 8 + (tid >> 6), NGW = gridDim.x * 8;
    for (int it = gw; it < MX * 4; it += NGW) {
        const int row = it >> 2, h = it & 3;
        bf16_t* p = Y + (size_t)row * 2048 + h * 512 + lane * 8;
        const u32x4 w = *(const u32x4*)p;
        float v[8] = {bf_lo(w.x), bf_hi(w.x), bf_lo(w.y), bf_hi(w.y), bf_lo(w.z), bf_hi(w.z), bf_lo(w.w), bf_hi(w.w)};
        float s = 0.f;
#pragma unroll
        for (int j = 0; j < 8; ++j) s += v[j];
        const float mu = wave_sum(s) * (1.0f / 512.0f); float q = 0.f;
#pragma unroll
        for (int j = 0; j < 8; ++j) { v[j] -= mu; q += v[j] * v[j]; }
        const float rstd = rsqrtf(wave_sum(q) * (1.0f / 512.0f) + EPSN);
        const float* gp = gng + h * 512 + lane * 8;
        const f32x4 g0 = *(const f32x4*)gp, g1 = *(const f32x4*)(gp + 4);
        u32x4 o; o.x = pkbf(v[0] * rstd * g0.x, v[1] * rstd * g0.y); o.y = pkbf(v[2] * rstd * g0.z, v[3] * rstd * g0.w);
        o.z = pkbf(v[4] * rstd * g1.x, v[5] * rstd * g1.y); o.w = pkbf(v[6] * rstd * g1.z, v[7] * rstd * g1.w);
        *(u32x4*)p = o;
    }
}

__device__ __forceinline__ f32x16 mfma32(bf16x8 a, bf16x8 b, f32x16 c) { return __builtin_amdgcn_mfma_f32_32x32x16_bf16(a, b, c, 0, 0, 0); }
__device__ __forceinline__ bf16x8 tr_pair(const LAS bf16_t* p0, const LAS bf16_t* p1) {
    const s16x4 a = __builtin_amdgcn_ds_read_tr16_b64_v4i16((LAS s16x4*)p0);
    const s16x4 b = __builtin_amdgcn_ds_read_tr16_b64_v4i16((LAS s16x4*)p1);
    return __builtin_shufflevector(a, b, 0, 1, 2, 3, 4, 5, 6, 7);
}
__device__ __forceinline__ bf16x8 pack8(const f32x16& v, int base) {
    u32x4 w; w.x = pkbf(v[base + 0], v[base + 1]); w.y = pkbf(v[base + 2], v[base + 3]); w.z = pkbf(v[base + 4], v[base + 5]); w.w = pkbf(v[base + 6], v[base + 7]);
    return __builtin_bit_cast(bf16x8, w);
}

constexpr int AKS = 72;
__device__ __forceinline__ void attn_phase(LAS unsigned char* lds, const bf16_t* QKV, bf16_t* O, const float* sink, const float* qg, const float* kg, int tid) {
    const int wid = __builtin_amdgcn_readfirstlane(tid >> 6), lane = tid & 63, r = lane & 31, hh = lane >> 5, blk = (lane >> 4) & 1, q4 = (lane & 15) >> 2, p4 = lane & 3;
    LAS bf16_t* Kl = (LAS bf16_t*)lds;
    LAS bf16_t* Vl = (LAS bf16_t*)(lds + 64 * AKS * 2);
    const int skey = tid >> 3, sch = tid & 7;
    float Bnd;
    { float gq = fabsf(qg[lane]), gk = fabsf(kg[lane]);
#pragma unroll
      for (int o = 1; o < 64; o <<= 1) { gq = fmaxf(gq, __shfl_xor(gq, o)); gk = fmaxf(gk, __shfl_xor(gk, o)); }
      Bnd = 8.0f * LOG2E * 1.02f * gq * gk; }
    for (int u0 = blockIdx.x; u0 < 2304; u0 += gridDim.x) {
        int u = u0;
        if (gridDim.x == 256 && u0 < 2048) { const int x = u0 & 7, idx = (u0 >> 3) & 31, rnd = u0 >> 8; u = ((rnd * 16 + x * 2 + (idx >> 4)) << 4) | (idx & 15); }
        int b, kvh, qb; bool isctx;
        if (u < 2048) { b = u >> 6; kvh = (u >> 4) & 3; qb = u & 15; isctx = false; } else { const int v = u - 2048; b = v >> 3; kvh = (v >> 1) & 3; qb = v & 1; isctx = true; }
        const int hq = kvh * 4 + (wid >> 1);
        const int qloc = qb * 128 + (wid & 1) * 64;
        const size_t qrow0 = isctx ? (size_t)MX + b * CL + qloc : (size_t)b * SEQ + qloc;
        bf16x8 qf[2][4];
#pragma unroll
        for (int qq = 0; qq < 2; ++qq)
#pragma unroll
            for (int s = 0; s < 4; ++s) qf[qq][s] = *(const bf16x8*)(QKV + (qrow0 + 32 * qq + r) * 1536 + (hq >> 2) * 256 + (s >> 1) * 128 + (hq & 3) * 32 + (s & 1) * 16 + 8 * hh);
        const float sl2 = sink[hq] * LOG2E;
        const float psink = hh == 0 ? __builtin_amdgcn_exp2f(sl2 - Bnd) : 0.0f;
        float lrun[2] = {psink, psink};
        f32x16 oacc[2][2];
#pragma unroll
        for (int i = 0; i < 2; ++i)
#pragma unroll
            for (int j = 0; j < 2; ++j)
#pragma unroll
                for (int e = 0; e < 16; ++e) oacc[i][j][e] = 0.f;
        int tlo = 2 - 2 * qb; if (tlo < 0) tlo = 0;
        int thi = 33 - 2 * qb; if (thi > 5) thi = 5;
        const int ntile = isctx ? 4 : 4 + (thi - tlo + 1);
        u32x4 kreg, vreg;
        {   const size_t row = (size_t)MX + b * CL + skey;
            kreg = *(const u32x4*)(QKV + row * 1536 + 1024 + (sch >> 2) * 128 + kvh * 32 + (sch & 3) * 8); vreg = *(const u32x4*)(QKV + row * 1536 + 1280 + kvh * 64 + sch * 8); }
        for (int it = 0; it < ntile; ++it) {
            __syncthreads();
            *(LAS u32x4*)(Kl + skey * AKS + sch * 8) = kreg; *(LAS u32x4*)(Vl + skey * AKS + sch * 8) = vreg;
            __syncthreads();
            if (it + 1 < ntile) { const int nt = it + 1;
                const size_t row = nt < 4 ? (size_t)MX + b * CL + 64 * nt + skey : (size_t)b * SEQ + qb * 128 - 128 + 64 * (tlo + nt - 4) + skey;
                kreg = *(const u32x4*)(QKV + row * 1536 + 1024 + (sch >> 2) * 128 + kvh * 32 + (sch & 3) * 8); vreg = *(const u32x4*)(QKV + row * 1536 + 1280 + kvh * 64 + sch * 8); }
            const int rel = it >= 4 ? (qb * 128 - 128 + 64 * (tlo + it - 4)) - qloc : 0;
            if (rel <= -192 || rel >= 192) continue;
            float nbnd = -Bnd; asm volatile("" : "+v"(nbnd));
            f32x16 st[2][2];
#pragma unroll
            for (int i = 0; i < 2; ++i)
#pragma unroll
                for (int j = 0; j < 2; ++j)
#pragma unroll
                    for (int e = 0; e < 16; ++e) st[i][j][e] = nbnd;
#pragma unroll
            for (int kb = 0; kb < 2; ++kb)
#pragma unroll
                for (int s = 0; s < 4; ++s) { const bf16x8 ka = *(const LAS bf16x8*)(Kl + (32 * kb + r) * AKS + 16 * s + 8 * hh);
                    st[kb][0] = mfma32(ka, qf[0][s], st[kb][0]); st[kb][1] = mfma32(ka, qf[1][s], st[kb][1]); }
            if (rel == -128 || rel == 128) {
                const int kbase = qb * 128 - 128 + 64 * (tlo + it - 4);
#pragma unroll
                for (int kb = 0; kb < 2; ++kb)
#pragma unroll
                    for (int qq = 0; qq < 2; ++qq) { const int qpos = qloc + 32 * qq + r;
#pragma unroll
                        for (int e = 0; e < 16; ++e) { const int key = kbase + 32 * kb + 8 * (e >> 2) + 4 * hh + (e & 3); int d = qpos - key; d = d < 0 ? -d : d;
                            st[kb][qq][e] = d <= 128 ? st[kb][qq][e] : -1e30f; } }
            }
            bf16x8 pf[2][2][2];
#pragma unroll
            for (int qq = 0; qq < 2; ++qq) {
                float ps = 0.f;
#pragma unroll
                for (int kb = 0; kb < 2; ++kb)
#pragma unroll
                    for (int s2 = 0; s2 < 2; ++s2) { float p[8];
#pragma unroll
                        for (int j = 0; j < 8; ++j) { p[j] = __builtin_amdgcn_exp2f(st[kb][qq][8 * s2 + j]); ps += p[j]; }
                        u32x4 w; w.x = pkbf(p[0], p[1]); w.y = pkbf(p[2], p[3]); w.z = pkbf(p[4], p[5]); w.w = pkbf(p[6], p[7]);
                        pf[kb][s2][qq] = __builtin_bit_cast(bf16x8, w); }
                lrun[qq] += ps;
            }
            __builtin_amdgcn_sched_barrier(0);
#pragma unroll
            for (int kb = 0; kb < 2; ++kb)
#pragma unroll
                for (int s2 = 0; s2 < 2; ++s2)
#pragma unroll
                    for (int db = 0; db < 2; ++db) {
                        const LAS bf16_t* vp = Vl + (32 * kb + 16 * s2 + 4 * hh + q4) * AKS + 32 * db + 16 * blk + 4 * p4;
                        const bf16x8 va = tr_pair(vp, vp + 8 * AKS);
                        oacc[db][0] = mfma32(va, pf[kb][s2][0], oacc[db][0]); oacc[db][1] = mfma32(va, pf[kb][s2][1], oacc[db][1]); }
        }
#pragma unroll
        for (int qq = 0; qq < 2; ++qq) {
            const float lt = lrun[qq] + __shfl_xor(lrun[qq], 32), inv = 1.0f / lt;
            bf16_t* op = O + (qrow0 + 32 * qq + r) * 1024 + hq * 64 + 4 * hh;
#pragma unroll
            for (int db = 0; db < 2; ++db)
#pragma unroll
                for (int g = 0; g < 4; ++g) { u32x2 w; w.x = pkbf(oacc[db][qq][4 * g] * inv, oacc[db][qq][4 * g + 1] * inv); w.y = pkbf(oacc[db][qq][4 * g + 2] * inv, oacc[db][qq][4 * g + 3] * inv);
                    *(u32x2*)(op + 32 * db + 8 * g) = w; }
        }
    }
}

constexpr int RS = 136;
__device__ __forceinline__ u32x4 scale8(const u32x4 w, const float f) {
    u32x4 o; o.x = pkbf(bf_lo(w.x) * f, bf_hi(w.x) * f); o.y = pkbf(bf_lo(w.y) * f, bf_hi(w.y) * f); o.z = pkbf(bf_lo(w.z) * f, bf_hi(w.z) * f); o.w = pkbf(bf_lo(w.w) * f, bf_hi(w.w) * f); return o;
}
__device__ __forceinline__ u32x4 add8(const u32x4 a, const u32x4 b) {
    u32x4 o; o.x = pkbf(bf_lo(a.x) + bf_lo(b.x), bf_hi(a.x) + bf_hi(b.x)); o.y = pkbf(bf_lo(a.y) + bf_lo(b.y), bf_hi(a.y) + bf_hi(b.y));
    o.z = pkbf(bf_lo(a.z) + bf_lo(b.z), bf_hi(a.z) + bf_hi(b.z)); o.w = pkbf(bf_lo(a.w) + bf_lo(b.w), bf_hi(a.w) + bf_hi(b.w)); return o;
}
template <int PM> __device__ __forceinline__ f32x16 rmf(bf16x8 a, bf16x8 b, f32x16 c) {
    if (PM == 1) { const u32x4 x = __builtin_bit_cast(u32x4, a), y = __builtin_bit_cast(u32x4, b); c[0] += __builtin_bit_cast(float, (x.x ^ y.x) & 0x3f800000u) + __builtin_bit_cast(float, (x.w ^ y.w) & 0x3f800000u); return c; }
    if (PM == 2) { const bf16x8 k = {0x3c00, 0x3c00, 0x3c00, 0x3c00, 0x3c00, 0x3c00, 0x3c00, 0x3c00}; return __builtin_amdgcn_mfma_f32_32x32x16_bf16(k, k, c, 0, 0, 0); }
    return __builtin_amdgcn_mfma_f32_32x32x16_bf16(a, b, c, 0, 0, 0);
}
template <int PM>
__device__ __forceinline__ void ret_phase(LAS unsigned char* lds, const bf16_t* Q1, const bf16_t* K1, bf16_t* V1, bf16_t* OF, float* gstats, unsigned* gsync, const float* decay_logit, int tid) {
    const int wid = tid >> 6, lane = tid & 63, r = lane & 31, hh = lane >> 5, blk = (lane >> 4) & 1, q4 = (lane & 15) >> 2, p4 = lane & 3;
    LAS bf16_t* QH = (LAS bf16_t*)lds;
    LAS bf16_t* KH = (LAS bf16_t*)(lds + 128 * RS * 2);
    LAS bf16_t* VL = (LAS bf16_t*)(lds + 2 * 128 * RS * 2);
    LAS bf16_t* SL = (LAS bf16_t*)(lds + 3 * 128 * RS * 2);
    LAS bf16_t* OL = KH;
    const int eb = wid & 3, dg = wid >> 2, nb = wid >> 1, mg = wid & 1;
    const int o_row = r * RS + 8 * hh;
    const int o_tr = (8 * hh + q4) * RS + 16 * blk + 4 * p4;
    const int sn = tid >> 4, scc = tid & 15;
    unsigned* gctr = (gsync != nullptr && gridDim.x == 256) ? gsync + ((blockIdx.x & 7) * 8 + ((blockIdx.x >> 5) & 7)) * 64 : nullptr;
    unsigned gtarget = 0u;
    for (int u0 = blockIdx.x; u0 < 512; u0 += gridDim.x) {
        int u = u0;
        if (gridDim.x == 256) { const int x = u0 & 7, idx = (u0 >> 3) & 31, rnd = u0 >> 8; u = ((rnd * 64 + x * 8 + (idx >> 2)) << 2) | (idx & 3); }
        const int b = u >> 4, h = (u >> 2) & 3, sl = u & 3;
        for (int dir = 0; dir < 2; ++dir) {
            const float logit = decay_logit[dir * 4 + h];
            const float lg2 = -log1pf(__expf(-logit)) * LOG2E;
            const float cd = exp2f(lg2 * 128.0f);
            f32x16 S[2][2];
#pragma unroll
            for (int i = 0; i < 2; ++i)
#pragma unroll
                for (int j = 0; j < 2; ++j)
#pragma unroll
                    for (int e = 0; e < 16; ++e) S[i][j][e] = 0.f;
            u32x4 rq[4], rk[4], rv[4];
#define RET_ROFF(i) (dir ? 127 - (sn + 32 * (i)) : (sn + 32 * (i)))
#define RET_ROFF2(i) (dir ? 127 - (sn2_ + 32 * (i)) : (sn2_ + 32 * (i)))
#define RET_TOK(base, i) ((base) + (size_t)RET_ROFF(i))
#define RET_LOAD_QK(stp, dhp) do { const bool cx_ = (stp) < 2; const int ci_ = cx_ ? (dir ? 1 - (stp) : (stp)) : (dir ? 17 - (stp) : (stp) - 2); \
        const size_t rb_ = cx_ ? (size_t)MX + b * CL + ci_ * 128 : (size_t)b * SEQ + ci_ * 128; \
        const bf16_t* qp_ = Q1 + rb_ * 1024 + h * 256 + (dhp) * 128; const bf16_t* kp_ = K1 + rb_ * 1024 + h * 256 + (dhp) * 128; \
        int sn2_ = sn; asm volatile("" : "+v"(sn2_)); \
        _Pragma("unroll") for (int i_ = 0; i_ < 4; ++i_) { const int o_ = RET_ROFF2(i_) * 1024 + scc * 8; \
            if (PM == 3) { rq[i_] = (u32x4){0x3c003c00u, 0x3c003c00u, 0x3c003c00u, 0x3c003c00u}; rk[i_] = rq[i_]; } else { \
            if (!cx_) rq[i_] = *(const u32x4*)(qp_ + o_); \
            rk[i_] = *(const u32x4*)(kp_ + o_); } } } while (0)
#define RET_LOAD_V(stp) do { const bool cx_ = (stp) < 2; const int ci_ = cx_ ? (dir ? 1 - (stp) : (stp)) : (dir ? 17 - (stp) : (stp) - 2); \
        const size_t rb_ = cx_ ? (size_t)MX + b * CL + ci_ * 128 : (size_t)b * SEQ + ci_ * 128; \
        const bf16_t* vp_ = V1 + rb_ * 2048 + h * 512 + sl * 128; \
        int sn2_ = sn; asm volatile("" : "+v"(sn2_)); \
        _Pragma("unroll") for (int i_ = 0; i_ < 4; ++i_) { const int o_ = RET_ROFF2(i_) * 2048 + scc * 8; if (PM == 3) rv[i_] = (u32x4){0x3c003c00u, 0x3c003c00u, 0x3c003c00u, 0x3c003c00u}; else rv[i_] = *(const u32x4*)(vp_ + o_); } } while (0)
            RET_LOAD_QK(0, 0); RET_LOAD_V(0);
            for (int st = 0; st < 18; ++st) {
                const bool isctx = st < 2;
                const int cidx = isctx ? (dir ? 1 - st : st) : (dir ? 17 - st : st - 2);
                gtarget += 4u;
                if (gctr != nullptr && tid == 0) { __hip_atomic_fetch_add(gctr, 1u, __ATOMIC_RELAXED, __HIP_MEMORY_SCOPE_AGENT);
                    for (int sp = 0; sp < 48 && __hip_atomic_load(gctr, __ATOMIC_RELAXED, __HIP_MEMORY_SCOPE_AGENT) < gtarget; ++sp) __builtin_amdgcn_s_sleep(2); }
                int r_l = r, hh_l = hh, sn_l = sn; float lg2_l = lg2; asm volatile("" : "+v"(r_l), "+v"(hh_l), "+v"(sn_l), "+v"(lg2_l));
                f32x16 sc[2], out[2];
#pragma unroll
                for (int i = 0; i < 2; ++i)
#pragma unroll
                    for (int e = 0; e < 16; ++e) { sc[i][e] = 0.f; out[i][e] = 0.f; }
#pragma unroll
                for (int dh = 0; dh < 2; ++dh) {
                    if (PM != 4) __syncthreads();
#pragma unroll
                    for (int i = 0; i < 4; ++i) { const int n = sn_l + 32 * i;
                        if (!isctx) *(LAS u32x4*)(QH + n * RS + scc * 8) = rq[i];
                        *(LAS u32x4*)(KH + n * RS + scc * 8) = rk[i];
                        if (dh == 0) *(LAS u32x4*)(VL + n * RS + scc * 8) = scale8(rv[i], 0.0625f * __builtin_amdgcn_exp2f(-lg2_l * (float)(n + 1))); }
                    if (!isctx) {
#pragma unroll
                        for (int i = 0; i < 2; ++i)
#pragma unroll
                            for (int g = 0; g < 4; ++g) { u32x2 w; w.x = pkbf(S[dh][i][4 * g], S[dh][i][4 * g + 1]); w.y = pkbf(S[dh][i][4 * g + 2], S[dh][i][4 * g + 3]);
                                *(LAS u32x2*)(SL + (32 * eb + r) * RS + 32 * (2 * dg + i) + 8 * g + 4 * hh) = w; }
                    }
                    if (PM != 4) __syncthreads();
                    if (dh == 0) RET_LOAD_QK(st, 1); else if (st + 1 < 18) RET_LOAD_QK(st + 1, 0);
                    if (!isctx) {
                        if (2 * mg <= nb) {
                            const bool two = 2 * mg + 1 <= nb;
#pragma unroll 2
                            for (int s = 0; s < 8; ++s) {
                                const bf16x8 qb_ = *(const LAS bf16x8*)(QH + o_row + 32 * nb * RS + 16 * s);
                                const bf16x8 k0 = *(const LAS bf16x8*)(KH + o_row + 32 * (2 * mg) * RS + 16 * s);
                                sc[0] = rmf<PM>(k0, qb_, sc[0]);
                                if (two) { const bf16x8 k1 = *(const LAS bf16x8*)(KH + o_row + 32 * (2 * mg + 1) * RS + 16 * s); sc[1] = rmf<PM>(k1, qb_, sc[1]); } }
                        }
#pragma unroll 2
                        for (int s = 0; s < 8; ++s) {
                            const bf16x8 sb = *(const LAS bf16x8*)(SL + o_row + 32 * eb * RS + 16 * s);
                            const bf16x8 q0 = *(const LAS bf16x8*)(QH + o_row + 32 * (2 * dg) * RS + 16 * s), q1 = *(const LAS bf16x8*)(QH + o_row + 32 * (2 * dg + 1) * RS + 16 * s);
                            out[0] = rmf<PM>(sb, q0, out[0]); out[1] = rmf<PM>(sb, q1, out[1]); }
                    }
#pragma unroll 2
                    for (int s = 0; s < 8; ++s) {
                        const LAS bf16_t* vp = VL + o_tr + 16 * s * RS + 32 * eb;
                        const bf16x8 vb = tr_pair(vp, vp + 4 * RS);
                        const LAS bf16_t* kp = KH + o_tr + 16 * s * RS + 32 * (2 * dg);
                        const bf16x8 ka0 = tr_pair(kp, kp + 4 * RS), ka1 = tr_pair(kp + 32, kp + 32 + 4 * RS);
                        S[dh][0] = rmf<PM>(ka0, vb, S[dh][0]); S[dh][1] = rmf<PM>(ka1, vb, S[dh][1]); }
                }
                if (!isctx) {
                    if (PM != 4) __syncthreads();
#pragma unroll
                    for (int i = 0; i < 2; ++i) { const bool diag = (2 * mg + i) == nb;
#pragma unroll
                        for (int g = 0; g < 4; ++g) { const int n = 32 * nb + r_l, m0 = 32 * (2 * mg + i) + 8 * g + 4 * hh_l;
                            float v0 = sc[i][4 * g], v1 = sc[i][4 * g + 1], v2 = sc[i][4 * g + 2], v3 = sc[i][4 * g + 3];
                            if (diag) { v0 = n >= m0 ? v0 : 0.f; v1 = n >= m0 + 1 ? v1 : 0.f; v2 = n >= m0 + 2 ? v2 : 0.f; v3 = n >= m0 + 3 ? v3 : 0.f; }
                            u32x2 w; w.x = pkbf(v0, v1); w.y = pkbf(v2, v3); *(LAS u32x2*)(QH + n * RS + m0) = w; } }
                    if (PM != 4) __syncthreads();
                }
                if (isctx) RET_LOAD_V(st + 1);
                if (!isctx) {
#pragma unroll 2
                    for (int s = 0; s < 4 * dg + 2; ++s) {
                        const LAS bf16_t* vp = VL + o_tr + 16 * s * RS + 32 * eb;
                        const bf16x8 vb = tr_pair(vp, vp + 4 * RS);
                        const bf16x8 p0 = *(const LAS bf16x8*)(QH + o_row + 32 * (2 * dg) * RS + 16 * s), p1 = *(const LAS bf16x8*)(QH + o_row + 32 * (2 * dg + 1) * RS + 16 * s);
                        out[0] = rmf<PM>(vb, p0, out[0]); out[1] = rmf<PM>(vb, p1, out[1]); }
#pragma unroll 2
                    for (int s = 4 * dg + 2; s < 4 * dg + 4; ++s) {
                        const LAS bf16_t* vp = VL + o_tr + 16 * s * RS + 32 * eb;
                        const bf16x8 vb = tr_pair(vp, vp + 4 * RS);
                        const bf16x8 p1 = *(const LAS bf16x8*)(QH + o_row + 32 * (2 * dg + 1) * RS + 16 * s);
                        out[1] = rmf<PM>(vb, p1, out[1]); }
#pragma unroll
                    for (int i = 0; i < 2; ++i) { const int n = 32 * (2 * dg + i) + r_l; const float f = __builtin_amdgcn_exp2f(lg2_l * (float)(n + 1));
#pragma unroll
                        for (int g = 0; g < 4; ++g) { u32x2 w; w.x = pkbf(out[i][4 * g] * f, out[i][4 * g + 1] * f); w.y = pkbf(out[i][4 * g + 2] * f, out[i][4 * g + 3] * f);
                            *(LAS u32x2*)(OL + n * RS + 32 * eb + 8 * g + 4 * hh_l) = w; } }
                    if (st + 1 < 18) RET_LOAD_V(st + 1);
                    if (PM != 4) __syncthreads();
                    const size_t lb = ((size_t)b * SEQ + cidx * 128) * 2048 + h * 512 + sl * 128;
                    bf16_t* ofb = OF + lb; bf16_t* vob = V1 + lb;
#pragma unroll
                    for (int i = 0; i < 4; ++i) { const int n = sn_l + 32 * i; const int off = (dir ? 127 - n : n) * 2048 + scc * 8;
                        const u32x4 v = *(const LAS u32x4*)(OL + n * RS + scc * 8);
                        if (dir == 0) *(u32x4*)(ofb + off) = v;
                        else { const u32x4 o = *(const u32x4*)(ofb + off);
                            const float t0 = bf_lo(v.x) + bf_lo(o.x), t1 = bf_hi(v.x) + bf_hi(o.x), t2 = bf_lo(v.y) + bf_lo(o.y), t3 = bf_hi(v.y) + bf_hi(o.y), t4 = bf_lo(v.z) + bf_lo(o.z), t5 = bf_hi(v.z) + bf_hi(o.z), t6 = bf_lo(v.w) + bf_lo(o.w), t7 = bf_hi(v.w) + bf_hi(o.w);
                            u32x4 w; w.x = pkbf(t0, t1); w.y = pkbf(t2, t3); w.z = pkbf(t4, t5); w.w = pkbf(t6, t7); *(u32x4*)(vob + off) = w;
                            float s0 = ((t0 + t1) + (t2 + t3)) + ((t4 + t5) + (t6 + t7)), s1 = ((t0 * t0 + t1 * t1) + (t2 * t2 + t3 * t3)) + ((t4 * t4 + t5 * t5) + (t6 * t6 + t7 * t7));
#pragma unroll
                            for (int o2 = 1; o2 < 16; o2 <<= 1) { s0 += __shfl_xor(s0, o2); s1 += __shfl_xor(s1, o2); }
                            if (scc == 0) { const int ro_ = dir ? 127 - (sn_l + 32 * i) : (sn_l + 32 * i); float* gp = gstats + ((size_t)b * SEQ + cidx * 128) * 8 + h * 2 + ro_ * 8; atomicAdd(gp, s0); atomicAdd(gp + 1, s1); } }
                        asm volatile("" ::: "memory"); }
                }
#pragma unroll
                for (int i = 0; i < 2; ++i)
#pragma unroll
                    for (int j = 0; j < 2; ++j)
#pragma unroll
                        for (int e = 0; e < 16; ++e) S[i][j][e] *= cd;
            }
#undef RET_TOK
#undef RET_ROFF
#undef RET_ROFF2
#undef RET_LOAD_QK
#undef RET_LOAD_V
        }
    }
}

#define XB_TMO      128
#define XB_XCNT(j)  (256  + 64 * (j))
#define XB_XSUB(j)  (1280 + 64 * (j))
#define XB_XGEN(j)  (2304 + 64 * (j))
#define XB_TOP      3328
#define XB_TOPGEN   3392
#define XCD_BAR_WORDS 3456
#define XB_SPIN_CAP (1u << 18)

__device__ __forceinline__ unsigned xb_ld(unsigned* p)              { return __hip_atomic_load(p, __ATOMIC_RELAXED, __HIP_MEMORY_SCOPE_AGENT); }
__device__ __forceinline__ unsigned xb_add(unsigned* p, unsigned v) { return __hip_atomic_fetch_add(p, v, __ATOMIC_RELAXED, __HIP_MEMORY_SCOPE_AGENT); }
__device__ __forceinline__ unsigned xb_xcc_id() { return (unsigned)__builtin_amdgcn_s_getreg((3 << 11) | 20) & 0xFu; }
#define XB_SPIN(cond, bar) do { unsigned _sp = 0; while (cond) { __builtin_amdgcn_s_sleep(1); \
    if ((++_sp & 255u) == 0u) { if (xb_ld(&(bar)[XB_TMO])) break; if (_sp > XB_SPIN_CAP) { atomicAdd(&(bar)[XB_TMO], 1u); break; } } } } while (0)

struct XcdBarrier {
    unsigned* bar; unsigned x;
    volatile LAS unsigned* st;
};

__device__ __forceinline__ XcdBarrier xcd_barrier_post(unsigned* bar, volatile LAS unsigned* st) {
    XcdBarrier b; b.bar = bar; b.x = xb_xcc_id(); b.st = st;
    if (threadIdx.x == 0) (void)xb_add(&bar[XB_XCNT(b.x)], 1u);
    return b;
}
__device__ __forceinline__ void xcd_barrier_complete(unsigned* bar, unsigned x, unsigned& nloc, unsigned& nx) {
    const unsigned G = gridDim.x * gridDim.y * gridDim.z;
    unsigned sum, cnt, mine, sp = 0u;
    for (;;) {
        sum = 0u; cnt = 0u; mine = 0u;
#pragma unroll
        for (unsigned j = 0; j < 16; ++j) { const unsigned c = xb_ld(&bar[XB_XCNT(j)]); sum += c; cnt += (c > 0u) ? 1u : 0u; mine = (j == x) ? c : mine; }
        if (sum == G) break;
        __builtin_amdgcn_s_sleep(1);
        if ((++sp & 255u) == 0u) { if (xb_ld(&bar[XB_TMO])) break; if (sp > XB_SPIN_CAP) { atomicAdd(&bar[XB_TMO], 1u); break; } }
    }
    nloc = mine > 0u ? mine : 1u; nx = cnt > 0u ? cnt : 1u;
}

__device__ __forceinline__ void xcd_barrier(const XcdBarrier& b) {
    asm volatile("s_waitcnt vmcnt(0)" ::: "memory");
    __syncthreads();
    if (threadIdx.x == 0) {
        unsigned* bar = b.bar;
        __builtin_amdgcn_s_waitcnt(0);
        unsigned nloc = b.st[0], nx = b.st[1];
        if (nloc == 0u) { xcd_barrier_complete(bar, b.x, nloc, nx); b.st[0] = nloc; b.st[1] = nx; }
        const unsigned old = xb_add(&bar[XB_XSUB(b.x)], 1u);
        const unsigned gen = old / nloc;
        if (old + 1u == (gen + 1u) * nloc) {
            __builtin_amdgcn_fence(__ATOMIC_RELEASE, "agent");
            asm volatile("s_waitcnt vmcnt(0)" ::: "memory");
            const unsigned og = xb_add(&bar[XB_TOP], 1u);
            const unsigned tg = og / nx;
            if (og + 1u == (tg + 1u) * nx) xb_add(&bar[XB_TOPGEN], 1u);
            else XB_SPIN(xb_ld(&bar[XB_TOPGEN]) == tg, bar);
            __builtin_amdgcn_fence(__ATOMIC_ACQUIRE, "agent");
            xb_add(&bar[XB_XGEN(b.x)], 1u);
            asm volatile("s_waitcnt vmcnt(0)" ::: "memory");
        } else {
            XB_SPIN(xb_ld(&bar[XB_XGEN(b.x)]) == gen, bar);
            __builtin_amdgcn_fence(__ATOMIC_ACQUIRE, "agent");
            asm volatile("s_waitcnt vmcnt(0)" ::: "memory");
        }
    }
    __syncthreads();
}

__global__ void __launch_bounds__(512, 2) mega_fwd(Args a) {
    extern __shared__ __attribute__((aligned(16))) unsigned char lds_raw[];
    LAS unsigned char* lds = (LAS unsigned char*)lds_raw;
    cg::grid_group grid = cg::this_grid();
    volatile LAS unsigned* xb_st = (volatile LAS unsigned*)(lds + XB_LDS_OFF);
    if (threadIdx.x < 4) xb_st[threadIdx.x] = 0u;
    __syncthreads();
    const XcdBarrier xbar = xcd_barrier_post((unsigned*)(a.ws + WS_BAR), xb_st);
    unsigned char* const ws = a.ws;
    const int lo = a.ph_lo, hi = a.ph_hi;
#ifndef NO_RET
#define NO_RET 0
#endif
#ifndef NO_ATTN
#define NO_ATTN 0
#endif
#ifndef NO_GEMM
#define NO_GEMM 0
#endif
#define IN(k) (lo <= (k) && (k) < hi)
#define TID ({ int t_ = threadIdx.x; asm volatile("" : "+v"(t_)); t_; })
#define SYNC(k) do { if (lo <= (k) && (k) + 1 < hi) { if ((k) == 0) grid.sync(); else xcd_barrier(xbar); } } while (0)
#define MODP ((float*)(ws + WS_MOD))
#define BF(off) ((bf16_t*)(ws + (off)))
#define GEMM(EpiT, Aoff, Boff, M_, N_, K_, E) do { const pg8::Gemm g_{BF(Aoff), BF(Boff), (M_), (N_), (K_)}; pg8::StaticOrder S_; S_.init((M_), (N_), (int)gridDim.x, (int)blockIdx.x); \
        if (!NO_GEMM) pg8::gemm_phase<EpiT, pg8::StaticOrder, PG8_ALIGN, PG8_SP2>(lds, g_, S_, E); } while (0)
    if (IN(0)) { phase0(a, lds, TID); } SYNC(0);
    if (IN(1)) { norm_phase<false>(a.in[0], a.in[2], nullptr, a.in[6], MODP, MODP + 1024, MA, BF(WS_H), TID); } SYNC(1);
    if (IN(2)) { const EpiQKV0 e{BF(WS_QKV0), a.in[11], a.in[12], (const float*)(ws + WS_TAB0)}; GEMM(EpiQKV0, WS_H, WS_WQKV0, MA, 1536, 1024, e); } SYNC(2);
    if (IN(3) && !NO_ATTN) { attn_phase(lds, BF(WS_QKV0), BF(WS_H), a.in[13], a.in[11], a.in[12], TID); } SYNC(3);
    if (IN(4)) { const EpiResid<0> e{a.in[0], a.in[2], BF(WS_X), nullptr, MODP + 2048}; GEMM(EpiResid<0>, WS_H, WS_WO0, MA, 1024, 1024, e); } SYNC(4);
    if (IN(5)) { norm_phase<true>(nullptr, nullptr, BF(WS_X), a.in[7], MODP + 3072, MODP + 4096, MA, BF(WS_H), TID); } SYNC(5);
    if (IN(6)) { const EpiSwiglu e{BF(WS_ACT0)}; GEMM(EpiSwiglu, WS_H, WS_WIN0, MA, 5632, 1024, e); } SYNC(6);
    if (IN(7)) { const EpiResid<1> e{nullptr, nullptr, BF(WS_X), nullptr, MODP + 5120}; GEMM(EpiResid<1>, WS_ACT0, WS_WOUT0, MA, 1024, 2816, e); } SYNC(7);
    if (IN(8)) { norm_phase<true>(nullptr, nullptr, BF(WS_X), a.in[6] + 1024, MODP + 33 * 6144, MODP + 33 * 6144 + 1024, MA, BF(WS_HL1), TID); } SYNC(8);
    if (IN(9)) { const EpiQKV1 e{BF(WS_Q1), BF(WS_K1), BF(WS_V1), (const float*)(ws + WS_TAB1)}; GEMM(EpiQKV1, WS_HL1, WS_WR, MA, 4096, 1024, e); } SYNC(9);
    if (IN(10) && !NO_RET) { ret_phase<0>(lds, BF(WS_Q1), BF(WS_K1), BF(WS_V1), (bf16_t*)a.out, (float*)(ws + WS_GNS), nullptr, a.in[16], TID); } SYNC(10);
    if (IN(11)) { const EpiGate e{BF(WS_V1), (const float*)(ws + WS_GNS), a.in[17]}; GEMM(EpiGate, WS_HL1, WS_WR + (size_t)4096 * 1024 * 2, MX, 2048, 1024, e); } SYNC(11);
    if (IN(12)) { const EpiResid<1> e{nullptr, nullptr, BF(WS_X), nullptr, MODP + 33 * 6144 + 2048}; GEMM(EpiResid<1>, WS_V1, WS_WRO, MX, 1024, 2048, e); } SYNC(12);
    if (IN(13)) { norm_phase<true>(nullptr, nullptr, BF(WS_X), a.in[7] + 1024, MODP + 33 * 6144 + 3072, MODP + 33 * 6144 + 4096, MX, BF(WS_Q1), TID); } SYNC(13);
    if (IN(14)) { const EpiSwiglu e{BF(WS_ACT1)}; GEMM(EpiSwiglu, WS_Q1, WS_WIN1, MX, 5632, 1024, e); } SYNC(14);
    if (IN(15)) { const EpiResid<2> e{nullptr, nullptr, BF(WS_X), a.out, MODP + 33 * 6144 + 5120}; GEMM(EpiResid<2>, WS_ACT1, WS_WOUT1, MX, 1024, 2816, e); }
#ifdef PROBE_UP1
    grid.sync();
    { const EpiSwiglu e{BF(WS_ACT1)}; GEMM(EpiSwiglu, WS_Q1, WS_WIN1, MX, 5632, 1024, e); }
#endif
#ifdef PROBE_RET
    grid.sync();
    ret_phase<PROBE_RET - 1>(lds, BF(WS_Q1), BF(WS_K1), BF(WS_V1), BF(WS_V1), (float*)(ws + WS_GNS), nullptr, a.in[16], TID);
#endif
#ifdef PROBE_SYNC
    for (int i = 0; i < 20; ++i) grid.sync();
#endif
#ifdef PROBE_RESID
    grid.sync();
    { const EpiResid<1> e{nullptr, nullptr, BF(WS_HL1), nullptr, MODP + 33 * 6144 + 2048}; GEMM(EpiResid<1>, WS_V1, WS_WRO, MX, 1024, 2048, e); }
    grid.sync();
    { const EpiResid<1> e{nullptr, nullptr, BF(WS_HL1), nullptr, MODP + 33 * 6144 + 5120}; GEMM(EpiResid<1>, WS_ACT1, WS_WOUT1, MX, 1024, 2816, e); }
#endif
#ifdef PROBE_NORM
    grid.sync();
    norm_phase<true>(nullptr, nullptr, BF(WS_X), a.in[7] + 1024, MODP + 33 * 6144 + 3072, MODP + 33 * 6144 + 4096, MX, BF(WS_Q1), TID);
    grid.sync();
    phase0(a, lds, TID);
#endif
}


#ifndef MK_MULTI
#define MK_MULTI 0
#endif
extern "C" void kernel_launch(void* const* d_in, const int* in_sizes, int n_in, void* d_out, int out_size, void* d_ws, size_t ws_size, hipStream_t stream) {
    static int grid = 0;
    if (grid == 0) {
        int dev = 0, cus = 0, per_cu = 0;
        (void)hipGetDevice(&dev); (void)hipDeviceGetAttribute(&cus, hipDeviceAttributeMultiprocessorCount, dev);
        if (hipFuncSetAttribute((const void*)mega_fwd, hipFuncAttributeMaxDynamicSharedMemorySize, LDS_BYTES) != hipSuccess) fprintf(stderr, "kernel_launch: hipFuncSetAttribute failed\n");
        if (hipOccupancyMaxActiveBlocksPerMultiprocessor(&per_cu, (const void*)mega_fwd, 512, LDS_BYTES) != hipSuccess || per_cu < 1) { fprintf(stderr, "kernel_launch: occupancy query says %d blocks/CU\n", per_cu); per_cu = 1; }
        (void)hipGetLastError();
        grid = cus > 0 ? cus : 256;
        if (n_in != 19 || ws_size < WS_END) fprintf(stderr, "kernel_launch: unexpected n_in %d / ws_size %zu (need %zu)\n", n_in, ws_size, (size_t)WS_END);
    }
    (void)hipMemsetAsync((unsigned char*)d_ws + WS_BAR, 0, 65536, stream);
    Args a{};
    for (int i = 0; i < 19; ++i) a.in[i] = (const float*)d_in[i];
    a.out = (float*)d_out; a.ws = (unsigned char*)d_ws;
#if MK_MULTI
    for (int ph = 0; ph < NPHASE; ++ph) { a.ph_lo = ph; a.ph_hi = ph + 1; hipLaunchKernelGGL(mega_fwd, dim3(grid), dim3(512), LDS_BYTES, stream, a); }
#else
    a.ph_lo = 0; a.ph_hi = NPHASE;
    void* args[] = {&a};
    const hipError_t e = hipLaunchCooperativeKernel((const void*)mega_fwd, dim3(grid), dim3(512), args, LDS_BYTES, stream);
    if (e != hipSuccess) fprintf(stderr, "kernel_launch: cooperative launch failed: %s (grid %d)\n", hipGetErrorString(e), grid);
#endif
}
```

```cpp
#include <hip/hip_runtime.h>
#include <hip/hip_cooperative_groups.h>
#include <cstdio>
#include <cstdint>
namespace cg = cooperative_groups;

namespace pg8 {
#define PG8_LAS __attribute__((address_space(3)))
typedef unsigned short bf16_t;
typedef short bf16x8 __attribute__((ext_vector_type(8)));
typedef float f32x4 __attribute__((ext_vector_type(4)));
typedef unsigned u32x4 __attribute__((ext_vector_type(4)));
constexpr int BM = 256, BK = 64, HALF = 128, HTB = HALF * BK * 2  , STAGE_BYTES = 8 * HTB, NXCD = 8, WGM = 8;

__host__ __device__ __forceinline__ int lds_byte(int r, int c) { const int st = (r >> 4) * 2 + (c >> 5), rr = r & 15, cc = c & 31, ob = rr * 64 + cc * 2; return st * 1024 + (ob ^ (((ob >> 9) & 1) << 5)); }
__host__ __device__ __forceinline__ void stage_rc(int b, int& R, int& C) { const int st = b / 1024, sb = b % 1024, swz = sb ^ (((sb >> 9) & 1) << 5); R = (st >> 1) * 16 + swz / 64; C = (st & 1) * 32 + (swz % 64) / 2; }
__host__ __device__ __forceinline__ int perm32(int rho) { const int n = rho >> 4, i = rho & 15; return 8 * (i >> 2) + 4 * n + (i & 3); }

struct Unit { int pm, pn; };
struct Gemm { const bf16_t* A; const bf16_t* Bt; int M, N, K; };

struct StaticOrder {
    int nM, nN, nwg, G, c;
    __host__ __device__ void init(int M, int N, int G_, int c_) { nM = M / BM; nN = N / BM; nwg = nM * nN; G = G_; c = c_; }
    __host__ __device__ bool next(int i, Unit& u) const {
        const long L = (long)i * G + c; if (L >= nwg) return false;
        int wgid = (int)L; { const int q = nwg / NXCD, r = nwg % NXCD, xcd = wgid % NXCD, off = wgid / NXCD; wgid = (xcd < r ? xcd * (q + 1) : r * (q + 1) + (xcd - r) * q) + off; }
        const int nig = WGM * nN, gid = wgid / nig, fm = gid * WGM, gsz = (nM - fm) < WGM ? (nM - fm) : WGM;
        u.pm = fm + ((wgid % nig) % gsz); u.pn = (wgid % nig) / gsz; return true;
    }
    __device__ __forceinline__ void a_ready(const Unit&) const {}
    __device__ __forceinline__ void done(const Unit&) const {}
};

__device__ __forceinline__ unsigned cvt_pk_bf16(float lo, float hi) { unsigned r; asm volatile("v_cvt_pk_bf16_f32 %0, %1, %2" : "=v"(r) : "v"(lo), "v"(hi)); return r; }
typedef float f32x2 __attribute__((ext_vector_type(2)));
template <class Epi, class Sched, bool ALIGN_EPI = false, bool SP2 = false>
__device__ __forceinline__ void gemm_phase(PG8_LAS unsigned char* lds, const Gemm g, const Sched& S, const Epi& E) {
    int tid_l = threadIdx.x; asm volatile("" : "+v"(tid_l));
    const int tid = tid_l, wid = __builtin_amdgcn_readfirstlane(tid >> 6), lane = tid & 63, wr = wid >> 2, wc = wid & 3, fr = lane & 15, fq = lane >> 4;
    const int K = g.K, nt = K / BK;
    unsigned voffA[2], voffB[2];
#pragma unroll
    for (int i = 0; i < 2; ++i) { int R, C; stage_rc(tid * 16 + i * 8192, R, C); const int Rb = Epi::PERM ? ((R & ~31) + perm32(R & 31)) : R;
        voffA[i] = (unsigned)(R * K + C) * 2u; voffB[i] = (unsigned)(Rb * K + C) * 2u; }
    const size_t kstep = (size_t)(BK * 2);
    const size_t hstep = (size_t)HALF * K * 2;
    const size_t tstep = 2 * hstep;
    const unsigned ldsw = (unsigned)wid * 1024u;
    const int aoff = lds_byte(wr * 64 + fr, fq * 8), boff = lds_byte(wc * 32 + fr, fq * 8);
#define PG8_SA(b, h) (((b) * 2 + (h)) * HTB)
#define PG8_SB(b, h) ((4 + (b) * 2 + (h)) * HTB)
#define PG8_STAGE(bufoff, gbase, voff) do { _Pragma("unroll") for (int _i = 0; _i < 2; ++_i) \
        __builtin_amdgcn_global_load_lds((const unsigned*)((const char*)(gbase) + (voff)[_i]), (PG8_LAS unsigned*)(lds + (bufoff) + ldsw + _i * 8192), 16, 0, 0); } while (0)
#define PG8_LDA(dst, b, h) do { _Pragma("unroll") for (int m = 0; m < 4; ++m) _Pragma("unroll") for (int k = 0; k < 2; ++k) dst[m][k] = *(const PG8_LAS bf16x8*)(lds + PG8_SA(b, h) + aoff + m * 2048 + k * 1024); } while (0)
#define PG8_LDB(dst, b, h) do { _Pragma("unroll") for (int n = 0; n < 2; ++n) _Pragma("unroll") for (int k = 0; k < 2; ++k) dst[n][k] = *(const PG8_LAS bf16x8*)(lds + PG8_SB(b, h) + boff + n * 2048 + k * 1024); } while (0)
#define PG8_MMA(ai, bj, At, Bt) do { __builtin_amdgcn_s_setprio(1); _Pragma("unroll") for (int m = 0; m < 4; ++m) _Pragma("unroll") for (int n = 0; n < 2; ++n) _Pragma("unroll") for (int k = 0; k < 2; ++k) \
        acc[ai][bj][m][n] = __builtin_amdgcn_mfma_f32_16x16x32_bf16(Bt[n][k], At[m][k], acc[ai][bj][m][n], 0, 0, 0); __builtin_amdgcn_s_setprio(0); } while (0)
#define PG8_WAIT_V(n) asm volatile("s_waitcnt vmcnt(" #n ")" ::: "memory")
#define PG8_WAIT_L(n) asm volatile("s_waitcnt lgkmcnt(" #n ")" ::: "memory")
#define PG8_BAR __builtin_amdgcn_s_barrier()
#define PG8_SCHED __builtin_amdgcn_sched_barrier(0)
    Unit cur, nxt; int ui = 0;
    if (!S.next(0, cur)) return;
    f32x4 acc[2][2][4][2];
#pragma unroll
    for (int a = 0; a < 2; ++a)
#pragma unroll
        for (int b = 0; b < 2; ++b)
#pragma unroll
            for (int m = 0; m < 4; ++m)
#pragma unroll
                for (int n = 0; n < 2; ++n) acc[a][b][m][n] = (f32x4){0.f, 0.f, 0.f, 0.f};
    bf16x8 At[4][2], B0[2][2], B1[2][2];
    const char* cA = (const char*)g.A + (size_t)cur.pm * tstep; const char* cB = (const char*)g.Bt + (size_t)cur.pn * tstep;
    S.a_ready(cur);
    if constexpr (SP2) {
        PG8_STAGE(PG8_SB(0, 0), cB, voffB); PG8_STAGE(PG8_SB(0, 1), cB + hstep, voffB); PG8_STAGE(PG8_SA(0, 0), cA, voffA); PG8_STAGE(PG8_SA(0, 1), cA + hstep, voffA);
        if (wr == 1) PG8_BAR;
        PG8_WAIT_V(2); PG8_BAR;
        PG8_STAGE(PG8_SB(1, 0), cB + kstep, voffB); PG8_STAGE(PG8_SA(1, 0), cA + kstep, voffA); PG8_STAGE(PG8_SB(1, 1), cB + hstep + kstep, voffB);
        PG8_WAIT_V(6); PG8_BAR;
    } else {
        PG8_STAGE(PG8_SB(0, 0), cB, voffB); PG8_STAGE(PG8_SA(0, 0), cA, voffA); PG8_STAGE(PG8_SB(0, 1), cB + hstep, voffB); PG8_STAGE(PG8_SA(0, 1), cA + hstep, voffA);
        if (wr == 1) PG8_BAR;
        PG8_WAIT_V(4); PG8_BAR;
        PG8_STAGE(PG8_SB(1, 0), cB + kstep, voffB); PG8_STAGE(PG8_SA(1, 0), cA + kstep, voffA); PG8_STAGE(PG8_SB(1, 1), cB + hstep + kstep, voffB);
        PG8_WAIT_V(6); PG8_BAR;
    }
    for (;;) {
        const bool has_next = S.next(ui + 1, nxt);
        const char* nA = has_next ? (const char*)g.A + (size_t)nxt.pm * tstep : cA; const char* nB = has_next ? (const char*)g.Bt + (size_t)nxt.pn * tstep : cB;
        for (int t = 0; t < nt; t += 2) {
            const bool last = (t == nt - 2);
            const char* a1 = cA + (size_t)(t + 1) * kstep;
            const char* a2 = last ? nA : cA + (size_t)(t + 2) * kstep; const char* b2 = last ? nB : cB + (size_t)(t + 2) * kstep;
            const char* a3 = a2 + kstep; const char* b3 = b2 + kstep;
            if (last && has_next) S.a_ready(nxt);
            if constexpr (SP2) {
            PG8_LDB(B0, 0, 0); PG8_LDB(B1, 0, 1); PG8_SCHED; PG8_LDA(At, 0, 0); PG8_STAGE(PG8_SA(1, 1), a1 + hstep, voffA);
            PG8_WAIT_V(8); PG8_WAIT_L(0); PG8_BAR; PG8_MMA(0, 0, At, B0); PG8_MMA(0, 1, At, B1); PG8_BAR; PG8_SCHED;
            PG8_LDA(At, 0, 1); PG8_STAGE(PG8_SB(0, 0), b2, voffB); PG8_STAGE(PG8_SB(0, 1), b2 + hstep, voffB); PG8_STAGE(PG8_SA(0, 0), a2, voffA);
            PG8_WAIT_V(8); PG8_WAIT_L(0); PG8_BAR; PG8_MMA(1, 0, At, B0); PG8_MMA(1, 1, At, B1); PG8_BAR; PG8_SCHED;
            PG8_LDB(B0, 1, 0); PG8_LDB(B1, 1, 1); PG8_SCHED; PG8_LDA(At, 1, 0); PG8_STAGE(PG8_SA(0, 1), a2 + hstep, voffA);
            PG8_WAIT_V(8); PG8_WAIT_L(0); PG8_BAR; PG8_MMA(0, 0, At, B0); PG8_MMA(0, 1, At, B1); PG8_BAR; PG8_SCHED;
            PG8_LDA(At, 1, 1); PG8_STAGE(PG8_SB(1, 0), b3, voffB); PG8_STAGE(PG8_SB(1, 1), b3 + hstep, voffB); PG8_STAGE(PG8_SA(1, 0), a3, voffA);
            PG8_WAIT_V(8); PG8_WAIT_L(0); PG8_BAR; PG8_MMA(1, 0, At, B0); PG8_MMA(1, 1, At, B1); PG8_BAR; PG8_SCHED;
            } else {
            PG8_LDB(B0, 0, 0); PG8_SCHED; PG8_LDA(At, 0, 0); PG8_STAGE(PG8_SA(1, 1), a1 + hstep, voffA);
            PG8_WAIT_L(8); PG8_BAR; PG8_WAIT_L(0); PG8_MMA(0, 0, At, B0); PG8_BAR; PG8_SCHED;
            PG8_LDB(B1, 0, 1); PG8_STAGE(PG8_SB(0, 0), b2, voffB);
            PG8_BAR; PG8_WAIT_L(0); PG8_MMA(0, 1, At, B1); PG8_BAR;
            PG8_LDA(At, 0, 1); PG8_STAGE(PG8_SA(0, 0), a2, voffA);
            PG8_BAR; PG8_WAIT_L(0); PG8_MMA(1, 0, At, B0); PG8_BAR; PG8_SCHED;
            PG8_STAGE(PG8_SB(0, 1), b2 + hstep, voffB);
            PG8_WAIT_V(6); PG8_BAR; PG8_MMA(1, 1, At, B1); PG8_BAR;
            PG8_LDB(B0, 1, 0); PG8_SCHED; PG8_LDA(At, 1, 0); PG8_STAGE(PG8_SA(0, 1), a2 + hstep, voffA);
            PG8_WAIT_L(8); PG8_BAR; PG8_WAIT_L(0); PG8_MMA(0, 0, At, B0); PG8_BAR; PG8_SCHED;
            PG8_LDB(B1, 1, 1); PG8_STAGE(PG8_SB(1, 0), b3, voffB);
            PG8_BAR; PG8_WAIT_L(0); PG8_MMA(0, 1, At, B1); PG8_BAR;
            PG8_LDA(At, 1, 1); PG8_STAGE(PG8_SA(1, 0), a3, voffA);
            PG8_BAR; PG8_WAIT_L(0); PG8_MMA(1, 0, At, B0); PG8_BAR; PG8_SCHED;
            PG8_STAGE(PG8_SB(1, 1), b3 + hstep, voffB);
            PG8_WAIT_V(6); PG8_BAR; PG8_MMA(1, 1, At, B1); PG8_BAR;
            }
        }
        if constexpr (ALIGN_EPI) { if (wr == 0) PG8_BAR; }
        if constexpr (!Epi::AFTER_DRAIN) { E(acc, cur, wr, wc, fr, fq); S.done(cur); }
        if (!has_next) break;
#pragma unroll
        for (int a = 0; a < 2; ++a)
#pragma unroll
            for (int b = 0; b < 2; ++b)
#pragma unroll
                for (int m = 0; m < 4; ++m)
#pragma unroll
                    for (int n = 0; n < 2; ++n) acc[a][b][m][n] = (f32x4){0.f, 0.f, 0.f, 0.f};
        cur = nxt; cA = nA; cB = nB; ++ui;
        if constexpr (ALIGN_EPI) { if (wr == 1) PG8_BAR; }
    }
    PG8_WAIT_V(0);
    if constexpr (!ALIGN_EPI) { if (wr == 0) PG8_BAR; }
    PG8_BAR;
    if constexpr (Epi::AFTER_DRAIN) { E.fused(acc, cur, wr, wc, fr, fq, lds, wid, lane); S.done(cur); }
#undef PG8_SA
#undef PG8_SB
#undef PG8_STAGE
#undef PG8_LDA
#undef PG8_LDB
#undef PG8_MMA
#undef PG8_WAIT_V
#undef PG8_WAIT_L
#undef PG8_BAR
#undef PG8_SCHED
}
}

#ifndef PG8_SP2
#define PG8_SP2 true
#endif
#ifndef PG8_ALIGN
#define PG8_ALIGN true
#endif

#define LAS __attribute__((address_space(3)))
typedef unsigned short bf16_t;
typedef short bf16x8 __attribute__((ext_vector_type(8)));
typedef short s16x4 __attribute__((ext_vector_type(4)));
typedef float f32x4 __attribute__((ext_vector_type(4)));
typedef float f32x16 __attribute__((ext_vector_type(16)));
typedef unsigned u32x4 __attribute__((ext_vector_type(4)));
typedef unsigned u32x2 __attribute__((ext_vector_type(2)));

constexpr int NB = 32, SEQ = 2048, DM = 1024, CL = 256, MX = NB * SEQ, MC = NB * CL, MA = MX + MC, DFF = 2816;
constexpr float LOG2E = 1.4426950408889634f;
constexpr float EPSN = 1e-6f;
constexpr size_t MiB = (size_t)1 << 20;
constexpr size_t WS_WQKV0 = 1 * MiB, WS_WO0 = 4 * MiB, WS_WIN0 = 6 * MiB, WS_WOUT0 = 17 * MiB, WS_WR = 23 * MiB, WS_WRO = 35 * MiB, WS_WIN1 = 39 * MiB, WS_WOUT1 = 50 * MiB;
constexpr size_t WS_MOD = 56 * MiB, WS_TAB0 = 58 * MiB, WS_TAB1 = 58 * MiB + 65536;
constexpr size_t WS_GNS = 60 * MiB;
constexpr size_t WS_X = 64 * MiB;
constexpr size_t WS_H = 208 * MiB, WS_QKV0 = 352 * MiB, WS_ACT0 = 352 * MiB;
constexpr size_t WS_Q1 = 208 * MiB, WS_K1 = 352 * MiB, WS_V1 = 496 * MiB, WS_HL1 = 784 * MiB, WS_ACT1 = 352 * MiB, WS_END = 1024 * MiB;
constexpr int LDS_BYTES = 152 * 1024, XB_LDS_OFF = 150 * 1024;
constexpr size_t WS_BAR = 62 * MiB;
constexpr int NPHASE = 16;

__device__ __forceinline__ unsigned pkbf(float lo, float hi) { return pg8::cvt_pk_bf16(lo, hi); }
__device__ __forceinline__ float bf_lo(unsigned w) { return __builtin_bit_cast(float, w << 16); }
__device__ __forceinline__ float bf_hi(unsigned w) { return __builtin_bit_cast(float, w & 0xffff0000u); }
__device__ __forceinline__ float bf2f(bf16_t v) { return __builtin_bit_cast(float, (unsigned)v << 16); }
__device__ __forceinline__ float wave_sum(float v) {
#pragma unroll
    for (int o = 1; o < 64; o <<= 1) v += __shfl_xor(v, o);
    return v;
}
__device__ __forceinline__ float fast_silu(float x) { return x * __builtin_amdgcn_rcpf(1.0f + __expf(-x)); }

struct EpiSplit {
    static constexpr bool PERM = true, AFTER_DRAIN = false;
    bf16_t* d0; int ld0; int t1; bf16_t* d1; int ld1; int t2; bf16_t* d2; int ld2;
    __device__ __forceinline__ void operator()(const pg8::f32x4 (&acc)[2][2][4][2], const pg8::Unit& u, int wr, int wc, int fr, int fq) const {
        bf16_t* base; int ld, ct;
        if (u.pn < t1) { base = d0; ld = ld0; ct = u.pn; } else if (u.pn < t2) { base = d1; ld = ld1; ct = u.pn - t1; } else { base = d2; ld = ld2; ct = u.pn - t2; }
        const int row0 = u.pm * 256 + wr * 64 + fr, col0 = ct * 256 + wc * 32 + 8 * fq;
#pragma unroll
        for (int ai = 0; ai < 2; ++ai)
#pragma unroll
            for (int m = 0; m < 4; ++m) { bf16_t* rowp = base + (size_t)(row0 + ai * 128 + m * 16) * ld + col0;
#pragma unroll
                for (int bj = 0; bj < 2; ++bj) { const pg8::f32x4 v0 = acc[ai][bj][m][0], v1 = acc[ai][bj][m][1]; u32x4 w;
                    w.x = pkbf(v0[0], v0[1]); w.y = pkbf(v0[2], v0[3]); w.z = pkbf(v1[0], v1[1]); w.w = pkbf(v1[2], v1[3]);
                    *(u32x4*)(rowp + bj * 128) = w; } }
    }
};
struct EpiQKV0 {
    static constexpr bool PERM = true, AFTER_DRAIN = false;
    bf16_t* O; const float* qg; const float* kg; const float* tab0;
    __device__ __forceinline__ void operator()(const pg8::f32x4 (&acc)[2][2][4][2], const pg8::Unit& u, int wr, int wc, int fr, int fq) const {
        const int row0 = u.pm * 256 + wr * 64 + fr, col0 = u.pn * 256 + wc * 32 + 8 * fq;
        if (u.pn >= 5) {
#pragma unroll
            for (int ai = 0; ai < 2; ++ai)
#pragma unroll
                for (int m = 0; m < 4; ++m) { bf16_t* rowp = O + (size_t)(row0 + ai * 128 + m * 16) * 1536 + col0;
#pragma unroll
                    for (int bj = 0; bj < 2; ++bj) { const pg8::f32x4 v0 = acc[ai][bj][m][0], v1 = acc[ai][bj][m][1]; u32x4 w;
                        w.x = pkbf(v0[0], v0[1]); w.y = pkbf(v0[2], v0[3]); w.z = pkbf(v1[0], v1[1]); w.w = pkbf(v1[2], v1[3]); *(u32x4*)(rowp + bj * 128) = w; } }
            return;
        }
        const float* gp = (u.pn < 4 ? qg : kg) + 8 * fq + (fq >= 2 ? 16 : 0);
        const float qs = u.pn < 4 ? 0.125f * LOG2E : 1.0f;
        pg8::f32x4 g1[2], g2[2];
#pragma unroll
        for (int n = 0; n < 2; ++n) { g1[n] = *(const pg8::f32x4*)(gp + 4 * n) * qs; g2[n] = *(const pg8::f32x4*)(gp + 16 + 4 * n) * qs; }
        const bool lat = u.pm * 256 < MX;
#pragma unroll
        for (int ai = 0; ai < 2; ++ai)
#pragma unroll
            for (int m = 0; m < 4; ++m) { const int row = row0 + ai * 128 + m * 16;
                pg8::f32x4 x1[2] = {acc[ai][0][m][0], acc[ai][0][m][1]}, x2[2] = {acc[ai][1][m][0], acc[ai][1][m][1]};
                float ss = 0.f;
#pragma unroll
                for (int n = 0; n < 2; ++n) ss += (x1[n][0] * x1[n][0] + x1[n][1] * x1[n][1]) + (x1[n][2] * x1[n][2] + x1[n][3] * x1[n][3]) + (x2[n][0] * x2[n][0] + x2[n][1] * x2[n][1]) + (x2[n][2] * x2[n][2] + x2[n][3] * x2[n][3]);
                ss += __shfl_xor(ss, 16); ss += __shfl_xor(ss, 32);
                const float rstd = rsqrtf(ss * (1.0f / 64.0f) + EPSN);
#pragma unroll
                for (int n = 0; n < 2; ++n) { x1[n] = x1[n] * rstd * g1[n]; x2[n] = x2[n] * rstd * g2[n]; }
                if (lat) { const int s = row & (SEQ - 1), pos = (fq & 2) ? (s & 63) : (s >> 6);
                    const float* tp = tab0 + ((size_t)pos * 16 + 8 * (fq & 1)) * 2;
#pragma unroll
                    for (int n = 0; n < 2; ++n) { const pg8::f32x4 t0 = *(const pg8::f32x4*)(tp + 8 * n), t1 = *(const pg8::f32x4*)(tp + 8 * n + 4);
                        const pg8::f32x4 cs = {t0[0], t0[2], t1[0], t1[2]}, sn = {t0[1], t0[3], t1[1], t1[3]};
                        const pg8::f32x4 a = x1[n] * cs - x2[n] * sn, bb = x1[n] * sn + x2[n] * cs; x1[n] = a; x2[n] = bb; } }
                bf16_t* rowp = O + (size_t)row * 1536 + col0; u32x4 w;
                w.x = pkbf(x1[0][0], x1[0][1]); w.y = pkbf(x1[0][2], x1[0][3]); w.z = pkbf(x1[1][0], x1[1][1]); w.w = pkbf(x1[1][2], x1[1][3]); *(u32x4*)rowp = w;
                w.x = pkbf(x2[0][0], x2[0][1]); w.y = pkbf(x2[0][2], x2[0][3]); w.z = pkbf(x2[1][0], x2[1][1]); w.w = pkbf(x2[1][2], x2[1][3]); *(u32x4*)(rowp + 128) = w;
                asm volatile("" ::: "memory"); }
    }
};
struct EpiQKV1 {
    static constexpr bool PERM = true, AFTER_DRAIN = false;
    bf16_t* Qd; bf16_t* Kd; bf16_t* Vd; const float* tab1;
    __device__ __forceinline__ void operator()(const pg8::f32x4 (&acc)[2][2][4][2], const pg8::Unit& u, int wr, int wc, int fr, int fq) const {
        bf16_t* base; int ld, ct;
        if (u.pn < 4) { base = Qd; ld = 1024; ct = u.pn; } else if (u.pn < 8) { base = Kd; ld = 1024; ct = u.pn - 4; } else { base = Vd; ld = 2048; ct = u.pn - 8; }
        const int row0 = u.pm * 256 + wr * 64 + fr, col0 = ct * 256 + wc * 32 + 8 * fq;
        const bool rope = u.pn < 8 && u.pm * 256 < MX;
#pragma unroll
        for (int ai = 0; ai < 2; ++ai)
#pragma unroll
            for (int m = 0; m < 4; ++m) { const int row = row0 + ai * 128 + m * 16;
                pg8::f32x4 x1[2] = {acc[ai][0][m][0], acc[ai][0][m][1]}, x2[2] = {acc[ai][1][m][0], acc[ai][1][m][1]};
                if (rope) { const int s = row & (SEQ - 1), pos = (wc & 2) ? (s & 63) : (s >> 6);
                    const float* tp = tab1 + ((size_t)pos * 64 + 32 * (wc & 1) + 8 * fq) * 2;
#pragma unroll
                    for (int n = 0; n < 2; ++n) { const pg8::f32x4 t0 = *(const pg8::f32x4*)(tp + 8 * n), t1 = *(const pg8::f32x4*)(tp + 8 * n + 4);
                        const pg8::f32x4 cs = {t0[0], t0[2], t1[0], t1[2]}, sn = {t0[1], t0[3], t1[1], t1[3]};
                        const pg8::f32x4 a = x1[n] * cs - x2[n] * sn, bb = x1[n] * sn + x2[n] * cs; x1[n] = a; x2[n] = bb; } }
                bf16_t* rowp = base + (size_t)row * ld + col0; u32x4 w;
                w.x = pkbf(x1[0][0], x1[0][1]); w.y = pkbf(x1[0][2], x1[0][3]); w.z = pkbf(x1[1][0], x1[1][1]); w.w = pkbf(x1[1][2], x1[1][3]); *(u32x4*)rowp = w;
                w.x = pkbf(x2[0][0], x2[0][1]); w.y = pkbf(x2[0][2], x2[0][3]); w.z = pkbf(x2[1][0], x2[1][1]); w.w = pkbf(x2[1][2], x2[1][3]); *(u32x4*)(rowp + 128) = w;
                asm volatile("" ::: "memory"); }
    }
};
template <int MODE> struct EpiResid {
    static constexpr bool PERM = true, AFTER_DRAIN = false;
    const float* xin_lat; const float* xin_ctx; bf16_t* X; float* outf; const float* gate;
    __device__ __forceinline__ void operator()(const pg8::f32x4 (&acc)[2][2][4][2], const pg8::Unit& u, int wr, int wc, int fr, int fq) const {
        const int R = u.pm * 256; const int gr = R < MX ? R / SEQ : NB;
        const int col0 = u.pn * 256 + wc * 32 + 8 * fq; const float* gp = gate + (size_t)gr * 6144 + col0;
        const float* xi = R < MX ? xin_lat + (size_t)R * DM : xin_ctx + (size_t)(R - MX) * DM;
        pg8::f32x4 g[2][2];
#pragma unroll
        for (int bj = 0; bj < 2; ++bj)
#pragma unroll
            for (int n = 0; n < 2; ++n) g[bj][n] = *(const pg8::f32x4*)(gp + bj * 128 + 4 * n);
#pragma unroll
        for (int ai = 0; ai < 2; ++ai)
#pragma unroll
            for (int m = 0; m < 4; ++m) { const size_t off = (size_t)(wr * 64 + fr + ai * 128 + m * 16) * DM + col0;
#pragma unroll
                for (int bj = 0; bj < 2; ++bj) {
                    pg8::f32x4 x0, x1;
                    if (MODE == 0) { x0 = *(const pg8::f32x4*)(xi + off + bj * 128); x1 = *(const pg8::f32x4*)(xi + off + bj * 128 + 4); }
                    else { const u32x4 w = *(const u32x4*)(X + (size_t)R * DM + off + bj * 128); x0 = (pg8::f32x4){bf_lo(w.x), bf_hi(w.x), bf_lo(w.y), bf_hi(w.y)}; x1 = (pg8::f32x4){bf_lo(w.z), bf_hi(w.z), bf_lo(w.w), bf_hi(w.w)}; }
                    x0 = x0 + g[bj][0] * acc[ai][bj][m][0]; x1 = x1 + g[bj][1] * acc[ai][bj][m][1];
                    if (MODE == 2) { __builtin_nontemporal_store(x0, (pg8::f32x4*)(outf + (size_t)R * DM + off + bj * 128)); __builtin_nontemporal_store(x1, (pg8::f32x4*)(outf + (size_t)R * DM + off + bj * 128 + 4)); }
                    else { u32x4 w; w.x = pkbf(x0[0], x0[1]); w.y = pkbf(x0[2], x0[3]); w.z = pkbf(x1[0], x1[1]); w.w = pkbf(x1[2], x1[3]); *(u32x4*)(X + (size_t)R * DM + off + bj * 128) = w; } }
                asm volatile("" ::: "memory"); }
    }
};
struct EpiSwiglu {
    static constexpr bool PERM = true, AFTER_DRAIN = false;
    bf16_t* O;
    __device__ __forceinline__ void operator()(const pg8::f32x4 (&acc)[2][2][4][2], const pg8::Unit& u, int wr, int wc, int fr, int fq) const {
        const int row0 = u.pm * 256 + wr * 64 + fr, col0 = u.pn * 128 + wc * 32 + 8 * fq;
#pragma unroll
        for (int ai = 0; ai < 2; ++ai)
#pragma unroll
            for (int m = 0; m < 4; ++m) { const pg8::f32x4 g0 = acc[ai][0][m][0], g1 = acc[ai][0][m][1], u0 = acc[ai][1][m][0], u1 = acc[ai][1][m][1]; u32x4 w;
#define SWG(g_, u_) ((g_) * (u_) * __builtin_amdgcn_rcpf(1.0f + __builtin_amdgcn_exp2f(g_)))
                w.x = pkbf(SWG(g0[0], u0[0]), SWG(g0[1], u0[1])); w.y = pkbf(SWG(g0[2], u0[2]), SWG(g0[3], u0[3]));
                w.z = pkbf(SWG(g1[0], u1[0]), SWG(g1[1], u1[1])); w.w = pkbf(SWG(g1[2], u1[2]), SWG(g1[3], u1[3]));
#undef SWG
                *(u32x4*)(O + (size_t)(row0 + ai * 128 + m * 16) * DFF + col0) = w; }
    }
};
struct EpiGate {
    static constexpr bool PERM = true, AFTER_DRAIN = false;
    bf16_t* Y; const float* stats; const float* gain;
    __device__ __forceinline__ void operator()(const pg8::f32x4 (&acc)[2][2][4][2], const pg8::Unit& u, int wr, int wc, int fr, int fq) const {
        const int row0 = u.pm * 256 + wr * 64 + fr, col0 = u.pn * 256 + wc * 32 + 8 * fq, hg = u.pn >> 1;
        pg8::f32x4 g[2][2];
#pragma unroll
        for (int bj = 0; bj < 2; ++bj)
#pragma unroll
            for (int n = 0; n < 2; ++n) g[bj][n] = *(const pg8::f32x4*)(gain + col0 + bj * 128 + 4 * n);
#pragma unroll
        for (int ai = 0; ai < 2; ++ai)
#pragma unroll
            for (int m = 0; m < 4; ++m) { const int row = row0 + ai * 128 + m * 16; bf16_t* rowp = Y + (size_t)row * 2048 + col0;
                const float s0 = stats[((size_t)row * 4 + hg) * 2], s1 = stats[((size_t)row * 4 + hg) * 2 + 1];
                const float mu = s0 * (1.0f / 512.0f), rstd = rsqrtf(fmaxf(s1 * (1.0f / 512.0f) - mu * mu, 0.f) + EPSN);
#pragma unroll
                for (int bj = 0; bj < 2; ++bj) { const u32x4 y = *(const u32x4*)(rowp + bj * 128); const pg8::f32x4 v0 = acc[ai][bj][m][0], v1 = acc[ai][bj][m][1];
                    const pg8::f32x4 y0 = ((pg8::f32x4){bf_lo(y.x), bf_hi(y.x), bf_lo(y.y), bf_hi(y.y)} - mu) * rstd * g[bj][0], y1 = ((pg8::f32x4){bf_lo(y.z), bf_hi(y.z), bf_lo(y.w), bf_hi(y.w)} - mu) * rstd * g[bj][1];
                    u32x4 w;
                    w.x = pkbf(fast_silu(v0[0]) * y0[0], fast_silu(v0[1]) * y0[1]); w.y = pkbf(fast_silu(v0[2]) * y0[2], fast_silu(v0[3]) * y0[3]);
                    w.z = pkbf(fast_silu(v1[0]) * y1[0], fast_silu(v1[1]) * y1[1]); w.w = pkbf(fast_silu(v1[2]) * y1[2], fast_silu(v1[3]) * y1[3]);
                    *(u32x4*)(rowp + bj * 128) = w; }
                asm volatile("" ::: "memory"); }
    }
};

__device__ __forceinline__ int drow_map(int mode, int n) {
    if (mode == 1) return n < DFF ? (n / 128) * 256 + (n % 128) : ((n - DFF) / 128) * 256 + 128 + ((n - DFF) % 128);
    if (mode == 2) { if (n >= 2048) return n; const int o = n & 255, blk = o >> 6, nb = (blk == 1) ? 2 : (blk == 2 ? 1 : blk); return (n - o) + 64 * nb + (o & 63); }
    if (mode == 3) { if (n >= 1280) return n; const int o = n & 255, hd = o >> 6, d = o & 63, q16 = d >> 4; return (n - o) + 128 * (q16 & 1) + 32 * hd + 16 * (q16 >> 1) + (d & 15); }
    return n;
}
__device__ __forceinline__ void transpose_item(const float* W, int K, int N, bf16_t* WT, int k0, int n0, int mode, LAS float* scr, int lane) {
    {
        float t[32];
        const float* wp = W + (size_t)(k0 + (lane >> 5)) * N + n0 + (lane & 31);
#pragma unroll
        for (int i = 0; i < 32; ++i) t[i] = wp[(size_t)(2 * i) * N];
#pragma unroll
        for (int i = 0; i < 32; ++i) scr[(2 * i + (lane >> 5)) * 33 + (lane & 31)] = t[i];
    }
    asm volatile("s_waitcnt lgkmcnt(0)" ::: "memory");
    const int c = lane & 7;
    const float wsc = mode == 1 ? (n0 < DFF ? -LOG2E : -1.0f / LOG2E) : 1.0f;
#pragma unroll
    for (int j = 0; j < 4; ++j) { const int n = (lane >> 3) + 8 * j; const LAS float* s = scr + (8 * c) * 33 + n;
        u32x4 o; o.x = pkbf(s[0 * 33] * wsc, s[1 * 33] * wsc); o.y = pkbf(s[2 * 33] * wsc, s[3 * 33] * wsc); o.z = pkbf(s[4 * 33] * wsc, s[5 * 33] * wsc); o.w = pkbf(s[6 * 33] * wsc, s[7 * 33] * wsc);
        *(u32x4*)(WT + (size_t)drow_map(mode, n0 + n) * K + k0 + 8 * c) = o; }
    asm volatile("s_waitcnt lgkmcnt(0)" ::: "memory");
}

struct Args { const float* in[19]; float* out; unsigned char* ws; int ph_lo, ph_hi; };

__device__ __forceinline__ void phase0(const Args& a, LAS unsigned char* lds, int tid) {
    const int wave = tid >> 6, lane = tid & 63;
    const int gw = blockIdx.x * 8 + wave, NGW = gridDim.x * 8;
    unsigned char* ws = a.ws;
    {
        LAS float* scr = (LAS float*)(lds + wave * 16384);
        constexpr int I0 = 16 * 48, I1 = 16 * 32, I2 = 16 * 176, I3 = 44 * 32, I4 = 16 * 192, I5 = 32 * 32, I6 = I2, I7 = I3;
        constexpr int NIT = I0 + I1 + I2 + I3 + I4 + I5 + I6 + I7;
        for (int it = gw; it < NIT; it += NGW) {
            int r = it; const float* W; bf16_t* WT; int K, N; int mode = 0;
            if (r < I0) { W = a.in[10]; WT = (bf16_t*)(ws + WS_WQKV0); K = 1024; N = 1536; mode = 3; }
            else if ((r -= I0) < I1) { W = a.in[14]; WT = (bf16_t*)(ws + WS_WO0); K = 1024; N = 1024; }
            else if ((r -= I1) < I2) { W = a.in[8]; WT = (bf16_t*)(ws + WS_WIN0); K = 1024; N = 5632; mode = 1; }
            else if ((r -= I2) < I3) { W = a.in[9]; WT = (bf16_t*)(ws + WS_WOUT0); K = 2816; N = 1024; }
            else if ((r -= I3) < I4) { W = a.in[15]; WT = (bf16_t*)(ws + WS_WR); K = 1024; N = 6144; mode = 2; }
            else if ((r -= I4) < I5) { W = a.in[18]; WT = (bf16_t*)(ws + WS_WRO); K = 2048; N = 1024; }
            else if ((r -= I5) < I6) { W = a.in[8] + (size_t)1024 * 5632; WT = (bf16_t*)(ws + WS_WIN1); K = 1024; N = 5632; mode = 1; }
            else { r -= I6; W = a.in[9] + (size_t)2816 * 1024; WT = (bf16_t*)(ws + WS_WOUT1); K = 2816; N = 1024; }
            const int nblk = N / 32, kb = r / nblk, nb = r % nblk, n0 = 32 * nb;
            transpose_item(W, K, N, WT, 64 * kb, n0, mode, scr, lane);
        }
    }
    { f32x4* gs = (f32x4*)(ws + WS_GNS); for (int i = blockIdx.x * 512 + tid; i < MX * 8 / 4; i += gridDim.x * 512) gs[i] = (f32x4){0.f, 0.f, 0.f, 0.f}; }
    {
        const int gt = blockIdx.x * 512 + tid;
        if (gt < 64 * 16 + 64 * 64) {
            int pos, f; float expo; float* dst;
            if (gt < 1024) { pos = gt >> 4; f = gt & 15; expo = -(float)(2 * f) / 32.0f; dst = (float*)(ws + WS_TAB0) + (size_t)gt * 2; }
            else { const int g2 = gt - 1024; pos = g2 >> 6; f = g2 & 63; expo = -(float)(2 * f) / 128.0f; dst = (float*)(ws + WS_TAB1) + (size_t)g2 * 2; }
            const float inv = exp2f(expo * 13.287712379549449f);
            const float ang = (float)pos * inv;
            const double ad = (double)ang; const double kk = __builtin_rint(ad * 0.15915494309189535); const float red = (float)(ad - kk * 6.283185307179586);
            dst[0] = __cosf(red); dst[1] = __sinf(red);
        }
    }
    __syncthreads();
    {
        LAS float* sc = (LAS float*)lds + wave * (128 * 36);
        LAS float* red = (LAS float*)lds;
        float* mod = (float*)(ws + WS_MOD);
        for (int it = blockIdx.x; it < 192; it += gridDim.x) {
            const int l = it / 96, n0 = (it % 96) * 64;
            int lane_l = lane; asm volatile("" : "+v"(lane_l));
#pragma unroll
            for (int t0 = 0; t0 < 66; t0 += 22) {
                float tv[22];
#pragma unroll
                for (int t = 0; t < 22; ++t) { const int r = (t0 + t) >> 1, k = lane_l + 64 * (t & 1); tv[t] = r < 32 ? a.in[1][r * 1024 + wave * 128 + k] : a.in[3][wave * 128 + k]; }
#pragma unroll
                for (int t = 0; t < 22; ++t) { const int r = (t0 + t) >> 1, k = lane_l + 64 * (t & 1); sc[k * 36 + r] = tv[t] * __builtin_amdgcn_rcpf(1.0f + __expf(-tv[t])); }
                asm volatile("" ::: "memory");
            }
            asm volatile("s_waitcnt lgkmcnt(0)" ::: "memory");
            float acc[33];
#pragma unroll
            for (int r = 0; r < 33; ++r) acc[r] = 0.f;
            const float* Wp = a.in[4] + ((size_t)l * 1024 + wave * 128) * 6144 + n0 + lane_l;
#pragma unroll 1
            for (int k0 = 0; k0 < 128; k0 += 16) {
                float wv[16];
#pragma unroll
                for (int kk = 0; kk < 16; ++kk) wv[kk] = Wp[(size_t)(k0 + kk) * 6144];
#pragma unroll
                for (int kk = 0; kk < 16; ++kk) { const int k = k0 + kk;
#pragma unroll
                    for (int r4 = 0; r4 < 8; ++r4) { const f32x4 s = *(const LAS f32x4*)(sc + k * 36 + 4 * r4); acc[4 * r4] += s[0] * wv[kk]; acc[4 * r4 + 1] += s[1] * wv[kk]; acc[4 * r4 + 2] += s[2] * wv[kk]; acc[4 * r4 + 3] += s[3] * wv[kk]; }
                    acc[32] += sc[k * 36 + 32] * wv[kk];
                    if ((kk & 1) == 1) asm volatile("" ::: "memory"); }
            }
            __syncthreads();
#pragma unroll
            for (int r = 0; r < 33; ++r) red[(wave * 33 + r) * 64 + lane] = acc[r];
            __syncthreads();
            for (int idx = tid; idx < 33 * 64; idx += 512) { const int r = idx >> 6, cc = idx & 63; float s = 0.f;
#pragma unroll
                for (int w = 0; w < 8; ++w) s += red[(w * 33 + r) * 64 + cc];
                mod[((size_t)l * 33 + r) * 6144 + n0 + cc] = s + a.in[5][l * 6144 + n0 + cc]; }
            __syncthreads();
        }
    }
}

template <bool SRC_BF16>
__device__ __forceinline__ void norm_phase(const float* src_lat, const float* src_ctx, const bf16_t* srcb, const float* g, const float* shift, const float* scale, int nrows, bf16_t* dst, int tid) {
    const int lane = tid & 63, gw = blockIdx.x * 8 + (tid >> 6), NGW = gridDim.x * 8;
    const int R = (nrows + NGW - 1) / NGW, row_lo = gw * R, row_hi = (row_lo + R < nrows) ? row_lo + R : nrows;
    int cols[4];
#pragma unroll
    for (int j = 0; j < 4; ++j) cols[j] = 8 * lane + 512 * (j >> 1) + 4 * (j & 1);
    f32x4 gg[4], A[4], sh[4];
#pragma unroll
    for (int j = 0; j < 4; ++j) gg[j] = *(const f32x4*)(g + cols[j]);
    int rcur = -1;
#define NORM_LOAD(v_, row_) do { if (SRC_BF16) { const u32x4 w0_ = *(const u32x4*)(srcb + (size_t)(row_) * DM + 8 * lane), w1_ = *(const u32x4*)(srcb + (size_t)(row_) * DM + 512 + 8 * lane); \
            v_[0] = (f32x4){bf_lo(w0_.x), bf_hi(w0_.x), bf_lo(w0_.y), bf_hi(w0_.y)}; v_[1] = (f32x4){bf_lo(w0_.z), bf_hi(w0_.z), bf_lo(w0_.w), bf_hi(w0_.w)}; \
            v_[2] = (f32x4){bf_lo(w1_.x), bf_hi(w1_.x), bf_lo(w1_.y), bf_hi(w1_.y)}; v_[3] = (f32x4){bf_lo(w1_.z), bf_hi(w1_.z), bf_lo(w1_.w), bf_hi(w1_.w)}; \
        } else { const float* src_ = (row_) < MX ? src_lat + (size_t)(row_) * DM : src_ctx + (size_t)((row_) - MX) * DM; \
            _Pragma("unroll") for (int j_ = 0; j_ < 4; ++j_) v_[j_] = *(const f32x4*)(src_ + cols[j_]); } } while (0)
#define NORM_ROW(v_, row_) do { const int r_ = (row_) < MX ? (row_) / SEQ : NB; \
        if (r_ != rcur) { rcur = r_; _Pragma("unroll") for (int j_ = 0; j_ < 4; ++j_) { sh[j_] = *(const f32x4*)(shift + (size_t)r_ * 6144 + cols[j_]); A[j_] = gg[j_] * (*(const f32x4*)(scale + (size_t)r_ * 6144 + cols[j_]) + 1.0f); } } \
        float ss_ = 0.f; \
        _Pragma("unroll") for (int j_ = 0; j_ < 4; ++j_) ss_ += (v_[j_].x * v_[j_].x + v_[j_].y * v_[j_].y) + (v_[j_].z * v_[j_].z + v_[j_].w * v_[j_].w); \
        const float rstd_ = rsqrtf(wave_sum(ss_) * (1.0f / DM) + EPSN); \
        _Pragma("unroll") for (int j_ = 0; j_ < 4; j_ += 2) { const f32x4 h_ = v_[j_] * rstd_ * A[j_] + sh[j_], h2_ = v_[j_ + 1] * rstd_ * A[j_ + 1] + sh[j_ + 1]; \
            u32x4 w_; w_.x = pkbf(h_.x, h_.y); w_.y = pkbf(h_.z, h_.w); w_.z = pkbf(h2_.x, h2_.y); w_.w = pkbf(h2_.z, h2_.w); \
            *(u32x4*)(dst + (size_t)(row_) * DM + cols[j_]) = w_; } } while (0)
    for (int row = row_lo; row < row_hi; row += 4) {
        f32x4 va[4], vb[4], vc[4], vd[4];
        const int nr = row_hi - row;
        NORM_LOAD(va, row);
        if (nr > 1) NORM_LOAD(vb, row + 1);
        if (nr > 2) NORM_LOAD(vc, row + 2);
        if (nr > 3) NORM_LOAD(vd, row + 3);
        NORM_ROW(va, row);
        if (nr > 1) NORM_ROW(vb, row + 1);
        if (nr > 2) NORM_ROW(vc, row + 2);
        if (nr > 3) NORM_ROW(vd, row + 3);
    }
#undef NORM_LOAD
#undef NORM_ROW
}

__device__ __forceinline__ void qknorm_phase(bf16_t* QKV, const float* qg, const float* kg, const float* tab0, int tid) {
    const long total = (long)MA * 160, stride = (long)gridDim.x * 512;
    for (long idx = (long)blockIdx.x * 512 + tid; idx < total; idx += stride) {
        const int ch = (int)(idx & 7), hd = (int)((idx >> 3) % 20), row = (int)(idx / 160);
        bf16_t* p = QKV + (size_t)row * 1536 + hd * 64 + ch * 8;
        const u32x4 w = *(const u32x4*)p;
        float v[8] = {bf_lo(w.x), bf_hi(w.x), bf_lo(w.y), bf_hi(w.y), bf_lo(w.z), bf_hi(w.z), bf_lo(w.w), bf_hi(w.w)};
        float ss = 0.f;
#pragma unroll
        for (int j = 0; j < 8; ++j) ss += v[j] * v[j];
        ss += __shfl_xor(ss, 1); ss += __shfl_xor(ss, 2); ss += __shfl_xor(ss, 4);
        const float rstd = rsqrtf(ss * (1.0f / 64.0f) + EPSN);
        const float* gp = (hd < 16 ? qg : kg) + ch * 8;
#pragma unroll
        for (int j = 0; j < 8; ++j) v[j] = v[j] * rstd * gp[j];
        float pv[8];
#pragma unroll
        for (int j = 0; j < 8; ++j) pv[j] = __shfl_xor(v[j], 2);
        if (row < MX) {
            const int s = row & (SEQ - 1), pos = (ch & 4) ? (s & 63) : (s >> 6);
            const float* tp = tab0 + ((size_t)pos * 16 + (ch & 1) * 8) * 2;
#pragma unroll
            for (int j = 0; j < 8; ++j) { const float cs = tp[2 * j], sn = tp[2 * j + 1];
                v[j] = (ch & 2) ? (pv[j] * sn + v[j] * cs) : (v[j] * cs - pv[j] * sn); }
        }
        const float qs = hd < 16 ? 0.125f * LOG2E : 1.0f;
        u32x4 o; o.x = pkbf(v[0] * qs, v[1] * qs); o.y = pkbf(v[2] * qs, v[3] * qs); o.z = pkbf(v[4] * qs, v[5] * qs); o.w = pkbf(v[6] * qs, v[7] * qs);
        *(u32x4*)p = o;
    }
}

__device__ __forceinline__ void rope1_phase(bf16_t* Q1, bf16_t* K1, const float* tab1, int tid) {
    const long total = (long)MX * 128, stride = (long)gridDim.x * 512;
    for (long idx = (long)blockIdx.x * 512 + tid; idx < total; idx += stride) {
        const int c8 = (int)(idx & 7), ax = (int)((idx >> 3) & 1), hd = (int)((idx >> 4) & 3), which = (int)((idx >> 6) & 1), row = (int)(idx >> 7);
        bf16_t* p = (which ? K1 : Q1) + (size_t)row * 1024 + hd * 256 + ax * 128 + c8 * 8;
        const u32x4 w1 = *(const u32x4*)p, w2 = *(const u32x4*)(p + 64);
        const float x1[8] = {bf_lo(w1.x), bf_hi(w1.x), bf_lo(w1.y), bf_hi(w1.y), bf_lo(w1.z), bf_hi(w1.z), bf_lo(w1.w), bf_hi(w1.w)};
        const float x2[8] = {bf_lo(w2.x), bf_hi(w2.x), bf_lo(w2.y), bf_hi(w2.y), bf_lo(w2.z), bf_hi(w2.z), bf_lo(w2.w), bf_hi(w2.w)};
        const int s = row & (SEQ - 1), pos = ax ? (s & 63) : (s >> 6);
        const float* tp = tab1 + ((size_t)pos * 64 + c8 * 8) * 2;
        float o1[8], o2[8];
#pragma unroll
        for (int j = 0; j < 8; ++j) { const float cs = tp[2 * j], sn = tp[2 * j + 1]; o1[j] = x1[j] * cs - x2[j] * sn; o2[j] = x1[j] * sn + x2[j] * cs; }
        u32x4 a, b; a.x = pkbf(o1[0], o1[1]); a.y = pkbf(o1[2], o1[3]); a.z = pkbf(o1[4], o1[5]); a.w = pkbf(o1[6], o1[7]);
        b.x = pkbf(o2[0], o2[1]); b.y = pkbf(o2[2], o2[3]); b.z = pkbf(o2[4], o2[5]); b.w = pkbf(o2[6], o2[7]);
        *(u32x4*)p = a; *(u32x4*)(p + 64) = b;
    }
}

__device__ __forceinline__ void gn_phase(bf16_t* Y, const float* gng, int tid) {
    const int lane = tid & 63, gw = blockIdx.x * 8 + (tid >> 6), NGW = gridDim.x * 8;
    for (int it = gw; it < MX * 4; it += NGW) {
        const int row = it >> 2, h = it & 3;
        bf16_t* p = Y + (size_t)row * 2048 + h * 512 + lane * 8;
        const u32x4 w = *(const u32x4*)p;
        float v[8] = {bf_lo(w.x), bf_hi(w.x), bf_lo(w.y), bf_hi(w.y), bf_lo(w.z), bf_hi(w.z), bf_lo(w.w), bf_hi(w.w)};
        float s = 0.f;
#pragma unroll
        for (int j = 0; j < 8; ++j) s += v[j];
        const float mu = wave_sum(s) * (1.0f / 512.0f); float q = 0.f;
#pragma unroll
        for (int j = 0; j < 8; ++j) { v[j] -= mu; q += v[j] * v[j]; }
        const float rstd = rsqrtf(wave_sum(q) * (1.0f / 512.0f) + EPSN);
        const float* gp = gng + h * 512 + lane * 8;
        const f32x4 g0 = *(const f32x4*)gp, g1 = *(const f32x4*)(gp + 4);
        u32x4 o; o.x = pkbf(v[0] * rstd * g0.x, v[1] * rstd * g0.y); o.y = pkbf(v[2] * rstd * g0.z, v[3] * rstd * g0.w);
        o.z = pkbf(v[4] * rstd * g1.x, v[5] * rstd * g1.y); o.w = pkbf(v[6] * rstd * g1.z, v[7] * rstd * g1.w);
        *(u32x4*)p = o;
    }
}

__device__ __forceinline__ f32x16 mfma32(bf16x8 a, bf16x8 b, f32x16 c) { return __builtin_amdgcn_mfma_f32_32x32x16_bf16(a, b, c, 0, 0, 0); }
__device__ __forceinline__ bf16x8 tr_pair(const LAS bf16_t* p0, const LAS bf16_t* p1) {
    const s16x4 a = __builtin_amdgcn_ds_read_tr16_b64_v4i16((LAS s16x4*)p0);
    const s16x4 b = __builtin_amdgcn_ds_read_tr16_b64_v4i16((LAS s16x4*)p1);
    return __builtin_shufflevector(a, b, 0, 1, 2, 3, 4, 5, 6, 7);
}
__device__ __forceinline__ bf16x8 pack8(const f32x16& v, int base) {
    u32x4 w; w.x = pkbf(v[base + 0], v[base + 1]); w.y = pkbf(v[base + 2], v[base + 3]); w.z = pkbf(v[base + 4], v[base + 5]); w.w = pkbf(v[base + 6], v[base + 7]);
    return __builtin_bit_cast(bf16x8, w);
}

constexpr int AKS = 72;
template <bool SHIFT>
__device__ __forceinline__ void attn_phase(LAS unsigned char* lds, const bf16_t* QKV, bf16_t* O, const float* sink, const float* qg, const float* kg, int tid) {
    const int wid = __builtin_amdgcn_readfirstlane(tid >> 6), lane = tid & 63, r = lane & 31, hh = lane >> 5, blk = (lane >> 4) & 1, q4 = (lane & 15) >> 2, p4 = lane & 3;
    LAS bf16_t* Kl = (LAS bf16_t*)lds;
    LAS bf16_t* Vl = (LAS bf16_t*)(lds + 64 * AKS * 2);
    const int skey = tid >> 3, sch = tid & 7;
    float Bnd;
    { float gq = fabsf(qg[lane]), gk = fabsf(kg[lane]);
#pragma unroll
      for (int o = 1; o < 64; o <<= 1) { gq = fmaxf(gq, __shfl_xor(gq, o)); gk = fmaxf(gk, __shfl_xor(gk, o)); }
      Bnd = SHIFT ? 8.0f * LOG2E * 1.02f * gq * gk : 0.0f; }
    for (int u0 = blockIdx.x; u0 < 2304; u0 += gridDim.x) {
        int u = u0;
        if (gridDim.x == 256 && u0 < 2048) { const int x = u0 & 7, idx = (u0 >> 3) & 31, rnd = u0 >> 8; u = ((rnd * 16 + x * 2 + (idx >> 4)) << 4) | (idx & 15); }
        int b, kvh, qb; bool isctx;
        if (u < 2048) { b = u >> 6; kvh = (u >> 4) & 3; qb = u & 15; isctx = false; } else { const int v = u - 2048; b = v >> 3; kvh = (v >> 1) & 3; qb = v & 1; isctx = true; }
        const int hq = kvh * 4 + (wid >> 1);
        const int qloc = qb * 128 + (wid & 1) * 64;
        const size_t qrow0 = isctx ? (size_t)MX + b * CL + qloc : (size_t)b * SEQ + qloc;
        bf16x8 qf[2][4];
#pragma unroll
        for (int qq = 0; qq < 2; ++qq)
#pragma unroll
            for (int s = 0; s < 4; ++s) qf[qq][s] = *(const bf16x8*)(QKV + (qrow0 + 32 * qq + r) * 1536 + (hq >> 2) * 256 + (s >> 1) * 128 + (hq & 3) * 32 + (s & 1) * 16 + 8 * hh);
        const float sl2 = sink[hq] * LOG2E;
        const float psink = hh == 0 ? __builtin_amdgcn_exp2f(sl2 - Bnd) : 0.0f;
        float lrun[2] = {psink, psink};
        f32x16 oacc[2][2];
#pragma unroll
        for (int i = 0; i < 2; ++i)
#pragma unroll
            for (int j = 0; j < 2; ++j)
#pragma unroll
                for (int e = 0; e < 16; ++e) oacc[i][j][e] = 0.f;
        int tlo = 2 - 2 * qb; if (tlo < 0) tlo = 0;
        int thi = 33 - 2 * qb; if (thi > 5) thi = 5;
        const int ntile = isctx ? 4 : 4 + (thi - tlo + 1);
        u32x4 kreg, vreg;
        {   const size_t row = (size_t)MX + b * CL + skey;
            kreg = *(const u32x4*)(QKV + row * 1536 + 1024 + (sch >> 2) * 128 + kvh * 32 + (sch & 3) * 8); vreg = *(const u32x4*)(QKV + row * 1536 + 1280 + kvh * 64 + sch * 8); }
        for (int it = 0; it < ntile; ++it) {
            __syncthreads();
            *(LAS u32x4*)(Kl + skey * AKS + sch * 8) = kreg; *(LAS u32x4*)(Vl + skey * AKS + sch * 8) = vreg;
            __syncthreads();
            if (it + 1 < ntile) { const int nt = it + 1;
                const size_t row = nt < 4 ? (size_t)MX + b * CL + 64 * nt + skey : (size_t)b * SEQ + qb * 128 - 128 + 64 * (tlo + nt - 4) + skey;
                kreg = *(const u32x4*)(QKV + row * 1536 + 1024 + (sch >> 2) * 128 + kvh * 32 + (sch & 3) * 8); vreg = *(const u32x4*)(QKV + row * 1536 + 1280 + kvh * 64 + sch * 8); }
            const int rel = it >= 4 ? (qb * 128 - 128 + 64 * (tlo + it - 4)) - qloc : 0;
            if (rel <= -192 || rel >= 192) continue;
            float nbnd = 0.0f; if (SHIFT) { nbnd = -Bnd; asm volatile("" : "+v"(nbnd)); }
            f32x16 st[2][2];
#pragma unroll
            for (int i = 0; i < 2; ++i)
#pragma unroll
                for (int j = 0; j < 2; ++j)
#pragma unroll
                    for (int e = 0; e < 16; ++e) st[i][j][e] = nbnd;
#pragma unroll
            for (int kb = 0; kb < 2; ++kb)
#pragma unroll
                for (int s = 0; s < 4; ++s) { const bf16x8 ka = *(const LAS bf16x8*)(Kl + (32 * kb + r) * AKS + 16 * s + 8 * hh);
                    st[kb][0] = mfma32(ka, qf[0][s], st[kb][0]); st[kb][1] = mfma32(ka, qf[1][s], st[kb][1]); }
            if (rel == -128 || rel == 128) {
                const int kbase = qb * 128 - 128 + 64 * (tlo + it - 4);
#pragma unroll
                for (int kb = 0; kb < 2; ++kb)
#pragma unroll
                    for (int qq = 0; qq < 2; ++qq) { const int qpos = qloc + 32 * qq + r;
#pragma unroll
                        for (int e = 0; e < 16; ++e) { const int key = kbase + 32 * kb + 8 * (e >> 2) + 4 * hh + (e & 3); int d = qpos - key; d = d < 0 ? -d : d;
                            st[kb][qq][e] = d <= 128 ? st[kb][qq][e] : -1e30f; } }
            }
            bf16x8 pf[2][2][2];
#pragma unroll
            for (int qq = 0; qq < 2; ++qq) {
                float ps = 0.f;
#pragma unroll
                for (int kb = 0; kb < 2; ++kb)
#pragma unroll
                    for (int s2 = 0; s2 < 2; ++s2) { float p[8];
#pragma unroll
                        for (int j = 0; j < 8; ++j) { p[j] = __builtin_amdgcn_exp2f(st[kb][qq][8 * s2 + j]); ps += p[j]; }
                        u32x4 w; w.x = pkbf(p[0], p[1]); w.y = pkbf(p[2], p[3]); w.z = pkbf(p[4], p[5]); w.w = pkbf(p[6], p[7]);
                        pf[kb][s2][qq] = __builtin_bit_cast(bf16x8, w); }
                lrun[qq] += ps;
            }
            __builtin_amdgcn_sched_barrier(0);
#pragma unroll
            for (int kb = 0; kb < 2; ++kb)
#pragma unroll
                for (int s2 = 0; s2 < 2; ++s2)
#pragma unroll
                    for (int db = 0; db < 2; ++db) {
                        const LAS bf16_t* vp = Vl + (32 * kb + 16 * s2 + 4 * hh + q4) * AKS + 32 * db + 16 * blk + 4 * p4;
                        const bf16x8 va = tr_pair(vp, vp + 8 * AKS);
                        oacc[db][0] = mfma32(va, pf[kb][s2][0], oacc[db][0]); oacc[db][1] = mfma32(va, pf[kb][s2][1], oacc[db][1]); }
        }
#pragma unroll
        for (int qq = 0; qq < 2; ++qq) {
            const float lt = lrun[qq] + __shfl_xor(lrun[qq], 32), inv = 1.0f / lt;
            bf16_t* op = O + (qrow0 + 32 * qq + r) * 1024 + hq * 64 + 4 * hh;
#pragma unroll
            for (int db = 0; db < 2; ++db)
#pragma unroll
                for (int g = 0; g < 4; ++g) { u32x2 w; w.x = pkbf(oacc[db][qq][4 * g] * inv, oacc[db][qq][4 * g + 1] * inv); w.y = pkbf(oacc[db][qq][4 * g + 2] * inv, oacc[db][qq][4 * g + 3] * inv);
                    *(u32x2*)(op + 32 * db + 8 * g) = w; }
        }
    }
}

constexpr int RS = 136;
__device__ __forceinline__ u32x4 scale8(const u32x4 w, const float f) {
    u32x4 o; o.x = pkbf(bf_lo(w.x) * f, bf_hi(w.x) * f); o.y = pkbf(bf_lo(w.y) * f, bf_hi(w.y) * f); o.z = pkbf(bf_lo(w.z) * f, bf_hi(w.z) * f); o.w = pkbf(bf_lo(w.w) * f, bf_hi(w.w) * f); return o;
}
__device__ __forceinline__ u32x4 add8(const u32x4 a, const u32x4 b) {
    u32x4 o; o.x = pkbf(bf_lo(a.x) + bf_lo(b.x), bf_hi(a.x) + bf_hi(b.x)); o.y = pkbf(bf_lo(a.y) + bf_lo(b.y), bf_hi(a.y) + bf_hi(b.y));
    o.z = pkbf(bf_lo(a.z) + bf_lo(b.z), bf_hi(a.z) + bf_hi(b.z)); o.w = pkbf(bf_lo(a.w) + bf_lo(b.w), bf_hi(a.w) + bf_hi(b.w)); return o;
}
template <int PM> __device__ __forceinline__ f32x16 rmf(bf16x8 a, bf16x8 b, f32x16 c) {
    if (PM == 1) { const u32x4 x = __builtin_bit_cast(u32x4, a), y = __builtin_bit_cast(u32x4, b); c[0] += __builtin_bit_cast(float, (x.x ^ y.x) & 0x3f800000u) + __builtin_bit_cast(float, (x.w ^ y.w) & 0x3f800000u); return c; }
    if (PM == 2) { const bf16x8 k = {0x3c00, 0x3c00, 0x3c00, 0x3c00, 0x3c00, 0x3c00, 0x3c00, 0x3c00}; return __builtin_amdgcn_mfma_f32_32x32x16_bf16(k, k, c, 0, 0, 0); }
    return __builtin_amdgcn_mfma_f32_32x32x16_bf16(a, b, c, 0, 0, 0);
}
template <int PM>
__device__ __forceinline__ void ret_phase(LAS unsigned char* lds, const bf16_t* Q1, const bf16_t* K1, bf16_t* V1, bf16_t* OF, float* gstats, unsigned* gsync, const float* decay_logit, int tid) {
    const int wid = tid >> 6, lane = tid & 63, r = lane & 31, hh = lane >> 5, blk = (lane >> 4) & 1, q4 = (lane & 15) >> 2, p4 = lane & 3;
    LAS bf16_t* QH = (LAS bf16_t*)lds;
    LAS bf16_t* KH = (LAS bf16_t*)(lds + 128 * RS * 2);
    LAS bf16_t* VL = (LAS bf16_t*)(lds + 2 * 128 * RS * 2);
    LAS bf16_t* SL = (LAS bf16_t*)(lds + 3 * 128 * RS * 2);
    LAS bf16_t* OL = KH;
    const int eb = wid & 3, dg = wid >> 2, nb = wid >> 1, mg = wid & 1;
    const int o_row = r * RS + 8 * hh;
    const int o_tr = (8 * hh + q4) * RS + 16 * blk + 4 * p4;
    const int sn = tid >> 4, scc = tid & 15;
    unsigned* gctr = (gsync != nullptr && gridDim.x == 256) ? gsync + ((blockIdx.x & 7) * 8 + ((blockIdx.x >> 5) & 7)) * 64 : nullptr;
    unsigned gtarget = 0u;
    for (int u0 = blockIdx.x; u0 < 512; u0 += gridDim.x) {
        int u = u0;
        if (gridDim.x == 256) { const int x = u0 & 7, idx = (u0 >> 3) & 31, rnd = u0 >> 8; u = ((rnd * 64 + x * 8 + (idx >> 2)) << 2) | (idx & 3); }
        const int b = u >> 4, h = (u >> 2) & 3, sl = u & 3;
        for (int dir = 0; dir < 2; ++dir) {
            const float logit = decay_logit[dir * 4 + h];
            const float lg2 = -log1pf(__expf(-logit)) * LOG2E;
            const float cd = exp2f(lg2 * 128.0f);
            f32x16 S[2][2];
#pragma unroll
            for (int i = 0; i < 2; ++i)
#pragma unroll
                for (int j = 0; j < 2; ++j)
#pragma unroll
                    for (int e = 0; e < 16; ++e) S[i][j][e] = 0.f;
            u32x4 rq[4], rk[4], rv[4];
#define RET_ROFF(i) (dir ? 127 - (sn + 32 * (i)) : (sn + 32 * (i)))
#define RET_ROFF2(i) (dir ? 127 - (sn2_ + 32 * (i)) : (sn2_ + 32 * (i)))
#define RET_TOK(base, i) ((base) + (size_t)RET_ROFF(i))
#define RET_LOAD_QK(stp, dhp) do { const bool cx_ = (stp) < 2; const int ci_ = cx_ ? (dir ? 1 - (stp) : (stp)) : (dir ? 17 - (stp) : (stp) - 2); \
        const size_t rb_ = cx_ ? (size_t)MX + b * CL + ci_ * 128 : (size_t)b * SEQ + ci_ * 128; \
        const bf16_t* qp_ = Q1 + rb_ * 1024 + h * 256 + (dhp) * 128; const bf16_t* kp_ = K1 + rb_ * 1024 + h * 256 + (dhp) * 128; \
        int sn2_ = sn; asm volatile("" : "+v"(sn2_)); \
        _Pragma("unroll") for (int i_ = 0; i_ < 4; ++i_) { const int o_ = RET_ROFF2(i_) * 1024 + scc * 8; \
            if (PM == 3) { rq[i_] = (u32x4){0x3c003c00u, 0x3c003c00u, 0x3c003c00u, 0x3c003c00u}; rk[i_] = rq[i_]; } else { \
            if (!cx_) rq[i_] = *(const u32x4*)(qp_ + o_); \
            rk[i_] = *(const u32x4*)(kp_ + o_); } } } while (0)
#define RET_LOAD_V(stp) do { const bool cx_ = (stp) < 2; const int ci_ = cx_ ? (dir ? 1 - (stp) : (stp)) : (dir ? 17 - (stp) : (stp) - 2); \
        const size_t rb_ = cx_ ? (size_t)MX + b * CL + ci_ * 128 : (size_t)b * SEQ + ci_ * 128; \
        const bf16_t* vp_ = V1 + rb_ * 2048 + h * 512 + sl * 128; \
        int sn2_ = sn; asm volatile("" : "+v"(sn2_)); \
        _Pragma("unroll") for (int i_ = 0; i_ < 4; ++i_) { const int o_ = RET_ROFF2(i_) * 2048 + scc * 8; if (PM == 3) rv[i_] = (u32x4){0x3c003c00u, 0x3c003c00u, 0x3c003c00u, 0x3c003c00u}; else rv[i_] = *(const u32x4*)(vp_ + o_); } } while (0)
            RET_LOAD_QK(0, 0); RET_LOAD_V(0);
            for (int st = 0; st < 18; ++st) {
                const bool isctx = st < 2;
                const int cidx = isctx ? (dir ? 1 - st : st) : (dir ? 17 - st : st - 2);
                gtarget += 4u;
                if (gctr != nullptr && tid == 0) { __hip_atomic_fetch_add(gctr, 1u, __ATOMIC_RELAXED, __HIP_MEMORY_SCOPE_AGENT);
                    for (int sp = 0; sp < 48 && __hip_atomic_load(gctr, __ATOMIC_RELAXED, __HIP_MEMORY_SCOPE_AGENT) < gtarget; ++sp) __builtin_amdgcn_s_sleep(2); }
                int r_l = r, hh_l = hh, sn_l = sn; float lg2_l = lg2; asm volatile("" : "+v"(r_l), "+v"(hh_l), "+v"(sn_l), "+v"(lg2_l));
                f32x16 sc[2], out[2];
#pragma unroll
                for (int i = 0; i < 2; ++i)
#pragma unroll
                    for (int e = 0; e < 16; ++e) { sc[i][e] = 0.f; out[i][e] = 0.f; }
#pragma unroll
                for (int dh = 0; dh < 2; ++dh) {
                    if (PM != 4) __syncthreads();
#pragma unroll
                    for (int i = 0; i < 4; ++i) { const int n = sn_l + 32 * i;
                        if (!isctx) *(LAS u32x4*)(QH + n * RS + scc * 8) = rq[i];
                        *(LAS u32x4*)(KH + n * RS + scc * 8) = rk[i];
                        if (dh == 0) *(LAS u32x4*)(VL + n * RS + scc * 8) = scale8(rv[i], 0.0625f * __builtin_amdgcn_exp2f(-lg2_l * (float)(n + 1))); }
                    if (!isctx) {
#pragma unroll
                        for (int i = 0; i < 2; ++i)
#pragma unroll
                            for (int g = 0; g < 4; ++g) { u32x2 w; w.x = pkbf(S[dh][i][4 * g], S[dh][i][4 * g + 1]); w.y = pkbf(S[dh][i][4 * g + 2], S[dh][i][4 * g + 3]);
                                *(LAS u32x2*)(SL + (32 * eb + r) * RS + 32 * (2 * dg + i) + 8 * g + 4 * hh) = w; }
                    }
                    if (PM != 4) __syncthreads();
                    if (dh == 0) RET_LOAD_QK(st, 1); else if (st + 1 < 18) RET_LOAD_QK(st + 1, 0);
                    if (!isctx) {
                        if (2 * mg <= nb) {
                            const bool two = 2 * mg + 1 <= nb;
#pragma unroll 2
                            for (int s = 0; s < 8; ++s) {
                                const bf16x8 qb_ = *(const LAS bf16x8*)(QH + o_row + 32 * nb * RS + 16 * s);
                                const bf16x8 k0 = *(const LAS bf16x8*)(KH + o_row + 32 * (2 * mg) * RS + 16 * s);
                                sc[0] = rmf<PM>(k0, qb_, sc[0]);
                                if (two) { const bf16x8 k1 = *(const LAS bf16x8*)(KH + o_row + 32 * (2 * mg + 1) * RS + 16 * s); sc[1] = rmf<PM>(k1, qb_, sc[1]); } }
                        }
#pragma unroll 2
                        for (int s = 0; s < 8; ++s) {
                            const bf16x8 sb = *(const LAS bf16x8*)(SL + o_row + 32 * eb * RS + 16 * s);
                            const bf16x8 q0 = *(const LAS bf16x8*)(QH + o_row + 32 * (2 * dg) * RS + 16 * s), q1 = *(const LAS bf16x8*)(QH + o_row + 32 * (2 * dg + 1) * RS + 16 * s);
                            out[0] = rmf<PM>(sb, q0, out[0]); out[1] = rmf<PM>(sb, q1, out[1]); }
                    }
#pragma unroll 2
                    for (int s = 0; s < 8; ++s) {
                        const LAS bf16_t* vp = VL + o_tr + 16 * s * RS + 32 * eb;
                        const bf16x8 vb = tr_pair(vp, vp + 4 * RS);
                        const LAS bf16_t* kp = KH + o_tr + 16 * s * RS + 32 * (2 * dg);
                        const bf16x8 ka0 = tr_pair(kp, kp + 4 * RS), ka1 = tr_pair(kp + 32, kp + 32 + 4 * RS);
                        S[dh][0] = rmf<PM>(ka0, vb, S[dh][0]); S[dh][1] = rmf<PM>(ka1, vb, S[dh][1]); }
                }
                if (!isctx) {
                    if (PM != 4) __syncthreads();
#pragma unroll
                    for (int i = 0; i < 2; ++i) { const bool diag = (2 * mg + i) == nb;
#pragma unroll
                        for (int g = 0; g < 4; ++g) { const int n = 32 * nb + r_l, m0 = 32 * (2 * mg + i) + 8 * g + 4 * hh_l;
                            float v0 = sc[i][4 * g], v1 = sc[i][4 * g + 1], v2 = sc[i][4 * g + 2], v3 = sc[i][4 * g + 3];
                            if (diag) { v0 = n >= m0 ? v0 : 0.f; v1 = n >= m0 + 1 ? v1 : 0.f; v2 = n >= m0 + 2 ? v2 : 0.f; v3 = n >= m0 + 3 ? v3 : 0.f; }
                            u32x2 w; w.x = pkbf(v0, v1); w.y = pkbf(v2, v3); *(LAS u32x2*)(QH + n * RS + m0) = w; } }
                    if (PM != 4) __syncthreads();
                }
                if (isctx) RET_LOAD_V(st + 1);
                if (!isctx) {
#pragma unroll 2
                    for (int s = 0; s < 4 * dg + 2; ++s) {
                        const LAS bf16_t* vp = VL + o_tr + 16 * s * RS + 32 * eb;
                        const bf16x8 vb = tr_pair(vp, vp + 4 * RS);
                        const bf16x8 p0 = *(const LAS bf16x8*)(QH + o_row + 32 * (2 * dg) * RS + 16 * s), p1 = *(const LAS bf16x8*)(QH + o_row + 32 * (2 * dg + 1) * RS + 16 * s);
                        out[0] = rmf<PM>(vb, p0, out[0]); out[1] = rmf<PM>(vb, p1, out[1]); }
#pragma unroll 2
                    for (int s = 4 * dg + 2; s < 4 * dg + 4; ++s) {
                        const LAS bf16_t* vp = VL + o_tr + 16 * s * RS + 32 * eb;
                        const bf16x8 vb = tr_pair(vp, vp + 4 * RS);
                        const bf16x8 p1 = *(const LAS bf16x8*)(QH + o_row + 32 * (2 * dg + 1) * RS + 16 * s);
                        out[1] = rmf<PM>(vb, p1, out[1]); }
#pragma unroll
                    for (int i = 0; i < 2; ++i) { const int n = 32 * (2 * dg + i) + r_l; const float f = __builtin_amdgcn_exp2f(lg2_l * (float)(n + 1));
#pragma unroll
                        for (int g = 0; g < 4; ++g) { u32x2 w; w.x = pkbf(out[i][4 * g] * f, out[i][4 * g + 1] * f); w.y = pkbf(out[i][4 * g + 2] * f, out[i][4 * g + 3] * f);
                            *(LAS u32x2*)(OL + n * RS + 32 * eb + 8 * g + 4 * hh_l) = w; } }
                    if (st + 1 < 18) RET_LOAD_V(st + 1);
                    if (PM != 4) __syncthreads();
                    const size_t lb = ((size_t)b * SEQ + cidx * 128) * 2048 + h * 512 + sl * 128;
                    bf16_t* ofb = OF + lb; bf16_t* vob = V1 + lb;
#pragma unroll
                    for (int i = 0; i < 4; ++i) { const int n = sn_l + 32 * i; const int off = (dir ? 127 - n : n) * 2048 + scc * 8;
                        const u32x4 v = *(const LAS u32x4*)(OL + n * RS + scc * 8);
                        if (dir == 0) *(u32x4*)(ofb + off) = v;
                        else { const u32x4 o = *(const u32x4*)(ofb + off);
                            const float t0 = bf_lo(v.x) + bf_lo(o.x), t1 = bf_hi(v.x) + bf_hi(o.x), t2 = bf_lo(v.y) + bf_lo(o.y), t3 = bf_hi(v.y) + bf_hi(o.y), t4 = bf_lo(v.z) + bf_lo(o.z), t5 = bf_hi(v.z) + bf_hi(o.z), t6 = bf_lo(v.w) + bf_lo(o.w), t7 = bf_hi(v.w) + bf_hi(o.w);
                            u32x4 w; w.x = pkbf(t0, t1); w.y = pkbf(t2, t3); w.z = pkbf(t4, t5); w.w = pkbf(t6, t7); *(u32x4*)(vob + off) = w;
                            float s0 = ((t0 + t1) + (t2 + t3)) + ((t4 + t5) + (t6 + t7)), s1 = ((t0 * t0 + t1 * t1) + (t2 * t2 + t3 * t3)) + ((t4 * t4 + t5 * t5) + (t6 * t6 + t7 * t7));
#pragma unroll
                            for (int o2 = 1; o2 < 16; o2 <<= 1) { s0 += __shfl_xor(s0, o2); s1 += __shfl_xor(s1, o2); }
                            if (scc == 0) { const int ro_ = dir ? 127 - (sn_l + 32 * i) : (sn_l + 32 * i); float* gp = gstats + ((size_t)b * SEQ + cidx * 128) * 8 + h * 2 + ro_ * 8; atomicAdd(gp, s0); atomicAdd(gp + 1, s1); } }
                        asm volatile("" ::: "memory"); }
                }
#pragma unroll
                for (int i = 0; i < 2; ++i)
#pragma unroll
                    for (int j = 0; j < 2; ++j)
#pragma unroll
                        for (int e = 0; e < 16; ++e) S[i][j][e] *= cd;
            }
#undef RET_TOK
#undef RET_ROFF
#undef RET_ROFF2
#undef RET_LOAD_QK
#undef RET_LOAD_V
        }
    }
}

#define XB_TMO      128
#define XB_XCNT(j)  (256  + 64 * (j))
#define XB_XSUB(j)  (1280 + 64 * (j))
#define XB_XGEN(j)  (2304 + 64 * (j))
#define XB_TOP      3328
#define XB_TOPGEN   3392
#define XCD_BAR_WORDS 3456
#define XB_SPIN_CAP (1u << 18)

__device__ __forceinline__ unsigned xb_ld(unsigned* p)              { return __hip_atomic_load(p, __ATOMIC_RELAXED, __HIP_MEMORY_SCOPE_AGENT); }
__device__ __forceinline__ unsigned xb_add(unsigned* p, unsigned v) { return __hip_atomic_fetch_add(p, v, __ATOMIC_RELAXED, __HIP_MEMORY_SCOPE_AGENT); }
__device__ __forceinline__ unsigned xb_xcc_id() { return (unsigned)__builtin_amdgcn_s_getreg((3 << 11) | 20) & 0xFu; }
#define XB_SPIN(cond, bar) do { unsigned _sp = 0; while (cond) { __builtin_amdgcn_s_sleep(1); \
    if ((++_sp & 255u) == 0u) { if (xb_ld(&(bar)[XB_TMO])) break; if (_sp > XB_SPIN_CAP) { atomicAdd(&(bar)[XB_TMO], 1u); break; } } } } while (0)

struct XcdBarrier {
    unsigned* bar; unsigned x;
    volatile LAS unsigned* st;
};

__device__ __forceinline__ XcdBarrier xcd_barrier_post(unsigned* bar, volatile LAS unsigned* st) {
    XcdBarrier b; b.bar = bar; b.x = xb_xcc_id(); b.st = st;
    if (threadIdx.x == 0) (void)xb_add(&bar[XB_XCNT(b.x)], 1u);
    return b;
}
__device__ __forceinline__ void xcd_barrier_complete(unsigned* bar, unsigned x, unsigned& nloc, unsigned& nx) {
    const unsigned G = gridDim.x * gridDim.y * gridDim.z;
    unsigned sum, cnt, mine, sp = 0u;
    for (;;) {
        sum = 0u; cnt = 0u; mine = 0u;
#pragma unroll
        for (unsigned j = 0; j < 16; ++j) { const unsigned c = xb_ld(&bar[XB_XCNT(j)]); sum += c; cnt += (c > 0u) ? 1u : 0u; mine = (j == x) ? c : mine; }
        if (sum == G) break;
        __builtin_amdgcn_s_sleep(1);
        if ((++sp & 255u) == 0u) { if (xb_ld(&bar[XB_TMO])) break; if (sp > XB_SPIN_CAP) { atomicAdd(&bar[XB_TMO], 1u); break; } }
    }
    nloc = mine > 0u ? mine : 1u; nx = cnt > 0u ? cnt : 1u;
}

__device__ __forceinline__ void xcd_barrier(const XcdBarrier& b) {
    asm volatile("s_waitcnt vmcnt(0)" ::: "memory");
    __syncthreads();
    if (threadIdx.x == 0) {
        unsigned* bar = b.bar;
        __builtin_amdgcn_s_waitcnt(0);
        unsigned nloc = b.st[0], nx = b.st[1];
        if (nloc == 0u) { xcd_barrier_complete(bar, b.x, nloc, nx); b.st[0] = nloc; b.st[1] = nx; }
        const unsigned old = xb_add(&bar[XB_XSUB(b.x)], 1u);
        const unsigned gen = old / nloc;
        if (old + 1u == (gen + 1u) * nloc) {
            __builtin_amdgcn_fence(__ATOMIC_RELEASE, "agent");
            asm volatile("s_waitcnt vmcnt(0)" ::: "memory");
            const unsigned og = xb_add(&bar[XB_TOP], 1u);
            const unsigned tg = og / nx;
            if (og + 1u == (tg + 1u) * nx) xb_add(&bar[XB_TOPGEN], 1u);
            else XB_SPIN(xb_ld(&bar[XB_TOPGEN]) == tg, bar);
            __builtin_amdgcn_fence(__ATOMIC_ACQUIRE, "agent");
            xb_add(&bar[XB_XGEN(b.x)], 1u);
            asm volatile("s_waitcnt vmcnt(0)" ::: "memory");
        } else {
            XB_SPIN(xb_ld(&bar[XB_XGEN(b.x)]) == gen, bar);
            __builtin_amdgcn_fence(__ATOMIC_ACQUIRE, "agent");
            asm volatile("s_waitcnt vmcnt(0)" ::: "memory");
        }
    }
    __syncthreads();
}

__global__ void __launch_bounds__(512, 2) mega_fwd(Args a) {
    extern __shared__ __attribute__((aligned(16))) unsigned char lds_raw[];
    LAS unsigned char* lds = (LAS unsigned char*)lds_raw;
    cg::grid_group grid = cg::this_grid();
    volatile LAS unsigned* xb_st = (volatile LAS unsigned*)(lds + XB_LDS_OFF);
    if (threadIdx.x < 4) xb_st[threadIdx.x] = 0u;
    __syncthreads();
    const XcdBarrier xbar = xcd_barrier_post((unsigned*)(a.ws + WS_BAR), xb_st);
    unsigned char* const ws = a.ws;
    const int lo = a.ph_lo, hi = a.ph_hi;
#ifndef NO_RET
#define NO_RET 0
#endif
#ifndef NO_ATTN
#define NO_ATTN 0
#endif
#ifndef NO_GEMM
#define NO_GEMM 0
#endif
#define IN(k) (lo <= (k) && (k) < hi)
#define TID ({ int t_ = threadIdx.x; asm volatile("" : "+v"(t_)); t_; })
#define SYNC(k) do { if (lo <= (k) && (k) + 1 < hi) { if ((k) == 0) grid.sync(); else xcd_barrier(xbar); } } while (0)
#define MODP ((float*)(ws + WS_MOD))
#define BF(off) ((bf16_t*)(ws + (off)))
#define GEMM(EpiT, Aoff, Boff, M_, N_, K_, E) do { const pg8::Gemm g_{BF(Aoff), BF(Boff), (M_), (N_), (K_)}; pg8::StaticOrder S_; S_.init((M_), (N_), (int)gridDim.x, (int)blockIdx.x); \
        if (!NO_GEMM) pg8::gemm_phase<EpiT, pg8::StaticOrder, PG8_ALIGN, PG8_SP2>(lds, g_, S_, E); } while (0)
    if (IN(0)) { phase0(a, lds, TID); } SYNC(0);
    if (IN(1)) { norm_phase<false>(a.in[0], a.in[2], nullptr, a.in[6], MODP, MODP + 1024, MA, BF(WS_H), TID); } SYNC(1);
    if (IN(2)) { const EpiQKV0 e{BF(WS_QKV0), a.in[11], a.in[12], (const float*)(ws + WS_TAB0)}; GEMM(EpiQKV0, WS_H, WS_WQKV0, MA, 1536, 1024, e); } SYNC(2);
    if (IN(3) && !NO_ATTN) { { const int t_ = TID; float gq_ = fabsf(a.in[11][t_ & 63]), gk_ = fabsf(a.in[12][t_ & 63]);
            for (int o_ = 1; o_ < 64; o_ <<= 1) { gq_ = fmaxf(gq_, __shfl_xor(gq_, o_)); gk_ = fmaxf(gk_, __shfl_xor(gk_, o_)); }
            const bool small_ = __builtin_amdgcn_readfirstlane((8.0f * LOG2E * 1.02f * gq_ * gk_ < 60.0f) ? 1 : 0) != 0;
            if (small_) attn_phase<false>(lds, BF(WS_QKV0), BF(WS_H), a.in[13], a.in[11], a.in[12], t_);
            else attn_phase<true>(lds, BF(WS_QKV0), BF(WS_H), a.in[13], a.in[11], a.in[12], t_); } } SYNC(3);
    if (IN(4)) { const EpiResid<0> e{a.in[0], a.in[2], BF(WS_X), nullptr, MODP + 2048}; GEMM(EpiResid<0>, WS_H, WS_WO0, MA, 1024, 1024, e); } SYNC(4);
    if (IN(5)) { norm_phase<true>(nullptr, nullptr, BF(WS_X), a.in[7], MODP + 3072, MODP + 4096, MA, BF(WS_H), TID); } SYNC(5);
    if (IN(6)) { const EpiSwiglu e{BF(WS_ACT0)}; GEMM(EpiSwiglu, WS_H, WS_WIN0, MA, 5632, 1024, e); } SYNC(6);
    if (IN(7)) { const EpiResid<1> e{nullptr, nullptr, BF(WS_X), nullptr, MODP + 5120}; GEMM(EpiResid<1>, WS_ACT0, WS_WOUT0, MA, 1024, 2816, e); } SYNC(7);
    if (IN(8)) { norm_phase<true>(nullptr, nullptr, BF(WS_X), a.in[6] + 1024, MODP + 33 * 6144, MODP + 33 * 6144 + 1024, MA, BF(WS_HL1), TID); } SYNC(8);
    if (IN(9)) { const EpiQKV1 e{BF(WS_Q1), BF(WS_K1), BF(WS_V1), (const float*)(ws + WS_TAB1)}; GEMM(EpiQKV1, WS_HL1, WS_WR, MA, 4096, 1024, e); } SYNC(9);
    if (IN(10) && !NO_RET) { ret_phase<0>(lds, BF(WS_Q1), BF(WS_K1), BF(WS_V1), (bf16_t*)a.out, (float*)(ws + WS_GNS), nullptr, a.in[16], TID); } SYNC(10);
    if (IN(11)) { const EpiGate e{BF(WS_V1), (const float*)(ws + WS_GNS), a.in[17]}; GEMM(EpiGate, WS_HL1, WS_WR + (size_t)4096 * 1024 * 2, MX, 2048, 1024, e); } SYNC(11);
    if (IN(12)) { const EpiResid<1> e{nullptr, nullptr, BF(WS_X), nullptr, MODP + 33 * 6144 + 2048}; GEMM(EpiResid<1>, WS_V1, WS_WRO, MX, 1024, 2048, e); } SYNC(12);
    if (IN(13)) { norm_phase<true>(nullptr, nullptr, BF(WS_X), a.in[7] + 1024, MODP + 33 * 6144 + 3072, MODP + 33 * 6144 + 4096, MX, BF(WS_Q1), TID); } SYNC(13);
    if (IN(14)) { const EpiSwiglu e{BF(WS_ACT1)}; GEMM(EpiSwiglu, WS_Q1, WS_WIN1, MX, 5632, 1024, e); } SYNC(14);
    if (IN(15)) { const EpiResid<2> e{nullptr, nullptr, BF(WS_X), a.out, MODP + 33 * 6144 + 5120}; GEMM(EpiResid<2>, WS_ACT1, WS_WOUT1, MX, 1024, 2816, e); }
#ifdef PROBE_UP1
    grid.sync();
    { const EpiSwiglu e{BF(WS_ACT1)}; GEMM(EpiSwiglu, WS_Q1, WS_WIN1, MX, 5632, 1024, e); }
#endif
#ifdef PROBE_RET
    grid.sync();
    ret_phase<PROBE_RET - 1>(lds, BF(WS_Q1), BF(WS_K1), BF(WS_V1), BF(WS_V1), (float*)(ws + WS_GNS), nullptr, a.in[16], TID);
#endif
#ifdef PROBE_SYNC
    for (int i = 0; i < 20; ++i) grid.sync();
#endif
#ifdef PROBE_RESID
    grid.sync();
    { const EpiResid<1> e{nullptr, nullptr, BF(WS_HL1), nullptr, MODP + 33 * 6144 + 2048}; GEMM(EpiResid<1>, WS_V1, WS_WRO, MX, 1024, 2048, e); }
    grid.sync();
    { const EpiResid<1> e{nullptr, nullptr, BF(WS_HL1), nullptr, MODP + 33 * 6144 + 5120}; GEMM(EpiResid<1>, WS_ACT1, WS_WOUT1, MX, 1024, 2816, e); }
#endif
#ifdef PROBE_NORM
    grid.sync();
    norm_phase<true>(nullptr, nullptr, BF(WS_X), a.in[7] + 1024, MODP + 33 * 6144 + 3072, MODP + 33 * 6144 + 4096, MX, BF(WS_Q1), TID);
    grid.sync();
    phase0(a, lds, TID);
#endif
}


#ifndef MK_MULTI
#define MK_MULTI 0
#endif
extern "C" void kernel_launch(void* const* d_in, const int* in_sizes, int n_in, void* d_out, int out_size, void* d_ws, size_t ws_size, hipStream_t stream) {
    static int grid = 0;
    if (grid == 0) {
        int dev = 0, cus = 0, per_cu = 0;
        (void)hipGetDevice(&dev); (void)hipDeviceGetAttribute(&cus, hipDeviceAttributeMultiprocessorCount, dev);
        if (hipFuncSetAttribute((const void*)mega_fwd, hipFuncAttributeMaxDynamicSharedMemorySize, LDS_BYTES) != hipSuccess) fprintf(stderr, "kernel_launch: hipFuncSetAttribute failed\n");
        if (hipOccupancyMaxActiveBlocksPerMultiprocessor(&per_cu, (const void*)mega_fwd, 512, LDS_BYTES) != hipSuccess || per_cu < 1) { fprintf(stderr, "kernel_launch: occupancy query says %d blocks/CU\n", per_cu); per_cu = 1; }
        (void)hipGetLastError();
        grid = cus > 0 ? cus : 256;
        if (n_in != 19 || ws_size < WS_END) fprintf(stderr, "kernel_launch: unexpected n_in %d / ws_size %zu (need %zu)\n", n_in, ws_size, (size_t)WS_END);
    }
    (void)hipMemsetAsync((unsigned char*)d_ws + WS_BAR, 0, 65536, stream);
    Args a{};
    for (int i = 0; i < 19; ++i) a.in[i] = (const float*)d_in[i];
    a.out = (float*)d_out; a.ws = (unsigned char*)d_ws;
#if MK_MULTI
    for (int ph = 0; ph < NPHASE; ++ph) { a.ph_lo = ph; a.ph_hi = ph + 1; hipLaunchKernelGGL(mega_fwd, dim3(grid), dim3(512), LDS_BYTES, stream, a); }
#else
    a.ph_lo = 0; a.ph_hi = NPHASE;
    void* args[] = {&a};
    const hipError_t e = hipLaunchCooperativeKernel((const void*)mega_fwd, dim3(grid), dim3(512), args, LDS_BYTES, stream);
    if (e != hipSuccess) fprintf(stderr, "kernel_launch: cooperative launch failed: %s (grid %d)\n", hipGetErrorString(e), grid);
#endif
}
```
